# Optimizing an MI355X kernel written in HIP

```python
import jax, jax.numpy as jnp
from jax import lax
import numpy as np

D_MODEL = 1024
BATCH = 8
SEQ = 4096
DEPTH = 1

GLA_HEADS = 4
GLA_DK = D_MODEL // 2 // GLA_HEADS
GLA_DV = D_MODEL // GLA_HEADS
GLA_QK_W = GLA_HEADS * GLA_DK
GLA_V_W = GLA_HEADS * GLA_DV
GLA_GATE_RANK = 16
GLA_GATE_NORMALIZER = 16.0
GLA_LOG_GATE_MIN = -0.5
GLA_CHUNK = 64
SWA_HEADS = 8
SWA_KV_HEADS = 2
SWA_HEAD_DIM = 128
SWA_Q_W = SWA_HEADS * SWA_HEAD_DIM
SWA_KV_W = SWA_KV_HEADS * SWA_HEAD_DIM
SWA_WINDOW = 128
SWA_BLOCK = 128
ROPE_THETA = 10000.0
D_FF = -(-8 * D_MODEL // (3 * 256)) * 256
NORM_EPS = 1e-6
IN_SPLITS = (GLA_QK_W, GLA_QK_W, GLA_V_W, GLA_V_W, GLA_GATE_RANK, GLA_GATE_RANK,
             SWA_Q_W, SWA_KV_W, SWA_KV_W, D_MODEL, D_MODEL)
D_IN = sum(IN_SPLITS)

kernel_name = "hybrid_gla_swa_gated_encoder_block"


def _rms_norm(x, g):
    xf = x.astype(jnp.float32)
    y = xf * lax.rsqrt(jnp.mean(xf * xf, axis=-1, keepdims=True) + NORM_EPS)
    return (y * g.astype(jnp.float32)).astype(x.dtype)


def _rope(x, pos):
    half = x.shape[-1] // 2
    inv_freq = ROPE_THETA ** (-jnp.arange(half, dtype=jnp.float32) / half)
    ang = pos.astype(jnp.float32)[:, None] * inv_freq[None, :]
    cos = jnp.cos(ang)[None, :, None, :]
    sin = jnp.sin(ang)[None, :, None, :]
    x1, x2 = x[..., :half], x[..., half:]
    return jnp.concatenate([x1 * cos - x2 * sin, x2 * cos + x1 * sin], axis=-1)


def _gla_direction(q, k, v, log_g, include_diag):
    bsz, nh, s, dk = q.shape
    dv = v.shape[-1]
    c = GLA_CHUNK
    n = s // c
    q = q.reshape(bsz, nh, n, c, dk)
    k = k.reshape(bsz, nh, n, c, dk)
    log_g = log_g.reshape(bsz, nh, n, c, dk)
    v = v.reshape(bsz, nh, n, c, dv)
    b = jnp.cumsum(log_g, axis=3)
    b_last = b[:, :, :, -1:, :]
    q_dec = q * jnp.exp(b)
    k_inv = k * jnp.exp(-b)
    k_tail = k * jnp.exp(b_last - b)
    mask = jnp.tril(jnp.ones((c, c), dtype=bool), k=0 if include_diag else -1)
    scores = jnp.where(mask, jnp.einsum("bhncd,bhnmd->bhncm", q_dec, k_inv), 0.0)
    o_intra = jnp.einsum("bhncm,bhnme->bhnce", scores, v)
    chunk_kv = jnp.einsum("bhnmd,bhnme->nbhde", k_tail, v)
    chunk_decay = jnp.exp(jnp.moveaxis(b_last[:, :, :, 0, :], 2, 0))

    def step(state, inp):
        kv_n, dec_n = inp
        return dec_n[..., None] * state + kv_n, state

    _, states = lax.scan(step, jnp.zeros((bsz, nh, dk, dv), q.dtype), (chunk_kv, chunk_decay))
    o_inter = jnp.einsum("bhncd,nbhde->bhnce", q_dec, states)
    return (o_intra + o_inter).reshape(bsz, nh, s, dv)


def _gla_branch(q, k, v, r, lr_f, lr_b, up_f, bias_f, up_b, bias_b, out_g):
    bsz, s, _ = q.shape
    f32 = jnp.float32

    def heads(t, d):
        return t.astype(f32).reshape(bsz, s, GLA_HEADS, d).transpose(0, 2, 1, 3)

    def log_gate(lr, up, bias):
        z = lr.astype(f32) @ up.astype(f32) + bias.astype(f32)
        lg = jnp.maximum(jax.nn.log_sigmoid(z) / GLA_GATE_NORMALIZER, GLA_LOG_GATE_MIN)
        return heads(lg, GLA_DK)

    qh = heads(q, GLA_DK) * (GLA_DK ** -0.5)
    kh = heads(k, GLA_DK)
    vh = heads(v, GLA_DV)
    o_fwd = _gla_direction(qh, kh, vh, log_gate(lr_f, up_f, bias_f), True)
    flip = lambda t: jnp.flip(t, axis=2)
    o_bwd = flip(_gla_direction(flip(qh), flip(kh), flip(vh),
                                flip(log_gate(lr_b, up_b, bias_b)), False))
    o = _rms_norm(o_fwd + o_bwd, out_g)
    o = o.transpose(0, 2, 1, 3).reshape(bsz, s, GLA_V_W)
    return (o * jax.nn.silu(r.astype(f32))).astype(q.dtype)


def _swa_branch(q, k, v, q_g, k_g, sinks):
    bsz, s, _ = q.shape
    f32 = jnp.float32
    hd, hkv, blk = SWA_HEAD_DIM, SWA_KV_HEADS, SWA_BLOCK
    grp = SWA_HEADS // SWA_KV_HEADS
    n = s // blk
    pos = jnp.arange(s)
    q = _rope(_rms_norm(q.astype(f32).reshape(bsz, s, SWA_HEADS, hd), q_g), pos)
    k = _rope(_rms_norm(k.astype(f32).reshape(bsz, s, hkv, hd), k_g), pos)
    v = v.astype(f32).reshape(bsz, s, hkv, hd)

    def context(t):
        tp = jnp.pad(t, ((0, 0), (blk, blk), (0, 0), (0, 0)))
        return jnp.concatenate(
            [tp[:, o * blk:o * blk + s].reshape(bsz, n, blk, hkv, hd) for o in range(3)], axis=2)

    kc, vc = context(k), context(v)
    qb = q.reshape(bsz, n, blk, hkv, grp, hd)
    scores = jnp.einsum("bnqhgd,bnkhd->bnhgqk", qb, kc) * (hd ** -0.5)
    q_off = jnp.arange(blk)
    k_off = jnp.arange(3 * blk) - blk
    in_window = jnp.abs(k_off[None, :] - q_off[:, None]) <= SWA_WINDOW
    k_abs = jnp.arange(n)[:, None] * blk + k_off[None, :]
    in_seq = (k_abs >= 0) & (k_abs < s)
    mask = in_window[None, :, :] & in_seq[:, None, :]
    scores = jnp.where(mask[None, :, None, None], scores, -jnp.inf)
    sink = sinks.astype(f32).reshape(1, 1, hkv, grp, 1, 1)
    m = jnp.maximum(scores.max(axis=-1, keepdims=True), sink)
    p = jnp.exp(scores - m)
    denom = p.sum(axis=-1, keepdims=True) + jnp.exp(sink - m)
    o = jnp.einsum("bnhgqk,bnkhd->bnqhgd", p / denom, vc)
    return o.reshape(bsz, s, SWA_Q_W)


def setup_inputs(seed: int = 0) -> dict:
    key = jax.random.key(seed)
    ks = jax.random.split(key, 20)
    f32 = jnp.float32
    nrm = lambda k, shape, scale: jax.random.normal(k, shape, f32) * scale
    gain = lambda k, d: 1.0 + 0.02 * jax.random.normal(k, (DEPTH, d), f32)
    return {
        "x": nrm(ks[0], (BATCH, SEQ, D_MODEL), 1.0),
        "norm_mix_g": gain(ks[1], D_MODEL),
        "w_in": nrm(ks[2], (DEPTH, D_MODEL, D_IN), D_MODEL ** -0.5),
        "gla_gate_up_fwd": nrm(ks[3], (DEPTH, GLA_GATE_RANK, GLA_QK_W), GLA_GATE_RANK ** -0.5),
        "gla_gate_bias_fwd": nrm(ks[4], (DEPTH, GLA_QK_W), 0.02),
        "gla_gate_up_bwd": nrm(ks[5], (DEPTH, GLA_GATE_RANK, GLA_QK_W), GLA_GATE_RANK ** -0.5),
        "gla_gate_bias_bwd": nrm(ks[6], (DEPTH, GLA_QK_W), 0.02),
        "gla_out_norm_g": gain(ks[7], GLA_DV),
        "w_o_gla": nrm(ks[8], (DEPTH, GLA_V_W, D_MODEL), GLA_V_W ** -0.5),
        "swa_q_norm_g": gain(ks[9], SWA_HEAD_DIM),
        "swa_k_norm_g": gain(ks[10], SWA_HEAD_DIM),
        "swa_sinks": nrm(ks[11], (DEPTH, SWA_HEADS), 0.5),
        "w_o_swa": nrm(ks[12], (DEPTH, SWA_Q_W, D_MODEL), SWA_Q_W ** -0.5),
        "w_out": nrm(ks[13], (DEPTH, D_MODEL, D_MODEL), D_MODEL ** -0.5),
        "norm_ffn_g": gain(ks[14], D_MODEL),
        "w_ffn_in": nrm(ks[15], (DEPTH, D_MODEL, 2 * D_FF), D_MODEL ** -0.5),
        "w_ffn_out": nrm(ks[16], (DEPTH, D_FF, D_MODEL), D_FF ** -0.5),
    }


def reference(x, norm_mix_g, w_in, gla_gate_up_fwd, gla_gate_bias_fwd, gla_gate_up_bwd,
              gla_gate_bias_bwd, gla_out_norm_g, w_o_gla, swa_q_norm_g, swa_k_norm_g,
              swa_sinks, w_o_swa, w_out, norm_ffn_g, w_ffn_in, w_ffn_out):
    split_at = tuple(int(i) for i in np.cumsum(IN_SPLITS)[:-1])
    for l in range(DEPTH):
        h = _rms_norm(x, norm_mix_g[l])
        proj = h @ w_in[l]
        (g_q, g_k, g_v, g_r, g_lr_f, g_lr_b,
         s_q, s_k, s_v, gate_a, gate_b) = jnp.split(proj, split_at, axis=-1)
        y_gla = _gla_branch(g_q, g_k, g_v, g_r, g_lr_f, g_lr_b,
                            gla_gate_up_fwd[l], gla_gate_bias_fwd[l],
                            gla_gate_up_bwd[l], gla_gate_bias_bwd[l],
                            gla_out_norm_g[l]) @ w_o_gla[l]
        y_swa = _swa_branch(s_q, s_k, s_v, swa_q_norm_g[l], swa_k_norm_g[l],
                            swa_sinks[l]).astype(x.dtype) @ w_o_swa[l]
        merged = jax.nn.sigmoid(gate_a) * y_gla + jax.nn.sigmoid(gate_b) * y_swa
        x = x + merged @ w_out[l]
        h2 = _rms_norm(x, norm_ffn_g[l])
        gu = h2 @ w_ffn_in[l]
        ff_gate, ff_up = gu[..., :D_FF], gu[..., D_FF:]
        x = x + (jax.nn.silu(ff_gate) * ff_up) @ w_ffn_out[l]
    return x
```

```cpp
#include <hip/hip_runtime.h>
#include <cstdio>
#include <cstdint>
#include <cmath>
namespace pg8 {
#define PG8_LAS __attribute__((address_space(3)))
typedef unsigned short bf16_t;
typedef short bf16x8 __attribute__((ext_vector_type(8)));
typedef float f32x4 __attribute__((ext_vector_type(4)));
typedef unsigned u32x4 __attribute__((ext_vector_type(4)));
constexpr int BM = 256, BK = 64, HALF = 128, HTB = HALF * BK * 2  , STAGE_BYTES = 8 * HTB, NXCD = 8, WGM = 8;

__host__ __device__ __forceinline__ int lds_byte(int r, int c) { const int st = (r >> 4) * 2 + (c >> 5), rr = r & 15, cc = c & 31, ob = rr * 64 + cc * 2; return st * 1024 + (ob ^ (((ob >> 9) & 1) << 5)); }
__host__ __device__ __forceinline__ void stage_rc(int b, int& R, int& C) { const int st = b / 1024, sb = b % 1024, swz = sb ^ (((sb >> 9) & 1) << 5); R = (st >> 1) * 16 + swz / 64; C = (st & 1) * 32 + (swz % 64) / 2; }
__host__ __device__ __forceinline__ int perm32(int rho) { const int n = rho >> 4, i = rho & 15; return 8 * (i >> 2) + 4 * n + (i & 3); }

struct Unit { int pm, pn; };
struct Gemm { const bf16_t* A; const bf16_t* Bt; int M, N, K; };

struct StaticOrder {
    int nM, nN, nwg, G, c;
    __host__ __device__ void init(int M, int N, int G_, int c_) { nM = M / BM; nN = N / BM; nwg = nM * nN; G = G_; c = c_; }
    __host__ __device__ bool next(int i, Unit& u) const {
        const long L = (long)i * G + c; if (L >= nwg) return false;
        int wgid = (int)L; { const int q = nwg / NXCD, r = nwg % NXCD, xcd = wgid % NXCD, off = wgid / NXCD; wgid = (xcd < r ? xcd * (q + 1) : r * (q + 1) + (xcd - r) * q) + off; }
        const int nig = WGM * nN, gid = wgid / nig, fm = gid * WGM, gsz = (nM - fm) < WGM ? (nM - fm) : WGM;
        u.pm = fm + ((wgid % nig) % gsz); u.pn = (wgid % nig) / gsz; return true;
    }
    __device__ __forceinline__ void a_ready(const Unit&) const {}
    __device__ __forceinline__ void done(const Unit&) const {}
};

__device__ __forceinline__ unsigned cvt_pk_bf16(float lo, float hi) { unsigned r; asm volatile("v_cvt_pk_bf16_f32 %0, %1, %2" : "=v"(r) : "v"(lo), "v"(hi)); return r; }
typedef float f32x2 __attribute__((ext_vector_type(2)));
typedef unsigned u32x2 __attribute__((ext_vector_type(2)));
__device__ __forceinline__ float bflo(unsigned w) { return __uint_as_float(w << 16); }
__device__ __forceinline__ float bfhi(unsigned w) { return __uint_as_float(w & 0xffff0000u); }
__device__ __forceinline__ float sigm(float x) { return __builtin_amdgcn_rcpf(1.0f + __builtin_amdgcn_exp2f(-1.4426950408889634f * x)); }

struct EpiProj {
    static constexpr bool PERM = true, AFTER_DRAIN = false;
    bf16_t *QG, *KG, *VG, *R, *SQ, *SK, *SV, *GA, *GB;
    __device__ __forceinline__ void operator()(const f32x4 (&acc)[2][2][4][2], const Unit& u, int wr, int wc, int fr, int fq) const {
        const int pn = u.pn; bf16_t* base; int ldc, ct; float sc = 1.f;
        if (pn < 2) { base = QG; ldc = 512; ct = pn * 256; sc = 0.08838834764831845f; }
        else if (pn < 4) { base = KG; ldc = 512; ct = (pn - 2) * 256; }
        else if (pn < 8) { base = VG; ldc = 1024; ct = (pn - 4) * 256; }
        else if (pn < 12) { base = R; ldc = 1024; ct = (pn - 8) * 256; }
        else if (pn < 16) { base = SQ; ldc = 1024; ct = (pn - 12) * 256; }
        else if (pn == 16) { base = SK; ldc = 256; ct = 0; }
        else if (pn == 17) { base = SV; ldc = 256; ct = 0; }
        else if (pn < 22) { base = GA; ldc = 1024; ct = (pn - 18) * 256; }
        else { base = GB; ldc = 1024; ct = (pn - 22) * 256; }
        const int row0 = u.pm * BM + wr * 64 + fr, col0 = ct + wc * 32 + 8 * fq;
#pragma unroll
        for (int ai = 0; ai < 2; ++ai)
#pragma unroll
            for (int m = 0; m < 4; ++m) { bf16_t* rowp = base + (size_t)(row0 + ai * HALF + m * 16) * ldc + col0;
#pragma unroll
                for (int bj = 0; bj < 2; ++bj) { const f32x4 v0 = acc[ai][bj][m][0] * sc, v1 = acc[ai][bj][m][1] * sc;
                    u32x4 w; w.x = cvt_pk_bf16(v0[0], v0[1]); w.y = cvt_pk_bf16(v0[2], v0[3]); w.z = cvt_pk_bf16(v1[0], v1[1]); w.w = cvt_pk_bf16(v1[2], v1[3]);
                    *(u32x4*)(rowp + bj * HALF) = w; } }
    }
};
struct EpiGateF32 {
    static constexpr bool PERM = false, AFTER_DRAIN = false;
    const bf16_t* gate; float* out;
    __device__ __forceinline__ void operator()(const f32x4 (&acc)[2][2][4][2], const Unit& u, int wr, int wc, int fr, int fq) const {
        const int row0 = u.pm * BM + wr * 64 + fr, col0 = u.pn * BM + wc * 32 + 4 * fq;
#pragma unroll
        for (int ai = 0; ai < 2; ++ai)
#pragma unroll
            for (int m = 0; m < 4; ++m) { const size_t off = (size_t)(row0 + ai * HALF + m * 16) * 1024 + col0;
#pragma unroll
                for (int bj = 0; bj < 2; ++bj)
#pragma unroll
                    for (int n = 0; n < 2; ++n) { const size_t o2 = off + bj * HALF + n * 16; const u32x2 g = *(const u32x2*)(gate + o2); f32x4 v = acc[ai][bj][m][n];
                        v[0] *= sigm(bflo(g.x)); v[1] *= sigm(bfhi(g.x)); v[2] *= sigm(bflo(g.y)); v[3] *= sigm(bfhi(g.y)); *(f32x4*)(out + o2) = v; } }
    }
};
struct EpiMerge {
    static constexpr bool PERM = true, AFTER_DRAIN = false;
    const bf16_t* gate; const float* part; bf16_t* out;
    __device__ __forceinline__ void operator()(const f32x4 (&acc)[2][2][4][2], const Unit& u, int wr, int wc, int fr, int fq) const {
        const int row0 = u.pm * BM + wr * 64 + fr, col0 = u.pn * BM + wc * 32 + 8 * fq;
#pragma unroll
        for (int ai = 0; ai < 2; ++ai)
#pragma unroll
            for (int m = 0; m < 4; ++m) { const size_t off = (size_t)(row0 + ai * HALF + m * 16) * 1024 + col0;
#pragma unroll
                for (int bj = 0; bj < 2; ++bj) { const size_t o2 = off + bj * HALF; const u32x4 g = *(const u32x4*)(gate + o2); const f32x4 p0 = *(const f32x4*)(part + o2), p1 = *(const f32x4*)(part + o2 + 4);
                    const f32x4 a0 = acc[ai][bj][m][0], a1 = acc[ai][bj][m][1];
                    u32x4 w; w.x = cvt_pk_bf16(p0[0] + a0[0] * sigm(bflo(g.x)), p0[1] + a0[1] * sigm(bfhi(g.x))); w.y = cvt_pk_bf16(p0[2] + a0[2] * sigm(bflo(g.y)), p0[3] + a0[3] * sigm(bfhi(g.y)));
                    w.z = cvt_pk_bf16(p1[0] + a1[0] * sigm(bflo(g.z)), p1[1] + a1[1] * sigm(bfhi(g.z))); w.w = cvt_pk_bf16(p1[2] + a1[2] * sigm(bflo(g.w)), p1[3] + a1[3] * sigm(bfhi(g.w)));
                    *(u32x4*)(out + o2) = w; } }
    }
};
struct EpiX1 {
    static constexpr bool PERM = false, AFTER_DRAIN = false;
    const float* x; float* out; bf16_t* xb; float* ssq;
    __device__ __forceinline__ void operator()(const f32x4 (&acc)[2][2][4][2], const Unit& u, int wr, int wc, int fr, int fq) const {
        const int row0 = u.pm * BM + wr * 64 + fr, col0 = u.pn * BM + wc * 32 + 4 * fq;
#pragma unroll
        for (int ai = 0; ai < 2; ++ai)
#pragma unroll
            for (int m = 0; m < 4; ++m) { const int row = row0 + ai * HALF + m * 16; const size_t off = (size_t)row * 1024 + col0; float s = 0.f;
#pragma unroll
                for (int bj = 0; bj < 2; ++bj)
#pragma unroll
                    for (int n = 0; n < 2; ++n) { const size_t o2 = off + bj * HALF + n * 16; const f32x4 v = *(const f32x4*)(x + o2) + acc[ai][bj][m][n]; *(f32x4*)(out + o2) = v;
                        s += (v[0] * v[0] + v[1] * v[1]) + (v[2] * v[2] + v[3] * v[3]); u32x2 w; w.x = cvt_pk_bf16(v[0], v[1]); w.y = cvt_pk_bf16(v[2], v[3]); *(u32x2*)(xb + o2) = w; }
                s += __shfl_xor(s, 16); s += __shfl_xor(s, 32);
                if (fq == 0) ssq[(size_t)row * 16 + u.pn * 4 + wc] = s; }
    }
};
struct EpiSwiGLU {
    static constexpr bool PERM = true, AFTER_DRAIN = false;
    const float* ssq; bf16_t* H;
    __device__ __forceinline__ void operator()(const f32x4 (&acc)[2][2][4][2], const Unit& u, int wr, int wc, int fr, int fq) const {
        const int row0 = u.pm * BM + wr * 64 + fr, col0 = u.pn * HALF + wc * 32 + 8 * fq;
#pragma unroll
        for (int ai = 0; ai < 2; ++ai)
#pragma unroll
            for (int m = 0; m < 4; ++m) { const int row = row0 + ai * HALF + m * 16; const f32x4* sp = (const f32x4*)(ssq + (size_t)row * 16);
                const f32x4 s0 = sp[0], s1 = sp[1], s2 = sp[2], s3 = sp[3]; const f32x4 st = (s0 + s1) + (s2 + s3);
                const float rstd = __builtin_amdgcn_rsqf(((st[0] + st[1]) + (st[2] + st[3])) * (1.0f / 1024.0f) + 1e-6f);
                float hv[8];
#pragma unroll
                for (int n = 0; n < 2; ++n)
#pragma unroll
                    for (int e = 0; e < 4; ++e) { const float g = acc[ai][0][m][n][e] * rstd, up = acc[ai][1][m][n][e] * rstd; hv[4 * n + e] = g * sigm(g) * up; }
                u32x4 w; w.x = cvt_pk_bf16(hv[0], hv[1]); w.y = cvt_pk_bf16(hv[2], hv[3]); w.z = cvt_pk_bf16(hv[4], hv[5]); w.w = cvt_pk_bf16(hv[6], hv[7]);
                *(u32x4*)(H + (size_t)row * 2816 + col0) = w; }
    }
};
struct EpiResid {
    static constexpr bool PERM = false, AFTER_DRAIN = false;
    float* out;
    __device__ __forceinline__ void operator()(const f32x4 (&acc)[2][2][4][2], const Unit& u, int wr, int wc, int fr, int fq) const {
        const int row0 = u.pm * BM + wr * 64 + fr, col0 = u.pn * BM + wc * 32 + 4 * fq;
#pragma unroll
        for (int ai = 0; ai < 2; ++ai)
#pragma unroll
            for (int m = 0; m < 4; ++m) { const size_t off = (size_t)(row0 + ai * HALF + m * 16) * 1024 + col0;
#pragma unroll
                for (int bj = 0; bj < 2; ++bj)
#pragma unroll
                    for (int n = 0; n < 2; ++n) { const size_t o2 = off + bj * HALF + n * 16; *(f32x4*)(out + o2) = *(const f32x4*)(out + o2) + acc[ai][bj][m][n]; } }
    }
};

template <class Epi, class Sched, bool ALIGN_EPI = false, bool SP2 = false>
__device__ __forceinline__ void gemm_phase(PG8_LAS unsigned char* lds, const Gemm g, const Sched& S, const Epi& E) {
    const int tid = threadIdx.x, wid = __builtin_amdgcn_readfirstlane(tid >> 6), lane = tid & 63, wr = wid >> 2, wc = wid & 3, fr = lane & 15, fq = lane >> 4;
    const int K = g.K, nt = K / BK;
    unsigned voffA[2], voffB[2];
#pragma unroll
    for (int i = 0; i < 2; ++i) { int R, C; stage_rc(tid * 16 + i * 8192, R, C); const int Rb = Epi::PERM ? ((R & ~31) + perm32(R & 31)) : R;
        voffA[i] = (unsigned)(R * K + C) * 2u; voffB[i] = (unsigned)(Rb * K + C) * 2u; }
    const size_t kstep = (size_t)(BK * 2);
    const size_t hstep = (size_t)HALF * K * 2;
    const size_t tstep = 2 * hstep;
    const unsigned ldsw = (unsigned)wid * 1024u;
    const int aoff = lds_byte(wr * 64 + fr, fq * 8), boff = lds_byte(wc * 32 + fr, fq * 8);
#define PG8_SA(b, h) (((b) * 2 + (h)) * HTB)
#define PG8_SB(b, h) ((4 + (b) * 2 + (h)) * HTB)
#define PG8_STAGE(bufoff, gbase, voff) do { _Pragma("unroll") for (int _i = 0; _i < 2; ++_i) \
        __builtin_amdgcn_global_load_lds((const unsigned*)((const char*)(gbase) + (voff)[_i]), (PG8_LAS unsigned*)(lds + (bufoff) + ldsw + _i * 8192), 16, 0, 0); } while (0)
#define PG8_LDA(dst, b, h) do { _Pragma("unroll") for (int m = 0; m < 4; ++m) _Pragma("unroll") for (int k = 0; k < 2; ++k) dst[m][k] = *(const PG8_LAS bf16x8*)(lds + PG8_SA(b, h) + aoff + m * 2048 + k * 1024); } while (0)
#define PG8_LDB(dst, b, h) do { _Pragma("unroll") for (int n = 0; n < 2; ++n) _Pragma("unroll") for (int k = 0; k < 2; ++k) dst[n][k] = *(const PG8_LAS bf16x8*)(lds + PG8_SB(b, h) + boff + n * 2048 + k * 1024); } while (0)
#define PG8_MMA(ai, bj, At, Bt) do { __builtin_amdgcn_s_setprio(1); _Pragma("unroll") for (int m = 0; m < 4; ++m) _Pragma("unroll") for (int n = 0; n < 2; ++n) _Pragma("unroll") for (int k = 0; k < 2; ++k) \
        acc[ai][bj][m][n] = __builtin_amdgcn_mfma_f32_16x16x32_bf16(Bt[n][k], At[m][k], acc[ai][bj][m][n], 0, 0, 0); __builtin_amdgcn_s_setprio(0); } while (0)
#define PG8_WAIT_V(n) asm volatile("s_waitcnt vmcnt(" #n ")" ::: "memory")
#define PG8_WAIT_L(n) asm volatile("s_waitcnt lgkmcnt(" #n ")" ::: "memory")
#define PG8_BAR __builtin_amdgcn_s_barrier()
#define PG8_SCHED __builtin_amdgcn_sched_barrier(0)
    Unit cur, nxt; int ui = 0;
    if (!S.next(0, cur)) return;
    f32x4 acc[2][2][4][2];
#pragma unroll
    for (int a = 0; a < 2; ++a)
#pragma unroll
        for (int b = 0; b < 2; ++b)
#pragma unroll
            for (int m = 0; m < 4; ++m)
#pragma unroll
                for (int n = 0; n < 2; ++n) acc[a][b][m][n] = (f32x4){0.f, 0.f, 0.f, 0.f};
    bf16x8 At[4][2], B0[2][2], B1[2][2];
    const char* cA = (const char*)g.A + (size_t)cur.pm * tstep; const char* cB = (const char*)g.Bt + (size_t)cur.pn * tstep;
    S.a_ready(cur);
    if constexpr (SP2) {
        PG8_STAGE(PG8_SB(0, 0), cB, voffB); PG8_STAGE(PG8_SB(0, 1), cB + hstep, voffB); PG8_STAGE(PG8_SA(0, 0), cA, voffA); PG8_STAGE(PG8_SA(0, 1), cA + hstep, voffA);
        if (wr == 1) PG8_BAR;
        PG8_WAIT_V(2); PG8_BAR;
        PG8_STAGE(PG8_SB(1, 0), cB + kstep, voffB); PG8_STAGE(PG8_SA(1, 0), cA + kstep, voffA); PG8_STAGE(PG8_SB(1, 1), cB + hstep + kstep, voffB);
        PG8_WAIT_V(6); PG8_BAR;
    } else {
        PG8_STAGE(PG8_SB(0, 0), cB, voffB); PG8_STAGE(PG8_SA(0, 0), cA, voffA); PG8_STAGE(PG8_SB(0, 1), cB + hstep, voffB); PG8_STAGE(PG8_SA(0, 1), cA + hstep, voffA);
        if (wr == 1) PG8_BAR;
        PG8_WAIT_V(4); PG8_BAR;
        PG8_STAGE(PG8_SB(1, 0), cB + kstep, voffB); PG8_STAGE(PG8_SA(1, 0), cA + kstep, voffA); PG8_STAGE(PG8_SB(1, 1), cB + hstep + kstep, voffB);
        PG8_WAIT_V(6); PG8_BAR;
    }
    for (;;) {
        const bool has_next = S.next(ui + 1, nxt);
        const char* nA = has_next ? (const char*)g.A + (size_t)nxt.pm * tstep : cA; const char* nB = has_next ? (const char*)g.Bt + (size_t)nxt.pn * tstep : cB;
        for (int t = 0; t < nt; t += 2) {
            const bool last = (t == nt - 2);
            const char* a1 = cA + (size_t)(t + 1) * kstep;
            const char* a2 = last ? nA : cA + (size_t)(t + 2) * kstep; const char* b2 = last ? nB : cB + (size_t)(t + 2) * kstep;
            const char* a3 = a2 + kstep; const char* b3 = b2 + kstep;
            if (last && has_next) S.a_ready(nxt);
            if constexpr (SP2) {
            PG8_LDB(B0, 0, 0); PG8_LDB(B1, 0, 1); PG8_SCHED; PG8_LDA(At, 0, 0); PG8_STAGE(PG8_SA(1, 1), a1 + hstep, voffA);
            PG8_WAIT_V(8); PG8_WAIT_L(0); PG8_BAR; PG8_MMA(0, 0, At, B0); PG8_MMA(0, 1, At, B1); PG8_BAR; PG8_SCHED;
            PG8_LDA(At, 0, 1); PG8_STAGE(PG8_SB(0, 0), b2, voffB); PG8_STAGE(PG8_SB(0, 1), b2 + hstep, voffB); PG8_STAGE(PG8_SA(0, 0), a2, voffA);
            PG8_WAIT_V(8); PG8_WAIT_L(0); PG8_BAR; PG8_MMA(1, 0, At, B0); PG8_MMA(1, 1, At, B1); PG8_BAR; PG8_SCHED;
            PG8_LDB(B0, 1, 0); PG8_LDB(B1, 1, 1); PG8_SCHED; PG8_LDA(At, 1, 0); PG8_STAGE(PG8_SA(0, 1), a2 + hstep, voffA);
            PG8_WAIT_V(8); PG8_WAIT_L(0); PG8_BAR; PG8_MMA(0, 0, At, B0); PG8_MMA(0, 1, At, B1); PG8_BAR; PG8_SCHED;
            PG8_LDA(At, 1, 1); PG8_STAGE(PG8_SB(1, 0), b3, voffB); PG8_STAGE(PG8_SB(1, 1), b3 + hstep, voffB); PG8_STAGE(PG8_SA(1, 0), a3, voffA);
            PG8_WAIT_V(8); PG8_WAIT_L(0); PG8_BAR; PG8_MMA(1, 0, At, B0); PG8_MMA(1, 1, At, B1); PG8_BAR; PG8_SCHED;
            } else {
            PG8_LDB(B0, 0, 0); PG8_SCHED; PG8_LDA(At, 0, 0); PG8_STAGE(PG8_SA(1, 1), a1 + hstep, voffA);
            PG8_WAIT_L(8); PG8_BAR; PG8_WAIT_L(0); PG8_MMA(0, 0, At, B0); PG8_BAR; PG8_SCHED;
            PG8_LDB(B1, 0, 1); PG8_STAGE(PG8_SB(0, 0), b2, voffB);
            PG8_BAR; PG8_WAIT_L(0); PG8_MMA(0, 1, At, B1); PG8_BAR;
            PG8_LDA(At, 0, 1); PG8_STAGE(PG8_SA(0, 0), a2, voffA);
            PG8_BAR; PG8_WAIT_L(0); PG8_MMA(1, 0, At, B0); PG8_BAR; PG8_SCHED;
            PG8_STAGE(PG8_SB(0, 1), b2 + hstep, voffB);
            PG8_WAIT_V(6); PG8_BAR; PG8_MMA(1, 1, At, B1); PG8_BAR;
            PG8_LDB(B0, 1, 0); PG8_SCHED; PG8_LDA(At, 1, 0); PG8_STAGE(PG8_SA(0, 1), a2 + hstep, voffA);
            PG8_WAIT_L(8); PG8_BAR; PG8_WAIT_L(0); PG8_MMA(0, 0, At, B0); PG8_BAR; PG8_SCHED;
            PG8_LDB(B1, 1, 1); PG8_STAGE(PG8_SB(1, 0), b3, voffB);
            PG8_BAR; PG8_WAIT_L(0); PG8_MMA(0, 1, At, B1); PG8_BAR;
            PG8_LDA(At, 1, 1); PG8_STAGE(PG8_SA(1, 0), a3, voffA);
            PG8_BAR; PG8_WAIT_L(0); PG8_MMA(1, 0, At, B0); PG8_BAR; PG8_SCHED;
            PG8_STAGE(PG8_SB(1, 1), b3 + hstep, voffB);
            PG8_WAIT_V(6); PG8_BAR; PG8_MMA(1, 1, At, B1); PG8_BAR;
            }
        }
        if constexpr (ALIGN_EPI) { if (wr == 0) PG8_BAR; }
        if constexpr (!Epi::AFTER_DRAIN) { E(acc, cur, wr, wc, fr, fq); S.done(cur); }
        if (!has_next) break;
#pragma unroll
        for (int a = 0; a < 2; ++a)
#pragma unroll
            for (int b = 0; b < 2; ++b)
#pragma unroll
                for (int m = 0; m < 4; ++m)
#pragma unroll
                    for (int n = 0; n < 2; ++n) acc[a][b][m][n] = (f32x4){0.f, 0.f, 0.f, 0.f};
        cur = nxt; cA = nA; cB = nB; ++ui;
        if constexpr (ALIGN_EPI) { if (wr == 1) PG8_BAR; }
    }
    PG8_WAIT_V(0);
    if constexpr (!ALIGN_EPI) { if (wr == 0) PG8_BAR; }
    PG8_BAR;
    if constexpr (Epi::AFTER_DRAIN) { E.fused(acc, cur, wr, wc, fr, fq, lds, wid, lane); S.done(cur); }
#undef PG8_SA
#undef PG8_SB
#undef PG8_STAGE
#undef PG8_LDA
#undef PG8_LDB
#undef PG8_MMA
#undef PG8_WAIT_V
#undef PG8_WAIT_L
#undef PG8_BAR
#undef PG8_SCHED
}
}
#define GAS __attribute__((address_space(1)))
#define LAS __attribute__((address_space(3)))
typedef unsigned short bf16;
typedef unsigned v4u __attribute__((ext_vector_type(4)));
typedef float f32x4 __attribute__((ext_vector_type(4)));
typedef short bf16x8 __attribute__((ext_vector_type(8)));
typedef GAS unsigned gu32;
typedef GAS unsigned long long gu64;
#define RLX_AGENT __ATOMIC_RELAXED, __HIP_MEMORY_SCOPE_AGENT
#define LDS_WAIT() asm volatile("s_waitcnt lgkmcnt(0)" ::: "memory")
#define VM_WAIT() asm volatile("s_waitcnt vmcnt(0)" ::: "memory")
__device__ __forceinline__ unsigned long long rt() { return __builtin_amdgcn_s_memrealtime(); }
__device__ __forceinline__ unsigned f2bf(float f) { unsigned u = __builtin_bit_cast(unsigned, f); return (u + 0x7fffu + ((u >> 16) & 1u)) >> 16; }
__device__ __forceinline__ unsigned pk2(float lo, float hi) { return f2bf(lo) | (f2bf(hi) << 16); }
constexpr int NWAVES = 8;
constexpr int BATCH = 8, SEQ = 4096, DM = 1024, M = BATCH * SEQ;
constexpr int NPROJ = 6656;
constexpr int DFF = 2816;
constexpr float EPS = 1e-6f;
constexpr size_t MiB = 1u << 20;
constexpr size_t WS_CTL = 0, CTL_ZERO_BYTES = 1 * MiB;
constexpr size_t WS_WIN = 1 * MiB;
constexpr size_t WS_WLR = 14 * MiB;
constexpr size_t WS_WG = 15 * MiB, WS_WS = 17 * MiB, WS_WOUT = 19 * MiB;
constexpr size_t WS_WFI = 21 * MiB;
constexpr size_t WS_WFO = 32 * MiB;
constexpr size_t WS_ROPE = 38 * MiB;
constexpr size_t WS_LR = 40 * MiB;
constexpr size_t WS_SSQ = 44 * MiB;
constexpr size_t WS_QG = 48 * MiB, WS_KG = 80 * MiB;
constexpr size_t WS_VG = 112 * MiB, WS_R = 176 * MiB, WS_SQ = 240 * MiB;
constexpr size_t WS_SK = 304 * MiB, WS_SV = 320 * MiB;
constexpr size_t WS_GA = 336 * MiB, WS_GB = 400 * MiB;
constexpr size_t WS_END = 464 * MiB;
constexpr size_t WS_MERGED = WS_VG;
constexpr size_t WS_X1B = WS_QG;
constexpr size_t WS_H = WS_SQ;
static_assert(WS_H + (size_t)M * DFF * 2 <= WS_END, "h overlay");
constexpr int CW_TMO = 0, CW_CODE = 1;
constexpr int CW_BAR = 4096;
constexpr int RING_OFF = 0, RING_BYTES = 131072;
constexpr int LDSCTL_OFF = RING_BYTES, MISC_OFF = LDSCTL_OFF + 320;
constexpr int LDS_BYTES = 147456;
static_assert(MISC_OFF + 128 <= LDS_BYTES, "LDS map");

#define XB_TMO      128
#define XB_XCNT(j)  (256  + 64 * (j))
#define XB_XSUB(j)  (1280 + 64 * (j))
#define XB_XGEN(j)  (2304 + 64 * (j))
#define XB_TOP      3328
#define XB_TOPGEN   3392
#define XCD_BAR_WORDS 3456
#define XB_SPIN_CAP (1u << 18)

__device__ __forceinline__ unsigned xb_ld(unsigned* p)              { return __hip_atomic_load(p, __ATOMIC_RELAXED, __HIP_MEMORY_SCOPE_AGENT); }
__device__ __forceinline__ unsigned xb_add(unsigned* p, unsigned v) { return __hip_atomic_fetch_add(p, v, __ATOMIC_RELAXED, __HIP_MEMORY_SCOPE_AGENT); }
__device__ __forceinline__ unsigned xb_xcc_id() { return (unsigned)__builtin_amdgcn_s_getreg((3 << 11) | 20) & 0xFu; }
#define XB_SPIN(cond, bar) do { unsigned _sp = 0; while (cond) { __builtin_amdgcn_s_sleep(1); \
    if ((++_sp & 255u) == 0u) { if (xb_ld(&(bar)[XB_TMO])) break; if (_sp > XB_SPIN_CAP) { atomicAdd(&(bar)[XB_TMO], 1u); break; } } } } while (0)

struct XcdBarrier {
    unsigned* bar; unsigned x;
    volatile LAS unsigned* st;
};

__device__ __forceinline__ XcdBarrier xcd_barrier_post(unsigned* bar, volatile LAS unsigned* st) {
    XcdBarrier b; b.bar = bar; b.x = xb_xcc_id(); b.st = st;
    if (threadIdx.x == 0) (void)xb_add(&bar[XB_XCNT(b.x)], 1u);
    return b;
}
__device__ __forceinline__ void xcd_barrier_complete(unsigned* bar, unsigned x, unsigned& nloc, unsigned& nx) {
    const unsigned G = gridDim.x * gridDim.y * gridDim.z;
    unsigned sum, cnt, mine, sp = 0u;
    for (;;) {
        sum = 0u; cnt = 0u; mine = 0u;
#pragma unroll
        for (unsigned j = 0; j < 16; ++j) { const unsigned c = xb_ld(&bar[XB_XCNT(j)]); sum += c; cnt += (c > 0u) ? 1u : 0u; mine = (j == x) ? c : mine; }
        if (sum == G) break;
        __builtin_amdgcn_s_sleep(1);
        if ((++sp & 255u) == 0u) { if (xb_ld(&bar[XB_TMO])) break; if (sp > XB_SPIN_CAP) { atomicAdd(&bar[XB_TMO], 1u); break; } }
    }
    nloc = mine > 0u ? mine : 1u; nx = cnt > 0u ? cnt : 1u;
}

__device__ __forceinline__ void xcd_barrier(const XcdBarrier& b) {
    asm volatile("s_waitcnt vmcnt(0)" ::: "memory");
    __syncthreads();
    if (threadIdx.x == 0) {
        unsigned* bar = b.bar;
        __builtin_amdgcn_s_waitcnt(0);
        unsigned nloc = b.st[0], nx = b.st[1];
        if (nloc == 0u) { xcd_barrier_complete(bar, b.x, nloc, nx); b.st[0] = nloc; b.st[1] = nx; }
        const unsigned old = xb_add(&bar[XB_XSUB(b.x)], 1u);
        const unsigned gen = old / nloc;
        if (old + 1u == (gen + 1u) * nloc) {
            __builtin_amdgcn_fence(__ATOMIC_RELEASE, "agent");
            asm volatile("s_waitcnt vmcnt(0)" ::: "memory");
            const unsigned og = xb_add(&bar[XB_TOP], 1u);
            const unsigned tg = og / nx;
            if (og + 1u == (tg + 1u) * nx) xb_add(&bar[XB_TOPGEN], 1u);
            else XB_SPIN(xb_ld(&bar[XB_TOPGEN]) == tg, bar);
            __builtin_amdgcn_fence(__ATOMIC_ACQUIRE, "agent");
            xb_add(&bar[XB_XGEN(b.x)], 1u);
            asm volatile("s_waitcnt vmcnt(0)" ::: "memory");
        } else {
            XB_SPIN(xb_ld(&bar[XB_XGEN(b.x)]) == gen, bar);
            __builtin_amdgcn_fence(__ATOMIC_ACQUIRE, "agent");
            asm volatile("s_waitcnt vmcnt(0)" ::: "memory");
        }
    }
    __syncthreads();
}

typedef unsigned u32x2 __attribute__((ext_vector_type(2)));
struct Frame {
    LAS unsigned char* lds;
    volatile LAS unsigned* MISC;
    gu32* ctl;
    int tid, lane, wave;
    int vcu, G;
    const float* x; float* out;
    const float *g_mix, *w_in, *up_f, *bias_f, *up_b, *bias_b, *g_gla, *w_og, *g_q, *g_k, *sinks, *w_os, *w_out, *g_ffn, *w_fi, *w_fo;
    bf16 *WIN, *WLR, *WG, *WS_, *WOUT, *WFI, *WFO;
    float *ROPE, *LR, *SSQ;
    bf16 *QG, *KG, *VG, *R, *SQ, *SK, *SV, *GA, *GB, *MERGED, *X1B, *H;
    bf16 *XN, *OF, *OB;
};
__device__ __forceinline__ float wave_sum(float v) {
#pragma unroll
    for (int o = 1; o < 64; o <<= 1) v += __shfl_xor(v, o);
    return v;
}
__device__ __forceinline__ float wave_max(float v) {
#pragma unroll
    for (int o = 1; o < 64; o <<= 1) v = fmaxf(v, __shfl_xor(v, o));
    return v;
}
__device__ __forceinline__ float bflo(unsigned w) { return __uint_as_float(w << 16); }
__device__ __forceinline__ float bfhi(unsigned w) { return __uint_as_float(w & 0xffff0000u); }
__device__ __forceinline__ float bf1(bf16 b) { return __uint_as_float((unsigned)b << 16); }

__device__ __forceinline__ void p0_item(const float* W, int ldw, int K, int scol0, bf16* WT, int drow0, int k0, const float* gain, LAS float* scr, int lane) {
#pragma unroll 8
    for (int i = 0; i < 32; ++i) { const int kk = 2 * i + (lane >> 5); float v = W[(size_t)(k0 + kk) * ldw + scol0 + (lane & 31)]; if (gain) v *= gain[k0 + kk]; scr[kk * 33 + (lane & 31)] = v; }
    LDS_WAIT(); asm volatile("" ::: "memory");
    const int c = lane & 7;
#pragma unroll
    for (int j = 0; j < 4; ++j) { const int n = (lane >> 3) + 8 * j; const LAS float* s = scr + (8 * c) * 33 + n;
        v4u o; o.x = pk2(s[0 * 33], s[1 * 33]); o.y = pk2(s[2 * 33], s[3 * 33]); o.z = pk2(s[4 * 33], s[5 * 33]); o.w = pk2(s[6 * 33], s[7 * 33]);
        *(GAS v4u*)(WT + (size_t)(drow0 + n) * K + k0 + 8 * c) = o; }
    LDS_WAIT(); asm volatile("" ::: "memory");
}
__device__ __forceinline__ void sincos_d(double a, float& c, float& s) {
    const double n = __builtin_rint(a * 0.6366197723675814);
    double r = __builtin_fma(-n, 1.5707963267948966, a); r = __builtin_fma(-n, 6.123233995736766e-17, r);
    const double r2 = r * r;
    double sp = -1.0 / 1307674368000.0;
    sp = sp * r2 + 1.0 / 6227020800.0; sp = sp * r2 - 1.0 / 39916800.0; sp = sp * r2 + 1.0 / 362880.0; sp = sp * r2 - 1.0 / 5040.0; sp = sp * r2 + 1.0 / 120.0; sp = sp * r2 - 1.0 / 6.0; sp = sp * r2 * r + r;
    double cp = 1.0 / 20922789888000.0;
    cp = cp * r2 - 1.0 / 87178291200.0; cp = cp * r2 + 1.0 / 479001600.0; cp = cp * r2 - 1.0 / 3628800.0; cp = cp * r2 + 1.0 / 40320.0; cp = cp * r2 - 1.0 / 720.0; cp = cp * r2 + 1.0 / 24.0; cp = cp * r2 - 0.5; cp = cp * r2 + 1.0;
    const int q = (int)n & 3;
    const double sv = (q == 0) ? sp : (q == 1) ? cp : (q == 2) ? -sp : -cp;
    const double cv = (q == 0) ? cp : (q == 1) ? -sp : (q == 2) ? -cp : sp;
    c = (float)cv; s = (float)sv;
}
__device__ __forceinline__ void p0_prologue(Frame& F) {
    LAS float* scr = (LAS float*)(F.lds + RING_OFF + F.wave * 16384);
    const int gw = F.vcu * NWAVES + F.wave, NGW = F.G * NWAVES;
    constexpr int I_IN = 16 * 208, I_LR = 16, I_SQ = 16 * 32, I_FI = 16 * 176, I_FO = 44 * 32;
    constexpr int NITEMS = I_IN + I_LR + 3 * I_SQ + I_FI + I_FO;
    for (int it = gw; it < NITEMS; it += NGW) {
        int r = it;
        if (r < I_IN) { const int kb = r / 208, nb = r % 208, dn0 = 32 * nb, sc0 = dn0 + (dn0 >= 3072 ? 32 : 0); p0_item(F.w_in, 6688, 1024, sc0, F.WIN, dn0, 64 * kb, nullptr, scr, F.lane); continue; } r -= I_IN;
        if (r < I_LR) { p0_item(F.w_in, 6688, 1024, 3072, F.WLR, 0, 64 * r, nullptr, scr, F.lane); continue; } r -= I_LR;
        if (r < I_SQ) { p0_item(F.w_og, 1024, 1024, 32 * (r % 32), F.WG, 32 * (r % 32), 64 * (r / 32), nullptr, scr, F.lane); continue; } r -= I_SQ;
        if (r < I_SQ) { p0_item(F.w_os, 1024, 1024, 32 * (r % 32), F.WS_, 32 * (r % 32), 64 * (r / 32), nullptr, scr, F.lane); continue; } r -= I_SQ;
        if (r < I_SQ) { p0_item(F.w_out, 1024, 1024, 32 * (r % 32), F.WOUT, 32 * (r % 32), 64 * (r / 32), nullptr, scr, F.lane); continue; } r -= I_SQ;
        if (r < I_FI) { const int kb = r / 176, nb = r % 176, dn0 = 32 * nb, tj = dn0 >> 8, wi = dn0 & 255, sc0 = (wi < 128) ? (128 * tj + wi) : (DFF + 128 * tj + (wi - 128));
            p0_item(F.w_fi, 2 * DFF, 1024, sc0, F.WFI, dn0, 64 * kb, F.g_ffn, scr, F.lane); continue; } r -= I_FI;
        p0_item(F.w_fo, 1024, DFF, 32 * (r % 32), F.WFO, 32 * (r % 32), 64 * (r / 32), nullptr, scr, F.lane);
    }
    for (int m = gw; m < M; m += NGW) {
        const GAS f32x4* xr = (const GAS f32x4*)(F.x + (size_t)m * DM) + F.lane;
        f32x4 v[4]; float s = 0.f;
#pragma unroll
        for (int j = 0; j < 4; ++j) { v[j] = xr[64 * j]; s += (v[j].x * v[j].x + v[j].y * v[j].y) + (v[j].z * v[j].z + v[j].w * v[j].w); }
        const float rstd = 1.0f / sqrtf(wave_sum(s) * (1.f / DM) + EPS);
        GAS unsigned long long* o8 = (GAS unsigned long long*)(F.XN + (size_t)m * DM) + F.lane;
#pragma unroll
        for (int j = 0; j < 4; ++j) { const f32x4 g = *((const f32x4*)F.g_mix + F.lane + 64 * j);
            o8[64 * j] = (unsigned long long)pk2(v[j].x * rstd * g.x, v[j].y * rstd * g.y) | ((unsigned long long)pk2(v[j].z * rstd * g.z, v[j].w * rstd * g.w) << 32); }
    }
    for (int idx = (F.vcu * NWAVES + F.wave) * 64 + F.lane; idx < SEQ * 64; idx += NGW * 64) {
        const int i = idx & 63, pos = idx >> 6; double f = 1.0;
        for (int k = 0; k < i; ++k) f *= 0.8659643233600653;
        float c, s; sincos_d((double)pos * f, c, s);
        F.ROPE[2 * idx] = c; F.ROPE[2 * idx + 1] = s;
    }
}
__device__ __forceinline__ void p1_lr(Frame& F) {
    const int gw = F.vcu * NWAVES + F.wave, NGW = F.G * NWAVES, fr = F.lane & 15, fq = F.lane >> 4;
    for (int g = gw; g < M / 16; g += NGW) {
        const bf16* ap = F.XN + (size_t)(16 * g + fr) * DM + 8 * fq; const bf16* b0p = F.WLR + (size_t)fr * DM + 8 * fq; const bf16* b1p = b0p + 16 * DM;
        f32x4 a0 = {0.f, 0.f, 0.f, 0.f}, a1 = {0.f, 0.f, 0.f, 0.f};
#pragma unroll 4
        for (int kk = 0; kk < 32; ++kk) { const bf16x8 a = *(const bf16x8*)(ap + 32 * kk), b0 = *(const bf16x8*)(b0p + 32 * kk), b1 = *(const bf16x8*)(b1p + 32 * kk);
            a0 = __builtin_amdgcn_mfma_f32_16x16x32_bf16(a, b0, a0, 0, 0, 0); a1 = __builtin_amdgcn_mfma_f32_16x16x32_bf16(a, b1, a1, 0, 0, 0); }
#pragma unroll
        for (int i = 0; i < 4; ++i) { float* o = F.LR + (size_t)(16 * g + 4 * fq + i) * 32 + fr; o[0] = a0[i]; o[16] = a1[i]; }
    }
}
__device__ __forceinline__ void p1b_qknorm_rope(Frame& F) {
    const int gw = F.vcu * NWAVES + F.wave, NGW = F.G * NWAVES, lane = F.lane;
    for (int idx = gw; idx < M * 10; idx += NGW) {
        const int row = idx / 10, hh = idx - row * 10, pos = row & (SEQ - 1);
        bf16* p; const float* gn; float sc;
        if (hh < 8) { p = F.SQ + (size_t)row * 1024 + hh * 128; gn = F.g_q; sc = 0.08838834764831845f; } else { p = F.SK + (size_t)row * 256 + (hh - 8) * 128; gn = F.g_k; sc = 1.f; }
        float x1 = bf1(p[lane]), x2 = bf1(p[lane + 64]);
        const float rstd = 1.0f / sqrtf(wave_sum(x1 * x1 + x2 * x2) * (1.f / 128.f) + EPS);
        x1 *= rstd * gn[lane]; x2 *= rstd * gn[lane + 64];
        const float c = F.ROPE[2 * (pos * 64 + lane)], s = F.ROPE[2 * (pos * 64 + lane) + 1];
        p[lane] = (bf16)f2bf((x1 * c - x2 * s) * sc); p[lane + 64] = (bf16)f2bf((x2 * c + x1 * s) * sc);
    }
}
__device__ __forceinline__ float logsig(float z) { return fminf(z, 0.f) - log1pf(expf(-fabsf(z))); }
__device__ __forceinline__ void gla_naive(Frame& F) {
    if (F.vcu >= 64) return;
    const int b = F.vcu >> 3, h = (F.vcu >> 1) & 3, dir = F.vcu & 1;
    LAS float* Gs = (LAS float*)(F.lds + RING_OFF); LAS float* Qs = Gs + 2048; LAS float* Ks = Qs + 2048;
    const float* up = dir ? F.up_b : F.up_f; const float* bias = dir ? F.bias_b : F.bias_f;
    const int tt = F.tid >> 5, d0 = (F.tid & 31) * 4;
    const int col = 32 * F.wave + (F.lane & 31), hf = F.lane >> 5;
    bf16* O = dir ? F.OB : F.OF;
    float S[64];
#pragma unroll
    for (int i = 0; i < 64; ++i) S[i] = 0.f;
    for (int tile = 0; tile < SEQ / 16; ++tile) {
        {
            const int i = tile * 16 + tt, t = dir ? (SEQ - 1 - i) : i; const size_t row = (size_t)b * SEQ + t;
            const f32x4* lrp = (const f32x4*)(F.LR + row * 32 + dir * 16);
            f32x4 z = *(const f32x4*)(bias + h * 128 + d0);
#pragma unroll
            for (int r4 = 0; r4 < 4; ++r4) { const f32x4 l = lrp[r4];
#pragma unroll
                for (int e = 0; e < 4; ++e) { const f32x4 u = *(const f32x4*)(up + (size_t)(4 * r4 + e) * 512 + h * 128 + d0); z += u * l[e]; } }
            f32x4 g;
#pragma unroll
            for (int e = 0; e < 4; ++e) g[e] = expf(fmaxf(logsig(z[e]) * (1.f / 16.f), -0.5f));
            const u32x2 qw = *(const u32x2*)(F.QG + row * 512 + h * 128 + d0), kw = *(const u32x2*)(F.KG + row * 512 + h * 128 + d0);
            *(LAS f32x4*)(Gs + tt * 128 + d0) = g;
            *(LAS f32x4*)(Qs + tt * 128 + d0) = (f32x4){bflo(qw.x), bfhi(qw.x), bflo(qw.y), bfhi(qw.y)};
            *(LAS f32x4*)(Ks + tt * 128 + d0) = (f32x4){bflo(kw.x), bfhi(kw.x), bflo(kw.y), bfhi(kw.y)};
        }
        __syncthreads();
        for (int t2 = 0; t2 < 16; ++t2) {
            const int i = tile * 16 + t2, t = dir ? (SEQ - 1 - i) : i; const size_t row = (size_t)b * SEQ + t;
            const float v = bf1(F.VG[row * 1024 + h * 256 + col]);
            float o = 0.f;
#pragma unroll
            for (int dd = 0; dd < 64; dd += 4) {
                const f32x4 g4 = *(const LAS f32x4*)(Gs + t2 * 128 + 64 * hf + dd), q4 = *(const LAS f32x4*)(Qs + t2 * 128 + 64 * hf + dd), k4 = *(const LAS f32x4*)(Ks + t2 * 128 + 64 * hf + dd);
#pragma unroll
                for (int e = 0; e < 4; ++e) { float s = S[dd + e] * g4[e];
                    if (dir == 0) { s = fmaf(k4[e], v, s); o = fmaf(q4[e], s, o); } else { o = fmaf(q4[e], s, o); s = fmaf(k4[e], v, s); }
                    S[dd + e] = s; }
            }
            o += __shfl_xor(o, 32);
            if (hf == 0) O[row * 1024 + h * 256 + col] = (bf16)f2bf(o);
        }
        __syncthreads();
    }
}
__device__ __forceinline__ void swa_naive(Frame& F) {
    LAS float* qs = (LAS float*)(F.lds + RING_OFF + 32768) + F.wave * 512; LAS float* ps = qs + 128;
    const int gw = F.vcu * NWAVES + F.wave, NGW = F.G * NWAVES, lane = F.lane;
    const int per = (BATCH * 8 * SEQ) / NGW;
    for (int j = 0; j < per; ++j) {
        const int it = gw * per + j, bh = it >> 12, i = it & (SEQ - 1), b = bh >> 3, hd = bh & 7, kvh = hd >> 2;
        const size_t rowb = (size_t)b * SEQ;
        bf16* qp = F.SQ + (rowb + i) * 1024 + hd * 128;
        { const unsigned w = *(const unsigned*)(qp + 2 * lane); qs[2 * lane] = bflo(w); qs[2 * lane + 1] = bfhi(w); }
        LDS_WAIT(); asm volatile("" ::: "memory");
        const int jlo = (i - 128 > 0) ? i - 128 : 0, jhi = (i + 128 < SEQ - 1) ? i + 128 : SEQ - 1;
        float s[5];
#pragma unroll
        for (int c = 0; c < 5; ++c) { const int jj = jlo + lane + 64 * c; const bool valid = jj <= jhi;
            const bf16* kp = F.SK + (rowb + (valid ? jj : jhi)) * 256 + kvh * 128; float a = 0.f;
#pragma unroll 4
            for (int ch = 0; ch < 16; ++ch) { const v4u w = *(const v4u*)(kp + 8 * ch); const f32x4 qa = *(const LAS f32x4*)(qs + 8 * ch), qb = *(const LAS f32x4*)(qs + 8 * ch + 4);
                a += (bflo(w.x) * qa[0] + bfhi(w.x) * qa[1]) + (bflo(w.y) * qa[2] + bfhi(w.y) * qa[3]) + (bflo(w.z) * qb[0] + bfhi(w.z) * qb[1]) + (bflo(w.w) * qb[2] + bfhi(w.w) * qb[3]); }
            s[c] = valid ? a : -INFINITY; }
        const float sink = F.sinks[hd];
        float mx = fmaxf(fmaxf(fmaxf(s[0], s[1]), fmaxf(s[2], s[3])), s[4]); mx = fmaxf(wave_max(mx), sink);
        float sum = 0.f;
#pragma unroll
        for (int c = 0; c < 5; ++c) { const float p = expf(s[c] - mx); ps[lane + 64 * c] = p; sum += p; }
        sum = wave_sum(sum) + expf(sink - mx);
        LDS_WAIT(); asm volatile("" ::: "memory");
        const int n = jhi - jlo + 1; float o0 = 0.f, o1 = 0.f;
        const bf16* vp = F.SV + (rowb + jlo) * 256 + kvh * 128 + 2 * lane;
        for (int jj = 0; jj < n; ++jj) { const float p = ps[jj]; const unsigned w = *(const unsigned*)(vp + (size_t)jj * 256); o0 = fmaf(p, bflo(w), o0); o1 = fmaf(p, bfhi(w), o1); }
        const float inv = 1.0f / sum;
        *(unsigned*)(qp + 2 * lane) = pk2(o0 * inv, o1 * inv);
        asm volatile("" ::: "memory");
    }
}
__device__ __forceinline__ void p2c_combine(Frame& F) {
    const int gw = F.vcu * NWAVES + F.wave, NGW = F.G * NWAVES, lane = F.lane;
    const f32x4 g = *((const f32x4*)F.g_gla + lane);
    for (int idx = gw; idx < M * 4; idx += NGW) {
        const size_t off = (size_t)idx * 256 + 4 * lane;
        const u32x2 a = *(const u32x2*)(F.OF + off), b2 = *(const u32x2*)(F.OB + off), r2 = *(const u32x2*)(F.R + off);
        const float o0 = bflo(a.x) + bflo(b2.x), o1 = bfhi(a.x) + bfhi(b2.x), o2 = bflo(a.y) + bflo(b2.y), o3 = bfhi(a.y) + bfhi(b2.y);
        const float rstd = 1.0f / sqrtf(wave_sum((o0 * o0 + o1 * o1) + (o2 * o2 + o3 * o3)) * (1.f / 256.f) + EPS);
        const float r0 = bflo(r2.x), r1 = bfhi(r2.x), r2_ = bflo(r2.y), r3 = bfhi(r2.y);
        u32x2 w; w.x = pk2(o0 * rstd * g[0] * r0 / (1.f + expf(-r0)), o1 * rstd * g[1] * r1 / (1.f + expf(-r1)));
        w.y = pk2(o2 * rstd * g[2] * r2_ / (1.f + expf(-r2_)), o3 * rstd * g[3] * r3 / (1.f + expf(-r3)));
        *(u32x2*)(F.R + off) = w;
    }
}

constexpr int N_PHASES = 10;
struct Args { const float* in[17]; float* out; unsigned char* ws; int ph_lo, ph_hi, use_bar, pad; };
__global__ void __launch_bounds__(NWAVES * 64, 2) mk_fwd(Args args) {
    extern __shared__ __attribute__((aligned(16))) unsigned char lds[];
    Frame F;
    F.lds = (LAS unsigned char*)lds;
    F.MISC = (volatile LAS unsigned*)(F.lds + MISC_OFF);
    F.tid = threadIdx.x; F.lane = F.tid & 63; F.wave = __builtin_amdgcn_readfirstlane(F.tid >> 6);
    F.G = gridDim.x; { const int bx = blockIdx.x; F.vcu = (F.G % 8 == 0) ? (bx % 8) * (F.G / 8) + bx / 8 : bx; }
    unsigned char* ws = args.ws;
    F.ctl = (gu32*)(ws + WS_CTL);
    F.x = args.in[0]; F.g_mix = args.in[1]; F.w_in = args.in[2]; F.up_f = args.in[3]; F.bias_f = args.in[4]; F.up_b = args.in[5]; F.bias_b = args.in[6]; F.g_gla = args.in[7];
    F.w_og = args.in[8]; F.g_q = args.in[9]; F.g_k = args.in[10]; F.sinks = args.in[11]; F.w_os = args.in[12]; F.w_out = args.in[13]; F.g_ffn = args.in[14]; F.w_fi = args.in[15]; F.w_fo = args.in[16];
    F.out = args.out;
    F.WIN = (bf16*)(ws + WS_WIN); F.WLR = (bf16*)(ws + WS_WLR); F.WG = (bf16*)(ws + WS_WG); F.WS_ = (bf16*)(ws + WS_WS); F.WOUT = (bf16*)(ws + WS_WOUT); F.WFI = (bf16*)(ws + WS_WFI); F.WFO = (bf16*)(ws + WS_WFO);
    F.ROPE = (float*)(ws + WS_ROPE); F.LR = (float*)(ws + WS_LR); F.SSQ = (float*)(ws + WS_SSQ);
    F.QG = (bf16*)(ws + WS_QG); F.KG = (bf16*)(ws + WS_KG); F.VG = (bf16*)(ws + WS_VG); F.R = (bf16*)(ws + WS_R); F.SQ = (bf16*)(ws + WS_SQ); F.SK = (bf16*)(ws + WS_SK); F.SV = (bf16*)(ws + WS_SV);
    F.GA = (bf16*)(ws + WS_GA); F.GB = (bf16*)(ws + WS_GB); F.MERGED = (bf16*)(ws + WS_MERGED); F.X1B = (bf16*)(ws + WS_X1B); F.H = (bf16*)(ws + WS_H);
    F.XN = (bf16*)args.out; F.OF = (bf16*)args.out; F.OB = (bf16*)args.out + (size_t)M * DM;
    for (int u = F.tid; u < (LDS_BYTES - LDSCTL_OFF) / 4; u += NWAVES * 64) ((LAS unsigned*)(F.lds + LDSCTL_OFF))[u] = 0u;
    __syncthreads();
    XcdBarrier bar; bar.bar = (unsigned*)(F.ctl + CW_BAR); bar.x = 0; bar.st = nullptr;
    if (args.use_bar) bar = xcd_barrier_post((unsigned*)(F.ctl + CW_BAR), F.MISC + 8);
    const int lo = args.ph_lo, hi = args.ph_hi;
#define IN(k) (lo <= (k) && (k) < hi)
#define SEAM(k) do { if (IN(k) && IN((k) + 1)) xcd_barrier(bar); } while (0)

    if (IN(0)) { p0_prologue(F); } SEAM(0);
    if (IN(1)) {
        p1_lr(F);
        pg8::Gemm g{F.XN, F.WIN, M, NPROJ, DM}; pg8::StaticOrder S; S.init(M, NPROJ, F.G, (int)blockIdx.x);
        pg8::EpiProj E{F.QG, F.KG, F.VG, F.R, F.SQ, F.SK, F.SV, F.GA, F.GB};
        pg8::gemm_phase<pg8::EpiProj, pg8::StaticOrder, true, true>(F.lds + RING_OFF, g, S, E);
    } SEAM(1);
    if (IN(2)) { p1b_qknorm_rope(F); } SEAM(2);
    if (IN(3)) { gla_naive(F); __syncthreads(); swa_naive(F); } SEAM(3);
    if (IN(4)) { p2c_combine(F); } SEAM(4);
    if (IN(5)) {
        pg8::Gemm g{F.R, F.WG, M, DM, DM}; pg8::StaticOrder S; S.init(M, DM, F.G, (int)blockIdx.x);
        pg8::EpiGateF32 E{F.GA, F.out};
        pg8::gemm_phase<pg8::EpiGateF32, pg8::StaticOrder, true, true>(F.lds + RING_OFF, g, S, E);
    } SEAM(5);
    if (IN(6)) {
        pg8::Gemm g{F.SQ, F.WS_, M, DM, DM}; pg8::StaticOrder S; S.init(M, DM, F.G, (int)blockIdx.x);
        pg8::EpiMerge E{F.GB, F.out, F.MERGED};
        pg8::gemm_phase<pg8::EpiMerge, pg8::StaticOrder, true, true>(F.lds + RING_OFF, g, S, E);
    } SEAM(6);
    if (IN(7)) {
        pg8::Gemm g{F.MERGED, F.WOUT, M, DM, DM}; pg8::StaticOrder S; S.init(M, DM, F.G, (int)blockIdx.x);
        pg8::EpiX1 E{F.x, F.out, F.X1B, F.SSQ};
        pg8::gemm_phase<pg8::EpiX1, pg8::StaticOrder, true, true>(F.lds + RING_OFF, g, S, E);
    } SEAM(7);
    if (IN(8)) {
        pg8::Gemm g{F.X1B, F.WFI, M, 2 * DFF, DM}; pg8::StaticOrder S; S.init(M, 2 * DFF, F.G, (int)blockIdx.x);
        pg8::EpiSwiGLU E{F.SSQ, F.H};
        pg8::gemm_phase<pg8::EpiSwiGLU, pg8::StaticOrder, true, true>(F.lds + RING_OFF, g, S, E);
    } SEAM(8);
    if (IN(9)) {
        pg8::Gemm g{F.H, F.WFO, M, DM, DFF}; pg8::StaticOrder S; S.init(M, DM, F.G, (int)blockIdx.x);
        pg8::EpiResid E{F.out};
        pg8::gemm_phase<pg8::EpiResid, pg8::StaticOrder, true, true>(F.lds + RING_OFF, g, S, E);
    }
#undef IN
#undef SEAM
}

#ifndef MK_ONE_LAUNCH
#define MK_ONE_LAUNCH 1
#endif
extern "C" void kernel_launch(void* const* d_in, const int* in_sizes, int n_in, void* d_out, int out_size, void* d_ws, size_t ws_size, hipStream_t stream) {
    static int grid = 0;
    if (grid == 0) {
        if (n_in != 17 || in_sizes[0] != M * DM || out_size != M * DM || ws_size < WS_END) { fprintf(stderr, "kernel_launch: shape/workspace mismatch (n_in %d, in0 %d, out %d, ws %zu); nothing launched\n", n_in, n_in > 0 ? in_sizes[0] : -1, out_size, ws_size); grid = -1; return; }
        int dev = 0, cus = 0;
        if (hipGetDevice(&dev) != hipSuccess || hipDeviceGetAttribute(&cus, hipDeviceAttributeMultiprocessorCount, dev) != hipSuccess) { grid = -1; return; }
        if (hipFuncSetAttribute((const void*)mk_fwd, hipFuncAttributeMaxDynamicSharedMemorySize, LDS_BYTES) != hipSuccess) { fprintf(stderr, "kernel_launch: hipFuncSetAttribute failed\n"); grid = -1; return; }
        (void)hipGetLastError();
        grid = cus;
        if (grid != 256) fprintf(stderr, "kernel_launch: %d CUs; built for 256\n", grid);
    }
    if (grid < 0) return;
    (void)hipMemsetAsync((char*)d_ws + WS_CTL, 0, CTL_ZERO_BYTES, stream);
    Args a{};
    for (int i = 0; i < 17; ++i) a.in[i] = (const float*)d_in[i];
    a.out = (float*)d_out; a.ws = (unsigned char*)d_ws;
#if MK_ONE_LAUNCH
    a.ph_lo = 0; a.ph_hi = N_PHASES; a.use_bar = 1;
    hipLaunchKernelGGL(mk_fwd, dim3(grid), dim3(NWAVES * 64), LDS_BYTES, stream, a);
#else
    for (int p = 0; p < N_PHASES; ++p) { a.ph_lo = p; a.ph_hi = p + 1; a.use_bar = 0; hipLaunchKernelGGL(mk_fwd, dim3(grid), dim3(NWAVES * 64), LDS_BYTES, stream, a); }
#endif
}
```

```cpp
#include <hip/hip_runtime.h>
#include <cstdio>
#include <cstdint>
#include <cmath>
namespace pg8 {
#define PG8_LAS __attribute__((address_space(3)))
typedef unsigned short bf16_t;
typedef short bf16x8 __attribute__((ext_vector_type(8)));
typedef float f32x4 __attribute__((ext_vector_type(4)));
typedef unsigned u32x4 __attribute__((ext_vector_type(4)));
constexpr int BM = 256, BK = 64, HALF = 128, HTB = HALF * BK * 2  , STAGE_BYTES = 8 * HTB, NXCD = 8, WGM = 8;

__host__ __device__ __forceinline__ int lds_byte(int r, int c) { const int st = (r >> 4) * 2 + (c >> 5), rr = r & 15, cc = c & 31, ob = rr * 64 + cc * 2; return st * 1024 + (ob ^ (((ob >> 9) & 1) << 5)); }
__host__ __device__ __forceinline__ void stage_rc(int b, int& R, int& C) { const int st = b / 1024, sb = b % 1024, swz = sb ^ (((sb >> 9) & 1) << 5); R = (st >> 1) * 16 + swz / 64; C = (st & 1) * 32 + (swz % 64) / 2; }
__host__ __device__ __forceinline__ int perm32(int rho) { const int n = rho >> 4, i = rho & 15; return 8 * (i >> 2) + 4 * n + (i & 3); }

template <class E> struct epi_has_post { static constexpr bool v = false; };
struct Unit { int pm, pn; };
struct Gemm { const bf16_t* A; const bf16_t* Bt; int M, N, K; const bf16_t* A2 = nullptr; const bf16_t* Bt2 = nullptr; };

struct StaticOrder {
    int nM, nN, nwg, G, c;
    __host__ __device__ void init(int M, int N, int G_, int c_) { nM = M / BM; nN = N / BM; nwg = nM * nN; G = G_; c = c_; }
    __host__ __device__ bool next(int i, Unit& u) const {
        const long L = (long)i * G + c; if (L >= nwg) return false;
        int wgid = (int)L; { const int q = nwg / NXCD, r = nwg % NXCD, xcd = wgid % NXCD, off = wgid / NXCD; wgid = (xcd < r ? xcd * (q + 1) : r * (q + 1) + (xcd - r) * q) + off; }
        const int nig = WGM * nN, gid = wgid / nig, fm = gid * WGM, gsz = (nM - fm) < WGM ? (nM - fm) : WGM;
        u.pm = fm + ((wgid % nig) % gsz); u.pn = (wgid % nig) / gsz; return true;
    }
    __device__ __forceinline__ void a_ready(const Unit&) const {}
    __device__ __forceinline__ void done(const Unit&) const {}
};

__device__ __forceinline__ unsigned cvt_pk_bf16(float lo, float hi) { unsigned r; asm volatile("v_cvt_pk_bf16_f32 %0, %1, %2" : "=v"(r) : "v"(lo), "v"(hi)); return r; }
typedef float f32x2 __attribute__((ext_vector_type(2)));
typedef unsigned u32x2 __attribute__((ext_vector_type(2)));
__device__ __forceinline__ float bflo(unsigned w) { return __uint_as_float(w << 16); }
__device__ __forceinline__ float bfhi(unsigned w) { return __uint_as_float(w & 0xffff0000u); }
__device__ __forceinline__ float sigm(float x) { return __builtin_amdgcn_rcpf(1.0f + __builtin_amdgcn_exp2f(-1.4426950408889634f * x)); }

struct EpiProj {
    static constexpr bool PERM = true, AFTER_DRAIN = false;
    static constexpr size_t MB = 1u << 20, O_QG = 48 * MB, O_KG = 80 * MB, O_VG = 112 * MB, O_R = 176 * MB, O_SQ = 240 * MB, O_SK = 304 * MB, O_SV = 320 * MB, O_GA = 336 * MB, O_GB = 400 * MB;
    unsigned char* ws; int skip;
    __device__ __forceinline__ void operator()(const f32x4 (&acc)[2][2][4][2], const Unit& u, int wr, int wc, int fr, int fq) const { part(acc, u, wr, wc, fr, fq, 0); part(acc, u, wr, wc, fr, fq, 1); }
    __device__ __forceinline__ void part(const f32x4 (&acc)[2][2][4][2], const Unit& u, int wr, int wc, int fr, int fq, const int ai) const {
        if (skip) { asm volatile("" :: "v"(acc[0][0][0][0]), "v"(acc[1][1][3][1])); return; }
        const int pn = u.pn; size_t off; int ldc, ct; float sc = 1.f;
        if (pn < 2) { off = O_QG; ldc = 512; ct = pn * 256; sc = 0.08838834764831845f; }
        else if (pn < 4) { off = O_KG; ldc = 512; ct = (pn - 2) * 256; }
        else if (pn < 8) { off = O_VG; ldc = 1024; ct = (pn - 4) * 256; }
        else if (pn < 12) { off = O_R; ldc = 1024; ct = (pn - 8) * 256; }
        else if (pn < 16) { off = O_SQ; ldc = 1024; ct = (pn - 12) * 256; }
        else if (pn == 16) { off = O_SK; ldc = 256; ct = 0; }
        else if (pn == 17) { off = O_SV; ldc = 256; ct = 0; }
        else if (pn < 22) { off = O_GA; ldc = 1024; ct = (pn - 18) * 256; }
        else { off = O_GB; ldc = 1024; ct = (pn - 22) * 256; }
        bf16_t* base = (bf16_t*)(ws + off);
        const int row0 = u.pm * BM + wr * 64 + fr, col0 = ct + wc * 32 + 8 * fq;
#pragma unroll
            for (int m = 0; m < 4; ++m) { bf16_t* rowp = base + (size_t)(row0 + ai * HALF + m * 16) * ldc + col0;
#pragma unroll
                for (int bj = 0; bj < 2; ++bj) { const f32x4 v0 = acc[ai][bj][m][0] * sc, v1 = acc[ai][bj][m][1] * sc;
                    u32x4 w; w.x = cvt_pk_bf16(v0[0], v0[1]); w.y = cvt_pk_bf16(v0[2], v0[3]); w.z = cvt_pk_bf16(v1[0], v1[1]); w.w = cvt_pk_bf16(v1[2], v1[3]);
                    *(u32x4*)(rowp + bj * HALF) = w; } }
    }
};
struct QkPost {
    bf16_t *SQ, *SK; const float *rope, *g_q, *g_k; float qsc;
    __device__ __forceinline__ void post(const Unit& u, int tid) const {
        const int wave = tid >> 6, lane = tid & 63, slot = lane >> 3, c = lane & 7; const bool isq = u.pn < 16;
        bf16_t* base = isq ? SQ + (size_t)(u.pn - 12) * 256 : SK; const int ldc = isq ? 1024 : 256; const float* gn = isq ? g_q : g_k; const float sc = isq ? qsc : 1.f;
        const f32x4 g10 = *(const f32x4*)(gn + 8 * c), g11 = *(const f32x4*)(gn + 8 * c + 4), g20 = *(const f32x4*)(gn + 64 + 8 * c), g21 = *(const f32x4*)(gn + 64 + 8 * c + 4);
#pragma unroll 1
        for (int rd = 0; rd < 2; ++rd) {
            u32x4 a1[4], a2[4]; f32x4 cs[4][4]; bf16_t* pp[4];
#pragma unroll
            for (int q = 0; q < 4; ++q) { const int idx = ((rd * 4 + q) * 8 + wave) * 8 + slot, row = u.pm * BM + (idx >> 1), pos = row & 4095;
                pp[q] = base + (size_t)row * ldc + (idx & 1) * 128; a1[q] = *(const u32x4*)(pp[q] + 8 * c); a2[q] = *(const u32x4*)(pp[q] + 64 + 8 * c);
                const f32x4* rp = (const f32x4*)(rope + 2 * (pos * 64 + 8 * c));
#pragma unroll
                for (int j = 0; j < 4; ++j) cs[q][j] = rp[j]; }
#pragma unroll
            for (int q = 0; q < 4; ++q) { float x1[8], x2[8];
                x1[0] = bflo(a1[q].x); x1[1] = bfhi(a1[q].x); x1[2] = bflo(a1[q].y); x1[3] = bfhi(a1[q].y); x1[4] = bflo(a1[q].z); x1[5] = bfhi(a1[q].z); x1[6] = bflo(a1[q].w); x1[7] = bfhi(a1[q].w);
                x2[0] = bflo(a2[q].x); x2[1] = bfhi(a2[q].x); x2[2] = bflo(a2[q].y); x2[3] = bfhi(a2[q].y); x2[4] = bflo(a2[q].z); x2[5] = bfhi(a2[q].z); x2[6] = bflo(a2[q].w); x2[7] = bfhi(a2[q].w);
                float ss = 0.f;
#pragma unroll
                for (int e = 0; e < 8; ++e) ss += x1[e] * x1[e] + x2[e] * x2[e];
                ss += __shfl_xor(ss, 1); ss += __shfl_xor(ss, 2); ss += __shfl_xor(ss, 4);
                const float rstd = sc * __builtin_amdgcn_rsqf(ss * (1.f / 128.f) + 1e-6f);
                float o1[8], o2[8];
#pragma unroll
                for (int e = 0; e < 8; ++e) { const float y1 = x1[e] * rstd * (e < 4 ? g10[e & 3] : g11[e & 3]), y2 = x2[e] * rstd * (e < 4 ? g20[e & 3] : g21[e & 3]);
                    const float cc = cs[q][e >> 1][2 * (e & 1)], sn = cs[q][e >> 1][2 * (e & 1) + 1]; o1[e] = y1 * cc - y2 * sn; o2[e] = y2 * cc + y1 * sn; }
                u32x4 w1, w2; w1.x = cvt_pk_bf16(o1[0], o1[1]); w1.y = cvt_pk_bf16(o1[2], o1[3]); w1.z = cvt_pk_bf16(o1[4], o1[5]); w1.w = cvt_pk_bf16(o1[6], o1[7]);
                w2.x = cvt_pk_bf16(o2[0], o2[1]); w2.y = cvt_pk_bf16(o2[2], o2[3]); w2.z = cvt_pk_bf16(o2[4], o2[5]); w2.w = cvt_pk_bf16(o2[6], o2[7]);
                *(u32x4*)(pp[q] + 8 * c) = w1; *(u32x4*)(pp[q] + 64 + 8 * c) = w2; }
        }
    }
};
struct EpiMerge2 {
    static constexpr bool PERM = true, AFTER_DRAIN = false;
    const bf16_t* ga; const bf16_t* gb; bf16_t* out;
    __device__ __forceinline__ void mid(f32x4 (&acc)[2][2][4][2], const Unit& u, int wr, int wc, int fr, int fq) const {
        int row0 = u.pm * BM + wr * 64 + fr, col0 = u.pn * BM + wc * 32 + 8 * fq; asm volatile("" : "+v"(row0), "+v"(col0));
#pragma unroll
        for (int ai = 0; ai < 2; ++ai)
#pragma unroll
            for (int m = 0; m < 4; ++m) { const size_t off = (size_t)(row0 + ai * HALF + m * 16) * 1024 + col0;
#pragma unroll
                for (int bj = 0; bj < 2; ++bj) { const size_t o2 = off + bj * HALF; const u32x4 a = *(const u32x4*)(ga + o2), b = *(const u32x4*)(gb + o2);
#define PG8_RATIO(aw, bw) ((1.0f + __builtin_amdgcn_exp2f(-1.4426950408889634f * (bw))) * __builtin_amdgcn_rcpf(1.0f + __builtin_amdgcn_exp2f(-1.4426950408889634f * (aw))))
                    acc[ai][bj][m][0][0] *= PG8_RATIO(bflo(a.x), bflo(b.x)); acc[ai][bj][m][0][1] *= PG8_RATIO(bfhi(a.x), bfhi(b.x)); acc[ai][bj][m][0][2] *= PG8_RATIO(bflo(a.y), bflo(b.y)); acc[ai][bj][m][0][3] *= PG8_RATIO(bfhi(a.y), bfhi(b.y));
                    acc[ai][bj][m][1][0] *= PG8_RATIO(bflo(a.z), bflo(b.z)); acc[ai][bj][m][1][1] *= PG8_RATIO(bfhi(a.z), bfhi(b.z)); acc[ai][bj][m][1][2] *= PG8_RATIO(bflo(a.w), bflo(b.w)); acc[ai][bj][m][1][3] *= PG8_RATIO(bfhi(a.w), bfhi(b.w));
#undef PG8_RATIO
                }
                if (m & 1) asm volatile("" ::: "memory"); }
    }
    __device__ __forceinline__ void operator()(const f32x4 (&acc)[2][2][4][2], const Unit& u, int wr, int wc, int fr, int fq) const {
        int row0 = u.pm * BM + wr * 64 + fr, col0 = u.pn * BM + wc * 32 + 8 * fq; asm volatile("" : "+v"(row0), "+v"(col0));
#pragma unroll
        for (int ai = 0; ai < 2; ++ai)
#pragma unroll
            for (int m = 0; m < 4; ++m) { const size_t off = (size_t)(row0 + ai * HALF + m * 16) * 1024 + col0;
#pragma unroll
                for (int bj = 0; bj < 2; ++bj) { const size_t o2 = off + bj * HALF; const u32x4 g = *(const u32x4*)(gb + o2);
                    const f32x4 a0 = acc[ai][bj][m][0], a1 = acc[ai][bj][m][1];
                    u32x4 w; w.x = cvt_pk_bf16(a0[0] * sigm(bflo(g.x)), a0[1] * sigm(bfhi(g.x))); w.y = cvt_pk_bf16(a0[2] * sigm(bflo(g.y)), a0[3] * sigm(bfhi(g.y)));
                    w.z = cvt_pk_bf16(a1[0] * sigm(bflo(g.z)), a1[1] * sigm(bfhi(g.z))); w.w = cvt_pk_bf16(a1[2] * sigm(bflo(g.w)), a1[3] * sigm(bfhi(g.w)));
                    *(u32x4*)(out + o2) = w; } }
    }
};
struct EpiX1 {
    static constexpr bool PERM = true, AFTER_DRAIN = false;
    const float* x; bf16_t* xb; float* ssq;
    __device__ __forceinline__ void operator()(const f32x4 (&acc)[2][2][4][2], const Unit& u, int wr, int wc, int fr, int fq) const {
        const int row0 = u.pm * BM + wr * 64 + fr, col0 = u.pn * BM + wc * 32 + 8 * fq;
#pragma unroll
        for (int ai = 0; ai < 2; ++ai)
#pragma unroll
            for (int m = 0; m < 4; ++m) { const int row = row0 + ai * HALF + m * 16; const size_t off = (size_t)row * 1024 + col0; float s = 0.f;
#pragma unroll
                for (int bj = 0; bj < 2; ++bj) { const size_t o2 = off + bj * HALF;
                    const f32x4 v0 = *(const f32x4*)(x + o2) + acc[ai][bj][m][0], v1 = *(const f32x4*)(x + o2 + 4) + acc[ai][bj][m][1];
                    s += ((v0[0] * v0[0] + v0[1] * v0[1]) + (v0[2] * v0[2] + v0[3] * v0[3])) + ((v1[0] * v1[0] + v1[1] * v1[1]) + (v1[2] * v1[2] + v1[3] * v1[3]));
                    u32x4 w; w.x = cvt_pk_bf16(v0[0], v0[1]); w.y = cvt_pk_bf16(v0[2], v0[3]); w.z = cvt_pk_bf16(v1[0], v1[1]); w.w = cvt_pk_bf16(v1[2], v1[3]); *(u32x4*)(xb + o2) = w; }
                s += __shfl_xor(s, 16); s += __shfl_xor(s, 32);
                if (fq == 0) ssq[(size_t)row * 16 + u.pn * 4 + wc] = s; }
    }
};
struct EpiSwiGLU {
    static constexpr bool PERM = true, AFTER_DRAIN = false;
    const float* ssq; bf16_t* H;
    __device__ __forceinline__ void operator()(const f32x4 (&acc)[2][2][4][2], const Unit& u, int wr, int wc, int fr, int fq) const {
        const int row0 = u.pm * BM + wr * 64 + fr, col0 = u.pn * HALF + wc * 32 + 8 * fq;
#pragma unroll
        for (int ai = 0; ai < 2; ++ai)
#pragma unroll
            for (int m = 0; m < 4; ++m) { const int row = row0 + ai * HALF + m * 16; const f32x4* sp = (const f32x4*)(ssq + (size_t)row * 16);
                const f32x4 s0 = sp[0], s1 = sp[1], s2 = sp[2], s3 = sp[3]; const f32x4 st = (s0 + s1) + (s2 + s3);
                const float rstd = __builtin_amdgcn_rsqf(((st[0] + st[1]) + (st[2] + st[3])) * (1.0f / 1024.0f) + 1e-6f);
                float hv[8];
#pragma unroll
                for (int n = 0; n < 2; ++n)
#pragma unroll
                    for (int e = 0; e < 4; ++e) { const float g = acc[ai][0][m][n][e] * rstd, up = acc[ai][1][m][n][e] * rstd; hv[4 * n + e] = g * sigm(g) * up; }
                u32x4 w; w.x = cvt_pk_bf16(hv[0], hv[1]); w.y = cvt_pk_bf16(hv[2], hv[3]); w.z = cvt_pk_bf16(hv[4], hv[5]); w.w = cvt_pk_bf16(hv[6], hv[7]);
                *(u32x4*)(H + (size_t)row * 2816 + col0) = w; }
    }
};
struct EpiResid {
    static constexpr bool PERM = true, AFTER_DRAIN = false;
    const bf16_t* xb; float* out;
    __device__ __forceinline__ void operator()(const f32x4 (&acc)[2][2][4][2], const Unit& u, int wr, int wc, int fr, int fq) const {
        const int row0 = u.pm * BM + wr * 64 + fr, col0 = u.pn * BM + wc * 32 + 8 * fq;
#pragma unroll
        for (int ai = 0; ai < 2; ++ai)
#pragma unroll
            for (int m = 0; m < 4; ++m) { const size_t off = (size_t)(row0 + ai * HALF + m * 16) * 1024 + col0;
#pragma unroll
                for (int bj = 0; bj < 2; ++bj) { const size_t o2 = off + bj * HALF; const u32x4 xw = *(const u32x4*)(xb + o2);
                    *(f32x4*)(out + o2) = (f32x4){bflo(xw.x), bfhi(xw.x), bflo(xw.y), bfhi(xw.y)} + acc[ai][bj][m][0];
                    *(f32x4*)(out + o2 + 4) = (f32x4){bflo(xw.z), bfhi(xw.z), bflo(xw.w), bfhi(xw.w)} + acc[ai][bj][m][1]; } }
    }
};

template <class Epi, class Sched, bool ALIGN_EPI = false, bool SP2 = false, bool DUAL = false, bool SPLIT_EPI = false>
__device__ __forceinline__ void gemm_phase(PG8_LAS unsigned char* lds, const Gemm g, const Sched& S, const Epi& E) {
    const int tid = threadIdx.x, wid = __builtin_amdgcn_readfirstlane(tid >> 6), lane = tid & 63, wr = wid >> 2, wc = wid & 3, fr = lane & 15, fq = lane >> 4;
    const int K = g.K, TS = K / BK, nt = DUAL ? 2 * TS : TS;
    unsigned voffA[2], voffB[2];
#pragma unroll
    for (int i = 0; i < 2; ++i) { int R, C; stage_rc(tid * 16 + i * 8192, R, C); const int Rb = Epi::PERM ? ((R & ~31) + perm32(R & 31)) : R;
        voffA[i] = (unsigned)(R * K + C) * 2u; voffB[i] = (unsigned)(Rb * K + C) * 2u; }
    const size_t kstep = (size_t)(BK * 2);
    const size_t hstep = (size_t)HALF * K * 2;
    const size_t tstep = 2 * hstep;
    const unsigned ldsw = (unsigned)wid * 1024u;
    const int aoff = lds_byte(wr * 64 + fr, fq * 8), boff = lds_byte(wc * 32 + fr, fq * 8);
#define PG8_SA(b, h) (((b) * 2 + (h)) * HTB)
#define PG8_SB(b, h) ((4 + (b) * 2 + (h)) * HTB)
#define PG8_STAGE(bufoff, gbase, voff) do { _Pragma("unroll") for (int _i = 0; _i < 2; ++_i) \
        __builtin_amdgcn_global_load_lds((const unsigned*)((const char*)(gbase) + (voff)[_i]), (PG8_LAS unsigned*)(lds + (bufoff) + ldsw + _i * 8192), 16, 0, 0); } while (0)
#define PG8_LDA(dst, b, h) do { _Pragma("unroll") for (int m = 0; m < 4; ++m) _Pragma("unroll") for (int k = 0; k < 2; ++k) dst[m][k] = *(const PG8_LAS bf16x8*)(lds + PG8_SA(b, h) + aoff + m * 2048 + k * 1024); } while (0)
#define PG8_LDB(dst, b, h) do { _Pragma("unroll") for (int n = 0; n < 2; ++n) _Pragma("unroll") for (int k = 0; k < 2; ++k) dst[n][k] = *(const PG8_LAS bf16x8*)(lds + PG8_SB(b, h) + boff + n * 2048 + k * 1024); } while (0)
#define PG8_MMA(ai, bj, At, Bt) do { __builtin_amdgcn_s_setprio(1); _Pragma("unroll") for (int m = 0; m < 4; ++m) _Pragma("unroll") for (int n = 0; n < 2; ++n) _Pragma("unroll") for (int k = 0; k < 2; ++k) \
        acc[ai][bj][m][n] = __builtin_amdgcn_mfma_f32_16x16x32_bf16(Bt[n][k], At[m][k], acc[ai][bj][m][n], 0, 0, 0); __builtin_amdgcn_s_setprio(0); } while (0)
#define PG8_WAIT_V(n) asm volatile("s_waitcnt vmcnt(" #n ")" ::: "memory")
#define PG8_WAIT_L(n) asm volatile("s_waitcnt lgkmcnt(" #n ")" ::: "memory")
#define PG8_BAR __builtin_amdgcn_s_barrier()
#define PG8_SCHED __builtin_amdgcn_sched_barrier(0)
    Unit cur, nxt, prev; int ui = 0; bool have_prev = false; (void)prev; (void)have_prev;
    static_assert(!SPLIT_EPI || (SP2 && !ALIGN_EPI && !DUAL && !Epi::AFTER_DRAIN), "SPLIT_EPI geometry");
    if (!S.next(0, cur)) return;
    f32x4 acc[2][2][4][2];
#pragma unroll
    for (int a = 0; a < 2; ++a)
#pragma unroll
        for (int b = 0; b < 2; ++b)
#pragma unroll
            for (int m = 0; m < 4; ++m)
#pragma unroll
                for (int n = 0; n < 2; ++n) acc[a][b][m][n] = (f32x4){0.f, 0.f, 0.f, 0.f};
    bf16x8 At[4][2], B0[2][2], B1[2][2];
    const char* cA = (const char*)g.A + (size_t)cur.pm * tstep; const char* cB = (const char*)g.Bt + (size_t)cur.pn * tstep;
    const char* cA2 = DUAL ? (const char*)g.A2 + (size_t)cur.pm * tstep - (size_t)TS * kstep : cA; const char* cB2 = DUAL ? (const char*)g.Bt2 + (size_t)cur.pn * tstep - (size_t)TS * kstep : cB;
    S.a_ready(cur);
    if constexpr (SP2) {
        PG8_STAGE(PG8_SB(0, 0), cB, voffB); PG8_STAGE(PG8_SB(0, 1), cB + hstep, voffB); PG8_STAGE(PG8_SA(0, 0), cA, voffA); PG8_STAGE(PG8_SA(0, 1), cA + hstep, voffA);
        if (wr == 1) PG8_BAR;
        PG8_WAIT_V(2); PG8_BAR;
        PG8_STAGE(PG8_SB(1, 0), cB + kstep, voffB); PG8_STAGE(PG8_SA(1, 0), cA + kstep, voffA); PG8_STAGE(PG8_SB(1, 1), cB + hstep + kstep, voffB);
        PG8_WAIT_V(6); PG8_BAR;
    } else {
        PG8_STAGE(PG8_SB(0, 0), cB, voffB); PG8_STAGE(PG8_SA(0, 0), cA, voffA); PG8_STAGE(PG8_SB(0, 1), cB + hstep, voffB); PG8_STAGE(PG8_SA(0, 1), cA + hstep, voffA);
        if (wr == 1) PG8_BAR;
        PG8_WAIT_V(4); PG8_BAR;
        PG8_STAGE(PG8_SB(1, 0), cB + kstep, voffB); PG8_STAGE(PG8_SA(1, 0), cA + kstep, voffA); PG8_STAGE(PG8_SB(1, 1), cB + hstep + kstep, voffB);
        PG8_WAIT_V(6); PG8_BAR;
    }
    for (;;) {
        const bool has_next = S.next(ui + 1, nxt);
        const char* nA = has_next ? (const char*)g.A + (size_t)nxt.pm * tstep : cA; const char* nB = has_next ? (const char*)g.Bt + (size_t)nxt.pn * tstep : cB;
        const char* nA2 = (DUAL && has_next) ? (const char*)g.A2 + (size_t)nxt.pm * tstep - (size_t)TS * kstep : cA2; const char* nB2 = (DUAL && has_next) ? (const char*)g.Bt2 + (size_t)nxt.pn * tstep - (size_t)TS * kstep : cB2;
#pragma unroll
        for (int seg = 0; seg < (DUAL ? 2 : 1); ++seg) {
        if constexpr (DUAL) { if (seg == 1) E.mid(acc, cur, wr, wc, fr, fq); }
        for (int t = (seg ? TS : 0); t < ((DUAL && seg == 0) ? TS : nt); t += 2) {
            const bool last = (t == nt - 2);
            const char* a1 = ((DUAL && t + 1 >= TS) ? cA2 : cA) + (size_t)(t + 1) * kstep;
            const char* a2 = last ? nA : ((DUAL && t + 2 >= TS) ? cA2 : cA) + (size_t)(t + 2) * kstep; const char* b2 = last ? nB : ((DUAL && t + 2 >= TS) ? cB2 : cB) + (size_t)(t + 2) * kstep;
            const char* a3 = a2 + kstep; const char* b3 = b2 + kstep;
            if (last && has_next) S.a_ready(nxt);
            if constexpr (SP2) {
            PG8_LDB(B0, 0, 0); PG8_LDB(B1, 0, 1); PG8_SCHED; PG8_LDA(At, 0, 0); PG8_STAGE(PG8_SA(1, 1), a1 + hstep, voffA);
            PG8_WAIT_V(8); PG8_WAIT_L(0); PG8_BAR;
            if constexpr (SPLIT_EPI) { if (t == 0 && have_prev) { E.part(acc, prev, wr, wc, fr, fq, 1);
                _Pragma("unroll") for (int b_ = 0; b_ < 2; ++b_) _Pragma("unroll") for (int m_ = 0; m_ < 4; ++m_) _Pragma("unroll") for (int n_ = 0; n_ < 2; ++n_) acc[1][b_][m_][n_] = (f32x4){0.f, 0.f, 0.f, 0.f}; } }
            PG8_MMA(0, 0, At, B0); PG8_MMA(0, 1, At, B1); PG8_BAR; PG8_SCHED;
            PG8_LDA(At, 0, 1); PG8_STAGE(PG8_SB(0, 0), b2, voffB); PG8_STAGE(PG8_SB(0, 1), b2 + hstep, voffB); PG8_STAGE(PG8_SA(0, 0), a2, voffA);
            PG8_WAIT_V(8); PG8_WAIT_L(0); PG8_BAR; PG8_MMA(1, 0, At, B0); PG8_MMA(1, 1, At, B1); PG8_BAR; PG8_SCHED;
            PG8_LDB(B0, 1, 0); PG8_LDB(B1, 1, 1); PG8_SCHED; PG8_LDA(At, 1, 0); PG8_STAGE(PG8_SA(0, 1), a2 + hstep, voffA);
            PG8_WAIT_V(8); PG8_WAIT_L(0); PG8_BAR; PG8_MMA(0, 0, At, B0); PG8_MMA(0, 1, At, B1); PG8_BAR; PG8_SCHED;
            PG8_LDA(At, 1, 1); PG8_STAGE(PG8_SB(1, 0), b3, voffB); PG8_STAGE(PG8_SB(1, 1), b3 + hstep, voffB); PG8_STAGE(PG8_SA(1, 0), a3, voffA);
            PG8_WAIT_V(8); PG8_WAIT_L(0); PG8_BAR;
            if constexpr (SPLIT_EPI) { if (last) { E.part(acc, cur, wr, wc, fr, fq, 0);
                _Pragma("unroll") for (int b_ = 0; b_ < 2; ++b_) _Pragma("unroll") for (int m_ = 0; m_ < 4; ++m_) _Pragma("unroll") for (int n_ = 0; n_ < 2; ++n_) acc[0][b_][m_][n_] = (f32x4){0.f, 0.f, 0.f, 0.f}; } }
            PG8_MMA(1, 0, At, B0); PG8_MMA(1, 1, At, B1); PG8_BAR; PG8_SCHED;
            } else {
            PG8_LDB(B0, 0, 0); PG8_SCHED; PG8_LDA(At, 0, 0); PG8_STAGE(PG8_SA(1, 1), a1 + hstep, voffA);
            PG8_WAIT_L(8); PG8_BAR; PG8_WAIT_L(0); PG8_MMA(0, 0, At, B0); PG8_BAR; PG8_SCHED;
            PG8_LDB(B1, 0, 1); PG8_STAGE(PG8_SB(0, 0), b2, voffB);
            PG8_BAR; PG8_WAIT_L(0); PG8_MMA(0, 1, At, B1); PG8_BAR;
            PG8_LDA(At, 0, 1); PG8_STAGE(PG8_SA(0, 0), a2, voffA);
            PG8_BAR; PG8_WAIT_L(0); PG8_MMA(1, 0, At, B0); PG8_BAR; PG8_SCHED;
            PG8_STAGE(PG8_SB(0, 1), b2 + hstep, voffB);
            PG8_WAIT_V(6); PG8_BAR; PG8_MMA(1, 1, At, B1); PG8_BAR;
            PG8_LDB(B0, 1, 0); PG8_SCHED; PG8_LDA(At, 1, 0); PG8_STAGE(PG8_SA(0, 1), a2 + hstep, voffA);
            PG8_WAIT_L(8); PG8_BAR; PG8_WAIT_L(0); PG8_MMA(0, 0, At, B0); PG8_BAR; PG8_SCHED;
            PG8_LDB(B1, 1, 1); PG8_STAGE(PG8_SB(1, 0), b3, voffB);
            PG8_BAR; PG8_WAIT_L(0); PG8_MMA(0, 1, At, B1); PG8_BAR;
            PG8_LDA(At, 1, 1); PG8_STAGE(PG8_SA(1, 0), a3, voffA);
            PG8_BAR; PG8_WAIT_L(0); PG8_MMA(1, 0, At, B0); PG8_BAR; PG8_SCHED;
            PG8_STAGE(PG8_SB(1, 1), b3 + hstep, voffB);
            PG8_WAIT_V(6); PG8_BAR; PG8_MMA(1, 1, At, B1); PG8_BAR;
            }
        }
        }
        if constexpr (SPLIT_EPI) { prev = cur; have_prev = true; if (!has_next) break; cur = nxt; cA = nA; cB = nB; cA2 = nA2; cB2 = nB2; ++ui; continue; }
        if constexpr (ALIGN_EPI) { if (wr == 0) PG8_BAR; }
        if constexpr (!Epi::AFTER_DRAIN) { E(acc, cur, wr, wc, fr, fq); S.done(cur); }
        if constexpr (ALIGN_EPI && epi_has_post<Epi>::v) {
            if (E.need_post(cur)) { PG8_WAIT_V(0); PG8_WAIT_L(0); PG8_BAR; asm volatile("" ::: "memory"); E.post(cur, tid); } }
        if (!has_next) break;
#pragma unroll
        for (int a = 0; a < 2; ++a)
#pragma unroll
            for (int b = 0; b < 2; ++b)
#pragma unroll
                for (int m = 0; m < 4; ++m)
#pragma unroll
                    for (int n = 0; n < 2; ++n) acc[a][b][m][n] = (f32x4){0.f, 0.f, 0.f, 0.f};
        cur = nxt; cA = nA; cB = nB; cA2 = nA2; cB2 = nB2; ++ui;
        if constexpr (ALIGN_EPI) { if (wr == 1) PG8_BAR; }
    }
    PG8_WAIT_V(0);
    if constexpr (!ALIGN_EPI) { if (wr == 0) PG8_BAR; }
    PG8_BAR;
    if constexpr (Epi::AFTER_DRAIN) { E.fused(acc, cur, wr, wc, fr, fq, lds, wid, lane); S.done(cur); }
    if constexpr (SPLIT_EPI) { if (have_prev) E.part(acc, prev, wr, wc, fr, fq, 1); }
#undef PG8_SA
#undef PG8_SB
#undef PG8_STAGE
#undef PG8_LDA
#undef PG8_LDB
#undef PG8_MMA
#undef PG8_WAIT_V
#undef PG8_WAIT_L
#undef PG8_BAR
#undef PG8_SCHED
}
}
#define GAS __attribute__((address_space(1)))
#define LAS __attribute__((address_space(3)))
typedef unsigned short bf16;
typedef unsigned v4u __attribute__((ext_vector_type(4)));
typedef float f32x4 __attribute__((ext_vector_type(4)));
typedef short bf16x8 __attribute__((ext_vector_type(8)));
typedef GAS unsigned gu32;
typedef GAS unsigned long long gu64;
#define RLX_AGENT __ATOMIC_RELAXED, __HIP_MEMORY_SCOPE_AGENT
#define LDS_WAIT() asm volatile("s_waitcnt lgkmcnt(0)" ::: "memory")
#define VM_WAIT() asm volatile("s_waitcnt vmcnt(0)" ::: "memory")
__device__ __forceinline__ unsigned long long rt() { return __builtin_amdgcn_s_memrealtime(); }
__device__ __forceinline__ unsigned f2bf(float f) { unsigned u = __builtin_bit_cast(unsigned, f); return (u + 0x7fffu + ((u >> 16) & 1u)) >> 16; }
__device__ __forceinline__ unsigned pk2(float lo, float hi) { return f2bf(lo) | (f2bf(hi) << 16); }
constexpr int NWAVES = 8;
#ifndef GLA_MFMA
#define GLA_MFMA 1
#endif
#ifndef SWA_MFMA
#define SWA_MFMA 1
#endif
constexpr int BATCH = 8, SEQ = 4096, DM = 1024, M = BATCH * SEQ;
constexpr int NPROJ = 6656;
constexpr int DFF = 2816;
constexpr float EPS = 1e-6f;
constexpr size_t MiB = 1u << 20;
constexpr size_t WS_CTL = 0, CTL_ZERO_BYTES = 1 * MiB;
constexpr size_t WS_WIN = 1 * MiB;
constexpr size_t WS_WLR = 14 * MiB;
constexpr size_t WS_WG = 15 * MiB, WS_WS = 17 * MiB, WS_WOUT = 19 * MiB;
constexpr size_t WS_WFI = 21 * MiB;
constexpr size_t WS_WFO = 32 * MiB;
constexpr size_t WS_ROPE = 38 * MiB;
constexpr size_t WS_LR = 40 * MiB;
constexpr size_t WS_SSQ = 44 * MiB;
constexpr size_t WS_QG = 48 * MiB, WS_KG = 80 * MiB;
constexpr size_t WS_VG = 112 * MiB, WS_R = 176 * MiB, WS_SQ = 240 * MiB;
constexpr size_t WS_SK = 304 * MiB, WS_SV = 320 * MiB;
constexpr size_t WS_GA = 336 * MiB, WS_GB = 400 * MiB;
constexpr size_t WS_END = 464 * MiB;
constexpr size_t WS_DUMMY = 500 * MiB;
constexpr size_t WS_MERGED = WS_VG;
constexpr size_t WS_X1B = WS_QG;
constexpr size_t WS_H = WS_SQ;
static_assert(WS_H + (size_t)M * DFF * 2 <= WS_END, "h overlay");
constexpr int CW_TMO = 0, CW_CODE = 1;
constexpr int CW_BAR = 4096;
constexpr int RING_OFF = 0, RING_BYTES = 131072;
constexpr int LDS_BYTES = 163840;
constexpr int LDSCTL_OFF = LDS_BYTES - 1024, MISC_OFF = LDSCTL_OFF + 320;
static_assert(MISC_OFF + 128 <= LDS_BYTES, "LDS map");

#define XB_TMO      128
#define XB_XCNT(j)  (256  + 64 * (j))
#define XB_XSUB(j)  (1280 + 64 * (j))
#define XB_XGEN(j)  (2304 + 64 * (j))
#define XB_TOP      3328
#define XB_TOPGEN   3392
#define XCD_BAR_WORDS 3456
#define XB_SPIN_CAP (1u << 18)

__device__ __forceinline__ unsigned xb_ld(unsigned* p)              { return __hip_atomic_load(p, __ATOMIC_RELAXED, __HIP_MEMORY_SCOPE_AGENT); }
__device__ __forceinline__ unsigned xb_add(unsigned* p, unsigned v) { return __hip_atomic_fetch_add(p, v, __ATOMIC_RELAXED, __HIP_MEMORY_SCOPE_AGENT); }
__device__ __forceinline__ unsigned xb_xcc_id() { return (unsigned)__builtin_amdgcn_s_getreg((3 << 11) | 20) & 0xFu; }
#define XB_SPIN(cond, bar) do { unsigned _sp = 0; while (cond) { __builtin_amdgcn_s_sleep(1); \
    if ((++_sp & 255u) == 0u) { if (xb_ld(&(bar)[XB_TMO])) break; if (_sp > XB_SPIN_CAP) { atomicAdd(&(bar)[XB_TMO], 1u); break; } } } } while (0)

struct XcdBarrier {
    unsigned* bar; unsigned x;
    volatile LAS unsigned* st;
};

__device__ __forceinline__ XcdBarrier xcd_barrier_post(unsigned* bar, volatile LAS unsigned* st) {
    XcdBarrier b; b.bar = bar; b.x = xb_xcc_id(); b.st = st;
    if (threadIdx.x == 0) (void)xb_add(&bar[XB_XCNT(b.x)], 1u);
    return b;
}
__device__ __forceinline__ void xcd_barrier_complete(unsigned* bar, unsigned x, unsigned& nloc, unsigned& nx) {
    const unsigned G = gridDim.x * gridDim.y * gridDim.z;
    unsigned sum, cnt, mine, sp = 0u;
    for (;;) {
        sum = 0u; cnt = 0u; mine = 0u;
#pragma unroll
        for (unsigned j = 0; j < 16; ++j) { const unsigned c = xb_ld(&bar[XB_XCNT(j)]); sum += c; cnt += (c > 0u) ? 1u : 0u; mine = (j == x) ? c : mine; }
        if (sum == G) break;
        __builtin_amdgcn_s_sleep(1);
        if ((++sp & 255u) == 0u) { if (xb_ld(&bar[XB_TMO])) break; if (sp > XB_SPIN_CAP) { atomicAdd(&bar[XB_TMO], 1u); break; } }
    }
    nloc = mine > 0u ? mine : 1u; nx = cnt > 0u ? cnt : 1u;
}

__device__ __forceinline__ void xcd_barrier(const XcdBarrier& b) {
    asm volatile("s_waitcnt vmcnt(0)" ::: "memory");
    __syncthreads();
    if (threadIdx.x == 0) {
        unsigned* bar = b.bar;
        __builtin_amdgcn_s_waitcnt(0);
        unsigned nloc = b.st[0], nx = b.st[1];
        if (nloc == 0u) { xcd_barrier_complete(bar, b.x, nloc, nx); b.st[0] = nloc; b.st[1] = nx; }
        const unsigned old = xb_add(&bar[XB_XSUB(b.x)], 1u);
        const unsigned gen = old / nloc;
        if (old + 1u == (gen + 1u) * nloc) {
            __builtin_amdgcn_fence(__ATOMIC_RELEASE, "agent");
            asm volatile("s_waitcnt vmcnt(0)" ::: "memory");
            const unsigned og = xb_add(&bar[XB_TOP], 1u);
            const unsigned tg = og / nx;
            if (og + 1u == (tg + 1u) * nx) xb_add(&bar[XB_TOPGEN], 1u);
            else XB_SPIN(xb_ld(&bar[XB_TOPGEN]) == tg, bar);
            __builtin_amdgcn_fence(__ATOMIC_ACQUIRE, "agent");
            xb_add(&bar[XB_XGEN(b.x)], 1u);
            asm volatile("s_waitcnt vmcnt(0)" ::: "memory");
        } else {
            XB_SPIN(xb_ld(&bar[XB_XGEN(b.x)]) == gen, bar);
            __builtin_amdgcn_fence(__ATOMIC_ACQUIRE, "agent");
            asm volatile("s_waitcnt vmcnt(0)" ::: "memory");
        }
    }
    __syncthreads();
}

typedef unsigned u32x2 __attribute__((ext_vector_type(2)));
__device__ __forceinline__ const float* inp(int i) { const float* const* ka = (const float* const*)__builtin_amdgcn_kernarg_segment_ptr(); asm volatile("" : "+s"(ka)); return ka[i]; }
enum { I_X = 0, I_GMIX, I_WIN, I_UPF, I_BIASF, I_UPB, I_BIASB, I_GGLA, I_WOG, I_GQ, I_GK, I_SINKS, I_WOS, I_WOUT, I_GFFN, I_WFI, I_WFO };
struct Frame {
    LAS unsigned char* lds;
    volatile LAS unsigned* MISC;
    gu32* ctl;
    unsigned char* ws; float* out;
    int tid, lane, wave;
    int vcu, G;
#define WSPTR(name, T, off) __device__ __forceinline__ T* name() const { return (T*)(ws + (off)); }
    WSPTR(WIN, bf16, WS_WIN) WSPTR(WLR, bf16, WS_WLR) WSPTR(WG, bf16, WS_WG) WSPTR(WS_, bf16, WS_WS) WSPTR(WOUT, bf16, WS_WOUT) WSPTR(WFI, bf16, WS_WFI) WSPTR(WFO, bf16, WS_WFO)
    WSPTR(ROPE, float, WS_ROPE) WSPTR(LR, float, WS_LR) WSPTR(SSQ, float, WS_SSQ)
    WSPTR(QG, bf16, WS_QG) WSPTR(KG, bf16, WS_KG) WSPTR(VG, bf16, WS_VG) WSPTR(R, bf16, WS_R) WSPTR(SQ, bf16, WS_SQ) WSPTR(SK, bf16, WS_SK) WSPTR(SV, bf16, WS_SV)
    WSPTR(GA, bf16, WS_GA) WSPTR(GB, bf16, WS_GB) WSPTR(MERGED, bf16, WS_MERGED) WSPTR(X1B, bf16, WS_X1B) WSPTR(H, bf16, WS_H)
#undef WSPTR
    __device__ __forceinline__ bf16* XN() const { return (bf16*)out; }
    __device__ __forceinline__ bf16* OF() const { return (bf16*)out; }
    __device__ __forceinline__ bf16* OB() const { return (bf16*)out + (size_t)M * DM; }
};
__device__ __forceinline__ float wave_sum(float v) {
#pragma unroll
    for (int o = 1; o < 64; o <<= 1) v += __shfl_xor(v, o);
    return v;
}
__device__ __forceinline__ float wave_max(float v) {
#pragma unroll
    for (int o = 1; o < 64; o <<= 1) v = fmaxf(v, __shfl_xor(v, o));
    return v;
}
__device__ __forceinline__ float bflo(unsigned w) { return __uint_as_float(w << 16); }
__device__ __forceinline__ float bfhi(unsigned w) { return __uint_as_float(w & 0xffff0000u); }
__device__ __forceinline__ float bf1(bf16 b) { return __uint_as_float((unsigned)b << 16); }

__device__ __forceinline__ void p0_item(const float* W, int ldw, int K, int scol0, bf16* WT, int drow0, int k0, const float* gain, LAS float* scr, int lane) {
    float wv[32];
#pragma unroll
    for (int i = 0; i < 32; ++i) wv[i] = W[(size_t)(k0 + 2 * i + (lane >> 5)) * ldw + scol0 + (lane & 31)];
#pragma unroll
    for (int i = 0; i < 32; ++i) { const int kk = 2 * i + (lane >> 5); float v = wv[i]; if (gain) v *= gain[k0 + kk]; scr[kk * 33 + (lane & 31)] = v; }
    LDS_WAIT(); asm volatile("" ::: "memory");
    const int c = lane & 7;
#pragma unroll
    for (int j = 0; j < 4; ++j) { const int n = (lane >> 3) + 8 * j; const LAS float* s = scr + (8 * c) * 33 + n;
        v4u o; o.x = pk2(s[0 * 33], s[1 * 33]); o.y = pk2(s[2 * 33], s[3 * 33]); o.z = pk2(s[4 * 33], s[5 * 33]); o.w = pk2(s[6 * 33], s[7 * 33]);
        *(GAS v4u*)(WT + (size_t)(drow0 + n) * K + k0 + 8 * c) = o; }
    LDS_WAIT(); asm volatile("" ::: "memory");
}
__device__ __forceinline__ void sincos_d(double a, float& c, float& s) {
    const double n = __builtin_rint(a * 0.6366197723675814);
    double r = __builtin_fma(-n, 1.5707963267948966, a); r = __builtin_fma(-n, 6.123233995736766e-17, r);
    const double r2 = r * r;
    double sp = -1.0 / 1307674368000.0;
    sp = sp * r2 + 1.0 / 6227020800.0; sp = sp * r2 - 1.0 / 39916800.0; sp = sp * r2 + 1.0 / 362880.0; sp = sp * r2 - 1.0 / 5040.0; sp = sp * r2 + 1.0 / 120.0; sp = sp * r2 - 1.0 / 6.0; sp = sp * r2 * r + r;
    double cp = 1.0 / 20922789888000.0;
    cp = cp * r2 - 1.0 / 87178291200.0; cp = cp * r2 + 1.0 / 479001600.0; cp = cp * r2 - 1.0 / 3628800.0; cp = cp * r2 + 1.0 / 40320.0; cp = cp * r2 - 1.0 / 720.0; cp = cp * r2 + 1.0 / 24.0; cp = cp * r2 - 0.5; cp = cp * r2 + 1.0;
    const int q = (int)n & 3;
    const double sv = (q == 0) ? sp : (q == 1) ? cp : (q == 2) ? -sp : -cp;
    const double cv = (q == 0) ? cp : (q == 1) ? -sp : (q == 2) ? -cp : sp;
    c = (float)cv; s = (float)sv;
}
__device__ __forceinline__ void p0_prologue(Frame& F) {
    LAS float* scr = (LAS float*)(F.lds + RING_OFF + F.wave * 8448);
    LAS unsigned char* wlr = F.lds + RING_OFF + 8 * 8448;
    const int gw = F.vcu * NWAVES + F.wave, NGW = F.G * NWAVES;
    {
        const float* wsrc = inp(I_WIN) + (size_t)(2 * F.tid) * 6688 + 3072;
        f32x4 w0[8], w1[8];
#pragma unroll
        for (int j = 0; j < 8; ++j) { w0[j] = *(const f32x4*)(wsrc + 4 * j); w1[j] = *(const f32x4*)(wsrc + 6688 + 4 * j); }
#pragma unroll
        for (int n = 0; n < 32; ++n) { const int fF = ((n & 3) << 2) | ((n >> 2) & 3);
            *(LAS unsigned*)(wlr + 2048 * n + 16 * ((F.tid >> 2) ^ fF) + 4 * (F.tid & 3)) = pk2(w0[n >> 2][n & 3], w1[n >> 2][n & 3]); }
        __syncthreads();
    }
    constexpr int I_IN = 16 * 208, I_LR = 16, I_SQ = 16 * 32, I_FI = 16 * 176, I_FO = 44 * 32;
    constexpr int NITEMS = I_IN + I_LR + 3 * I_SQ + I_FI + I_FO;
    for (int it = gw; it < NITEMS; it += NGW) {
        int r = it;
        if (r < I_IN) { const int kb = r / 208, nb = r % 208, dn0 = 32 * nb, sc0 = dn0 + (dn0 >= 3072 ? 32 : 0); p0_item(inp(I_WIN), 6688, 1024, sc0, F.WIN(), dn0, 64 * kb, nullptr, scr, F.lane); continue; } r -= I_IN;
        if (r < I_LR) { p0_item(inp(I_WIN), 6688, 1024, 3072, F.WLR(), 0, 64 * r, nullptr, scr, F.lane); continue; } r -= I_LR;
        if (r < I_SQ) { p0_item(inp(I_WOG), 1024, 1024, 32 * (r % 32), F.WG(), 32 * (r % 32), 64 * (r / 32), nullptr, scr, F.lane); continue; } r -= I_SQ;
        if (r < I_SQ) { p0_item(inp(I_WOS), 1024, 1024, 32 * (r % 32), F.WS_(), 32 * (r % 32), 64 * (r / 32), nullptr, scr, F.lane); continue; } r -= I_SQ;
        if (r < I_SQ) { p0_item(inp(I_WOUT), 1024, 1024, 32 * (r % 32), F.WOUT(), 32 * (r % 32), 64 * (r / 32), nullptr, scr, F.lane); continue; } r -= I_SQ;
        if (r < I_FI) { const int kb = r / 176, nb = r % 176, dn0 = 32 * nb, tj = dn0 >> 8, wi = dn0 & 255, sc0 = (wi < 128) ? (128 * tj + wi) : (DFF + 128 * tj + (wi - 128));
            p0_item(inp(I_WFI), 2 * DFF, 1024, sc0, F.WFI(), dn0, 64 * kb, inp(I_GFFN), scr, F.lane); continue; } r -= I_FI;
        p0_item(inp(I_WFO), 1024, DFF, 32 * (r % 32), F.WFO(), 32 * (r % 32), 64 * (r / 32), nullptr, scr, F.lane);
    }
    {
        const float* xin = inp(I_X); const float* gmix = inp(I_GMIX); bf16* XNp = F.XN(); bf16* LRp = (bf16*)F.LR();
        f32x4 gm[4];
#pragma unroll
        for (int j = 0; j < 4; ++j) gm[j] = *((const f32x4*)gmix + F.lane + 64 * j);
        for (int g = gw; g < M / 16; g += NGW) {
            for (int it = 0; it < 4; ++it) {
                const int m0 = 16 * g + 4 * it;
                f32x4 v[4][4];
#pragma unroll
                for (int u = 0; u < 4; ++u) { const GAS f32x4* xr = (const GAS f32x4*)(xin + (size_t)(m0 + u) * DM) + F.lane;
#pragma unroll
                    for (int j = 0; j < 4; ++j) v[u][j] = xr[64 * j]; }
#pragma unroll
                for (int u = 0; u < 4; ++u) { float s = 0.f;
#pragma unroll
                    for (int j = 0; j < 4; ++j) s += (v[u][j].x * v[u][j].x + v[u][j].y * v[u][j].y) + (v[u][j].z * v[u][j].z + v[u][j].w * v[u][j].w);
                    const float rstd = 1.0f / sqrtf(wave_sum(s) * (1.f / DM) + EPS);
                    GAS unsigned long long* o8 = (GAS unsigned long long*)(XNp + (size_t)(m0 + u) * DM) + F.lane;
#pragma unroll
                    for (int j = 0; j < 4; ++j) o8[64 * j] = (unsigned long long)pk2(v[u][j].x * rstd * gm[j].x, v[u][j].y * rstd * gm[j].y) | ((unsigned long long)pk2(v[u][j].z * rstd * gm[j].z, v[u][j].w * rstd * gm[j].w) << 32); }
            }
            asm volatile("s_waitcnt vmcnt(0)" ::: "memory");
            int ln = F.lane; asm volatile("" : "+v"(ln));
            const int fr = ln & 15, fq = ln >> 4, fF = ((fr & 3) << 2) | ((fr >> 2) & 3);
            const bf16* ap = XNp + (size_t)(16 * g + fr) * DM + 8 * fq;
            const unsigned aB = (unsigned)(2048 * fr + 16 * (fq ^ fF));
            f32x4 a0 = {0.f, 0.f, 0.f, 0.f}, a1 = {0.f, 0.f, 0.f, 0.f};
#pragma unroll
            for (int hb = 0; hb < 2; ++hb) {
                bf16x8 af[16];
#pragma unroll
                for (int kk = 0; kk < 16; ++kk) af[kk] = *(const bf16x8*)(ap + 32 * (16 * hb + kk));
#pragma unroll
                for (int kk = 0; kk < 16; ++kk) { const int k2 = 16 * hb + kk;
                    const bf16x8 b0 = *(const LAS bf16x8*)(wlr + (aB ^ ((k2 & 3) << 6)) + 256 * (k2 >> 2)), b1 = *(const LAS bf16x8*)(wlr + (aB ^ ((k2 & 3) << 6)) + 256 * (k2 >> 2) + 32768);
                    a0 = __builtin_amdgcn_mfma_f32_16x16x32_bf16(b0, af[kk], a0, 0, 0, 0); a1 = __builtin_amdgcn_mfma_f32_16x16x32_bf16(b1, af[kk], a1, 0, 0, 0);
                    if ((kk & 3) == 3) __builtin_amdgcn_sched_barrier(0); }
            }
            { u32x2 w0, w1; w0.x = pk2(a0[0], a0[1]); w0.y = pk2(a0[2], a0[3]); w1.x = pk2(a1[0], a1[1]); w1.y = pk2(a1[2], a1[3]);
              bf16* o = LRp + (size_t)(16 * g + fr) * 32 + 4 * fq; *(u32x2*)o = w0; *(u32x2*)(o + 16) = w1; }
        }
    }
    float* ROPEp = F.ROPE();
    for (int idx = (F.vcu * NWAVES + F.wave) * 64 + F.lane; idx < SEQ * 64; idx += NGW * 64) {
        const int i = idx & 63, pos = idx >> 6; double f = 1.0;
        for (int k = 0; k < i; ++k) f *= 0.8659643233600653;
        float c, s; sincos_d((double)pos * f, c, s);
        ROPEp[2 * idx] = c; ROPEp[2 * idx + 1] = s;
    }
}
__device__ __forceinline__ void p1_lr(Frame& F) {
    const int gw = F.vcu * NWAVES + F.wave, NGW = F.G * NWAVES, fr = F.lane & 15, fq = F.lane >> 4;
    const bf16* XNp = F.XN(); const bf16* WLRp = F.WLR(); bf16* LRp = (bf16*)F.LR();
    for (int g = gw; g < M / 16; g += NGW) {
        const bf16* ap = XNp + (size_t)(16 * g + fr) * DM + 8 * fq; const bf16* b0p = WLRp + (size_t)fr * DM + 8 * fq; const bf16* b1p = b0p + 16 * DM;
        f32x4 a0 = {0.f, 0.f, 0.f, 0.f}, a1 = {0.f, 0.f, 0.f, 0.f};
#pragma unroll 4
        for (int kk = 0; kk < 32; ++kk) { const bf16x8 a = *(const bf16x8*)(ap + 32 * kk), b0 = *(const bf16x8*)(b0p + 32 * kk), b1 = *(const bf16x8*)(b1p + 32 * kk);
            a0 = __builtin_amdgcn_mfma_f32_16x16x32_bf16(a, b0, a0, 0, 0, 0); a1 = __builtin_amdgcn_mfma_f32_16x16x32_bf16(a, b1, a1, 0, 0, 0); }
#pragma unroll
        for (int i = 0; i < 4; ++i) { bf16* o = LRp + (size_t)(16 * g + 4 * fq + i) * 32 + fr; o[0] = (bf16)f2bf(a0[i]); o[16] = (bf16)f2bf(a1[i]); }
    }
}
__device__ __forceinline__ void qk_xform(const v4u a1, const v4u a2, const f32x4 (&cs)[4], const float* gn, const int c, const float sc, v4u& w1, v4u& w2) {
    float x1[8], x2[8];
    x1[0] = bflo(a1.x); x1[1] = bfhi(a1.x); x1[2] = bflo(a1.y); x1[3] = bfhi(a1.y); x1[4] = bflo(a1.z); x1[5] = bfhi(a1.z); x1[6] = bflo(a1.w); x1[7] = bfhi(a1.w);
    x2[0] = bflo(a2.x); x2[1] = bfhi(a2.x); x2[2] = bflo(a2.y); x2[3] = bfhi(a2.y); x2[4] = bflo(a2.z); x2[5] = bfhi(a2.z); x2[6] = bflo(a2.w); x2[7] = bfhi(a2.w);
    float ss = 0.f;
#pragma unroll
    for (int e = 0; e < 8; ++e) ss += x1[e] * x1[e] + x2[e] * x2[e];
    ss += __shfl_xor(ss, 1); ss += __shfl_xor(ss, 2); ss += __shfl_xor(ss, 4);
    const float rstd = sc / sqrtf(ss * (1.f / 128.f) + EPS);
    const f32x4 g10 = *(const f32x4*)(gn + 8 * c), g11 = *(const f32x4*)(gn + 8 * c + 4), g20 = *(const f32x4*)(gn + 64 + 8 * c), g21 = *(const f32x4*)(gn + 64 + 8 * c + 4);
    float o1[8], o2[8];
#pragma unroll
    for (int e = 0; e < 8; ++e) { const float y1 = x1[e] * rstd * (e < 4 ? g10[e & 3] : g11[e & 3]), y2 = x2[e] * rstd * (e < 4 ? g20[e & 3] : g21[e & 3]);
        const float cc = cs[e >> 1][2 * (e & 1)], sn = cs[e >> 1][2 * (e & 1) + 1]; o1[e] = y1 * cc - y2 * sn; o2[e] = y2 * cc + y1 * sn; }
    w1.x = pk2(o1[0], o1[1]); w1.y = pk2(o1[2], o1[3]); w1.z = pk2(o1[4], o1[5]); w1.w = pk2(o1[6], o1[7]); w2.x = pk2(o2[0], o2[1]); w2.y = pk2(o2[2], o2[3]); w2.z = pk2(o2[4], o2[5]); w2.w = pk2(o2[6], o2[7]);
}
#ifndef QK_Q_IN_SWA
#define QK_Q_IN_SWA 1
#endif
__device__ __forceinline__ void p1b_qknorm_rope(Frame& F, int dummy = 0) {
    const int gw = F.vcu * NWAVES + F.wave, NGW = F.G * NWAVES, lane = F.lane, slot = lane >> 3, c = lane & 7;
    constexpr int NSLOT = QK_Q_IN_SWA ? 2 : 10, HH0 = QK_Q_IN_SWA ? 8 : 0;
    constexpr int NGRP = M * NSLOT / 8;
    bf16* SQp = F.SQ(); bf16* SKp = F.SK(); const float* ROPEp = F.ROPE(); const float* gqp = inp(I_GQ); const float* gkp = inp(I_GK);
    for (int g0 = gw; g0 < NGRP; g0 += 4 * NGW) {
        v4u a1[4], a2[4]; f32x4 cs[4][4];
#pragma unroll
        for (int u = 0; u < 4; ++u) { const int g = g0 + u * NGW, idx = (g < NGRP ? g : g0) * 8 + slot, row = idx / NSLOT, hh = HH0 + idx - row * NSLOT, pos = row & (SEQ - 1);
            const bf16* p = (hh < 8) ? SQp + (size_t)row * 1024 + hh * 128 : SKp + (size_t)row * 256 + (hh - 8) * 128;
            a1[u] = *(const v4u*)(p + 8 * c); a2[u] = *(const v4u*)(p + 64 + 8 * c);
            const f32x4* rp = (const f32x4*)(ROPEp + 2 * (pos * 64 + 8 * c));
#pragma unroll
            for (int j = 0; j < 4; ++j) cs[u][j] = rp[j]; }
#pragma unroll
        for (int u = 0; u < 4; ++u) { const int g = g0 + u * NGW, idx = (g < NGRP ? g : g0) * 8 + slot, row = idx / NSLOT, hh = HH0 + idx - row * NSLOT;
            bf16* p = (hh < 8) ? SQp + (size_t)row * 1024 + hh * 128 : SKp + (size_t)row * 256 + (hh - 8) * 128;
            const float* gn = (hh < 8) ? gqp : gkp; const float sc = (hh < 8) ? (SWA_MFMA ? 0.08838834764831845f * 1.4426950408889634f : 0.08838834764831845f) : 1.f;
            v4u w1, w2; qk_xform(a1[u], a2[u], cs[u], gn, c, sc, w1, w2);
            if (g < NGRP) { bf16* po = dummy ? (bf16*)(F.ws + WS_DUMMY) + (size_t)(idx & 8191) * 128 : p; *(v4u*)(po + 8 * c) = w1; *(v4u*)(po + 64 + 8 * c) = w2; } }
    }
}
#if 0
__device__ __forceinline__ float logsig(float z) { return fminf(z, 0.f) - log1pf(expf(-fabsf(z))); }
__device__ __forceinline__ void gla_naive(Frame& F) {
    if (F.vcu >= 64) return;
    const int b = F.vcu >> 3, h = (F.vcu >> 1) & 3, dir = F.vcu & 1;
    LAS float* Gs = (LAS float*)(F.lds + RING_OFF); LAS float* Qs = Gs + 2048; LAS float* Ks = Qs + 2048;
    const float* up = dir ? F.up_b : F.up_f; const float* bias = dir ? F.bias_b : F.bias_f;
    const int tt = F.tid >> 5, d0 = (F.tid & 31) * 4;
    const int col = 32 * F.wave + (F.lane & 31), hf = F.lane >> 5;
    bf16* O = dir ? F.OB : F.OF;
    float S[64];
#pragma unroll
    for (int i = 0; i < 64; ++i) S[i] = 0.f;
    for (int tile = 0; tile < SEQ / 16; ++tile) {
        {
            const int i = tile * 16 + tt, t = dir ? (SEQ - 1 - i) : i; const size_t row = (size_t)b * SEQ + t;
            const f32x4* lrp = (const f32x4*)(F.LR + row * 32 + dir * 16);
            f32x4 z = *(const f32x4*)(bias + h * 128 + d0);
#pragma unroll
            for (int r4 = 0; r4 < 4; ++r4) { const f32x4 l = lrp[r4];
#pragma unroll
                for (int e = 0; e < 4; ++e) { const f32x4 u = *(const f32x4*)(up + (size_t)(4 * r4 + e) * 512 + h * 128 + d0); z += u * l[e]; } }
            f32x4 g;
#pragma unroll
            for (int e = 0; e < 4; ++e) g[e] = expf(fmaxf(logsig(z[e]) * (1.f / 16.f), -0.5f));
            const u32x2 qw = *(const u32x2*)(F.QG + row * 512 + h * 128 + d0), kw = *(const u32x2*)(F.KG + row * 512 + h * 128 + d0);
            *(LAS f32x4*)(Gs + tt * 128 + d0) = g;
            *(LAS f32x4*)(Qs + tt * 128 + d0) = (f32x4){bflo(qw.x), bfhi(qw.x), bflo(qw.y), bfhi(qw.y)};
            *(LAS f32x4*)(Ks + tt * 128 + d0) = (f32x4){bflo(kw.x), bfhi(kw.x), bflo(kw.y), bfhi(kw.y)};
        }
        __syncthreads();
        for (int t2 = 0; t2 < 16; ++t2) {
            const int i = tile * 16 + t2, t = dir ? (SEQ - 1 - i) : i; const size_t row = (size_t)b * SEQ + t;
            const float v = bf1(F.VG[row * 1024 + h * 256 + col]);
            float o = 0.f;
#pragma unroll
            for (int dd = 0; dd < 64; dd += 4) {
                const f32x4 g4 = *(const LAS f32x4*)(Gs + t2 * 128 + 64 * hf + dd), q4 = *(const LAS f32x4*)(Qs + t2 * 128 + 64 * hf + dd), k4 = *(const LAS f32x4*)(Ks + t2 * 128 + 64 * hf + dd);
#pragma unroll
                for (int e = 0; e < 4; ++e) { float s = S[dd + e] * g4[e];
                    if (dir == 0) { s = fmaf(k4[e], v, s); o = fmaf(q4[e], s, o); } else { o = fmaf(q4[e], s, o); s = fmaf(k4[e], v, s); }
                    S[dd + e] = s; }
            }
            o += __shfl_xor(o, 32);
            if (hf == 0) O[row * 1024 + h * 256 + col] = (bf16)f2bf(o);
        }
        __syncthreads();
    }
}
__device__ __forceinline__ void swa_naive(Frame& F) {
    LAS float* qs = (LAS float*)(F.lds + RING_OFF + 32768) + F.wave * 512; LAS float* ps = qs + 128;
    const int gw = F.vcu * NWAVES + F.wave, NGW = F.G * NWAVES, lane = F.lane;
    const int per = (BATCH * 8 * SEQ) / NGW;
    for (int j = 0; j < per; ++j) {
        const int it = gw * per + j, bh = it >> 12, i = it & (SEQ - 1), b = bh >> 3, hd = bh & 7, kvh = hd >> 2;
        const size_t rowb = (size_t)b * SEQ;
        bf16* qp = F.SQ + (rowb + i) * 1024 + hd * 128;
        { const unsigned w = *(const unsigned*)(qp + 2 * lane); qs[2 * lane] = bflo(w); qs[2 * lane + 1] = bfhi(w); }
        LDS_WAIT(); asm volatile("" ::: "memory");
        const int jlo = (i - 128 > 0) ? i - 128 : 0, jhi = (i + 128 < SEQ - 1) ? i + 128 : SEQ - 1;
        float s[5];
#pragma unroll
        for (int c = 0; c < 5; ++c) { const int jj = jlo + lane + 64 * c; const bool valid = jj <= jhi;
            const bf16* kp = F.SK + (rowb + (valid ? jj : jhi)) * 256 + kvh * 128; float a = 0.f;
#pragma unroll 4
            for (int ch = 0; ch < 16; ++ch) { const v4u w = *(const v4u*)(kp + 8 * ch); const f32x4 qa = *(const LAS f32x4*)(qs + 8 * ch), qb = *(const LAS f32x4*)(qs + 8 * ch + 4);
                a += (bflo(w.x) * qa[0] + bfhi(w.x) * qa[1]) + (bflo(w.y) * qa[2] + bfhi(w.y) * qa[3]) + (bflo(w.z) * qb[0] + bfhi(w.z) * qb[1]) + (bflo(w.w) * qb[2] + bfhi(w.w) * qb[3]); }
            s[c] = valid ? a : -INFINITY; }
        const float sink = F.sinks[hd];
        float mx = fmaxf(fmaxf(fmaxf(s[0], s[1]), fmaxf(s[2], s[3])), s[4]); mx = fmaxf(wave_max(mx), sink);
        float sum = 0.f;
#pragma unroll
        for (int c = 0; c < 5; ++c) { const float p = expf(s[c] - mx); ps[lane + 64 * c] = p; sum += p; }
        sum = wave_sum(sum) + expf(sink - mx);
        LDS_WAIT(); asm volatile("" ::: "memory");
        const int n = jhi - jlo + 1; float o0 = 0.f, o1 = 0.f;
        const bf16* vp = F.SV + (rowb + jlo) * 256 + kvh * 128 + 2 * lane;
        for (int jj = 0; jj < n; ++jj) { const float p = ps[jj]; const unsigned w = *(const unsigned*)(vp + (size_t)jj * 256); o0 = fmaf(p, bflo(w), o0); o1 = fmaf(p, bfhi(w), o1); }
        const float inv = 1.0f / sum;
        *(unsigned*)(qp + 2 * lane) = pk2(o0 * inv, o1 * inv);
        asm volatile("" ::: "memory");
    }
}
#endif
__device__ __forceinline__ void p2c_combine(Frame& F, int dummy = 0) {
    const int gw = F.vcu * NWAVES + F.wave, NGW = F.G * NWAVES, lane = F.lane, l32 = lane & 31;
    const float* ggla = inp(I_GGLA); bf16* Rp = F.R();
    const bf16* OFp = F.OF(); const bf16* OBp = F.OB();
    const f32x4 ga = *((const f32x4*)ggla + 2 * l32), gb = *((const f32x4*)ggla + 2 * l32 + 1);
    constexpr int NGRP = M * 4 / 2;
    for (int g0 = gw; g0 < NGRP; g0 += 4 * NGW) {
        v4u a[4], b2[4], r4[4];
#pragma unroll
        for (int u = 0; u < 4; ++u) { const int g = g0 + u * NGW, idx = (g < NGRP ? g : g0) * 2 + (lane >> 5); const size_t so = (size_t)idx * 256 + 8 * l32;
            a[u] = *(const v4u*)(OFp + so); b2[u] = *(const v4u*)(OBp + so); r4[u] = *(const v4u*)(Rp + so); }
#pragma unroll
        for (int u = 0; u < 4; ++u) { const int g = g0 + u * NGW; const size_t off = (size_t)((g < NGRP ? g : g0) * 2 + (lane >> 5)) * 256 + 8 * l32;
            float o[8], r[8];
            o[0] = bflo(a[u].x) + bflo(b2[u].x); o[1] = bfhi(a[u].x) + bfhi(b2[u].x); o[2] = bflo(a[u].y) + bflo(b2[u].y); o[3] = bfhi(a[u].y) + bfhi(b2[u].y);
            o[4] = bflo(a[u].z) + bflo(b2[u].z); o[5] = bfhi(a[u].z) + bfhi(b2[u].z); o[6] = bflo(a[u].w) + bflo(b2[u].w); o[7] = bfhi(a[u].w) + bfhi(b2[u].w);
            r[0] = bflo(r4[u].x); r[1] = bfhi(r4[u].x); r[2] = bflo(r4[u].y); r[3] = bfhi(r4[u].y); r[4] = bflo(r4[u].z); r[5] = bfhi(r4[u].z); r[6] = bflo(r4[u].w); r[7] = bfhi(r4[u].w);
            float ss = 0.f;
#pragma unroll
            for (int e = 0; e < 8; ++e) ss += o[e] * o[e];
            ss += __shfl_xor(ss, 1); ss += __shfl_xor(ss, 2); ss += __shfl_xor(ss, 4); ss += __shfl_xor(ss, 8); ss += __shfl_xor(ss, 16);
            const float rstd = 1.0f / sqrtf(ss * (1.f / 256.f) + EPS);
            float y[8];
#pragma unroll
            for (int e = 0; e < 8; ++e) y[e] = o[e] * rstd * (e < 4 ? ga[e & 3] : gb[e & 3]) * r[e] / (1.f + __expf(-r[e]));
            if (g < NGRP) { v4u w; w.x = pk2(y[0], y[1]); w.y = pk2(y[2], y[3]); w.z = pk2(y[4], y[5]); w.w = pk2(y[6], y[7]); *(v4u*)((dummy ? (bf16*)(F.ws + WS_DUMMY) + (off & 0xfffff) : Rp + off)) = w; } }
    }
}

typedef float f32x16 __attribute__((ext_vector_type(16)));
typedef short s16x4 __attribute__((ext_vector_type(4)));
typedef float f32x2_t __attribute__((ext_vector_type(2))); typedef __bf16 bf16x2_t __attribute__((ext_vector_type(2)));
__device__ __forceinline__ unsigned cvtpk(float lo, float hi) { f32x2_t v = {lo, hi}; bf16x2_t b = __builtin_convertvector(v, bf16x2_t); return __builtin_bit_cast(unsigned, b); }
__device__ __forceinline__ bf16x8 pack_step(const f32x16& x, int s) { v4u p; p.x = cvtpk(x[8 * s], x[8 * s + 1]); p.y = cvtpk(x[8 * s + 2], x[8 * s + 3]); p.z = cvtpk(x[8 * s + 4], x[8 * s + 5]); p.w = cvtpk(x[8 * s + 6], x[8 * s + 7]); return __builtin_bit_cast(bf16x8, p); }
__device__ __forceinline__ int qk_off(int row, int ch) { return 256 * row + 16 * (ch ^ (((row & 3) << 2) | ((row >> 2) & 3))); }
__device__ __forceinline__ int v_off(int tok, int ch) { return 512 * tok + 16 * (ch ^ ((tok & 3) << 2)); }
__device__ __forceinline__ int p_off(int row, int ch) { return 128 * row + 16 * (ch ^ ((row >> 1) & 7)); }
typedef short v4i16_t __attribute__((ext_vector_type(4)));
__device__ __forceinline__ s16x4 tr_rd(LAS const unsigned char* p) { return __builtin_bit_cast(s16x4, __builtin_amdgcn_ds_read_tr16_b64_v4i16((LAS v4i16_t*)p)); }
#define MFMA32(a, b, c) __builtin_amdgcn_mfma_f32_32x32x16_bf16((a), (b), (c), 0, 0, 0)
#define MFMA16(a, b, c) __builtin_amdgcn_mfma_f32_16x16x32_bf16((a), (b), (c), 0, 0, 0)
constexpr int GL_QKSZ = 32768, GL_KI = 16384, GL_V0 = 65536, GL_VSZ = 32768, GL_P = 131072, GL_DEC = 139264;
constexpr int GL_OST = 140800, GL_OSTW = 2560;
constexpr int GLA_LDS_END = GL_OST + 8 * GL_OSTW;
constexpr int GL_DSEG = GLA_LDS_END;
constexpr int GL_NSEG = 4, GL_SEGC = 64 / GL_NSEG;
__device__ __forceinline__ void glds16(const void* gsrc, unsigned lds_dst) { unsigned keep;
    asm volatile("s_mov_b32 %0, m0\n\ts_mov_b32 m0, %2\n\ts_nop 0\n\tglobal_load_lds_dwordx4 %1, off\n\ts_mov_b32 m0, %0" : "=&s"(keep) : "v"(gsrc), "s"(lds_dst) : "memory"); }

__device__ __forceinline__ float* gl_sloc(Frame& F) { return (float*)(F.ws + WS_END); }
__device__ __forceinline__ float* gl_dseg(Frame& F) { return (float*)(F.ws + WS_END + 32 * MiB); }
template <int MODE> __device__ __forceinline__ void gla_mfma(Frame& F, int item, bool dump = (MODE == 0)) {
    const int b = item >> 5, h = (item >> 3) & 3, dir = (item >> 2) & 1, seg = item & 3, n0 = seg * GL_SEGC, n1e = n0 + GL_SEGC;
    if (MODE == 0 && seg == GL_NSEG - 1) return;
    const int w = F.wave;
    LAS unsigned char* L = F.lds + RING_OFF; const unsigned lds0 = (unsigned)(size_t)L;
    bf16* O = dir ? F.OB() : F.OF(); const bf16* VGp = F.VG(); const bf16* QGp = F.QG(); const bf16* KGp = F.KG(); const bf16* LRp = (const bf16*)F.LR();
    const size_t rowb = (size_t)b * SEQ;
    bf16x8 upf; float biasv;
    { const float* up = inp(dir ? I_UPB : I_UPF); const float* bias = inp(dir ? I_BIASB : I_BIASF); const int fr = F.lane & 15, fq = F.lane >> 4;
      v4u t = {0u, 0u, 0u, 0u};
      if (fq < 2) { const float* p = up + (size_t)(8 * fq) * 512 + h * 128 + 16 * w + fr; t.x = cvtpk(p[0], p[512]); t.y = cvtpk(p[1024], p[1536]); t.z = cvtpk(p[2048], p[2560]); t.w = cvtpk(p[3072], p[3584]); }
      upf = __builtin_bit_cast(bf16x8, t); biasv = bias[h * 128 + 16 * w + fr]; }
    f32x16 S[4];
#pragma unroll
    for (int j = 0; j < 4; ++j)
#pragma unroll
        for (int r = 0; r < 16; ++r) S[j][r] = 0.f;
    if (MODE == 1 && seg > 0) {
        if (F.tid < 128 * seg) *(LAS float*)(L + GL_DSEG + 4 * F.tid) = gl_dseg(F)[(size_t)(item - seg + (F.tid >> 7)) * 128 + (F.tid & 127)];
        __syncthreads();
        const int hi_ = F.lane >> 5;
        for (int sp = 0; sp < seg; ++sp) { const float* sl = gl_sloc(F) + ((size_t)((item - seg + sp) * 8 + w) * 64) * 64 + F.lane;
#pragma unroll
            for (int j = 0; j < 4; ++j)
#pragma unroll
                for (int g = 0; g < 4; ++g) { const f32x4 d4 = *(const LAS f32x4*)(L + GL_DSEG + 512 * sp + 4 * (32 * j + 8 * g + 4 * hi_));
#pragma unroll
                    for (int e = 0; e < 4; ++e) S[j][4 * g + e] = S[j][4 * g + e] * d4[e] + sl[(size_t)(j * 16 + 4 * g + e) * 64]; } }
    }
    float dprod = 1.f;

#define GL_ROW(n_, i_) (rowb + (size_t)(dir ? (SEQ - 1 - (64 * (n_) + (i_))) : (64 * (n_) + (i_))))
#define GL_OPAQUE(x) asm volatile("" : "+v"(x))
#define GL_LANE() int ln_ = F.lane; GL_OPAQUE(ln_); const int fr = ln_ & 15, fq = ln_ >> 4, r32 = ln_ & 31, hi = ln_ >> 5; (void)fr; (void)fq; (void)r32; (void)hi
#define GL_LOAD(n1) do { GL_LANE(); \
        _Pragma("unroll") for (int tt = 0; tt < 4; ++tt) { const size_t row_ = GL_ROW(n1, 16 * tt + fr); \
            if (MODE == 1) pq[tt] = *(const u32x2*)(QGp + row_ * 512 + h * 128 + 16 * w + 4 * fq); pk[tt] = *(const u32x2*)(KGp + row_ * 512 + h * 128 + 16 * w + 4 * fq); } \
    } while (0)
#define GL_LOAD_LR(n1) do { GL_LANE(); _Pragma("unroll") for (int tt = 0; tt < 4; ++tt) plr[tt] = *(const v4u*)(LRp + GL_ROW(n1, 16 * tt + fr) * 32 + dir * 16 + 8 * (fq & 1)); } while (0)
#define GL_DMA_V(n1, bsel) do { GL_LANE(); _Pragma("unroll") for (int i_ = 0; i_ < 4; ++i_) { const int tok_ = 8 * w + 2 * i_ + hi, ch_ = r32 ^ (((2 * i_ + hi) & 3) << 2); \
        glds16(VGp + GL_ROW(n1, tok_) * 1024 + h * 256 + 8 * ch_, (unsigned)__builtin_amdgcn_readfirstlane((int)(lds0 + GL_V0 + (bsel) * GL_VSZ + 4096 * w + 1024 * i_))); } } while (0)
#define GL_STAGE_A(bsel) do { GL_LANE(); \
        const int fF_ = ((fr & 3) << 2) | ((fr >> 2) & 3); \
        const unsigned aW_ = (unsigned)((fr << 8) | (((2 * w + (fq >> 1)) ^ fF_) << 4) | ((fq & 1) << 3)) + (bsel) * GL_QKSZ; \
        bf16x8 tri0, tri1, ones; \
        _Pragma("unroll") for (int j = 0; j < 8; ++j) { const int tk = 16 * (j >> 2) + 4 * fq + (j & 3); tri0[j] = (tk <= fr) ? (short)0x3F80 : (short)0; tri1[j] = (tk <= 16 + fr) ? (short)0x3F80 : (short)0; ones[j] = (short)0x3F80; } \
        f32x4 zt_[4]; \
        _Pragma("unroll") for (int tt = 0; tt < 4; ++tt) { v4u a_ = plr[tt]; if (fq >= 2) a_ = (v4u){0u, 0u, 0u, 0u}; \
            zt_[tt] = MFMA16(__builtin_bit_cast(bf16x8, a_), upf, ((f32x4){biasv, biasv, biasv, biasv})); } \
        v4u ahi_[2], alo_[2]; \
        _Pragma("unroll") for (int tt = 0; tt < 4; ++tt) { float lg_[4], lo_[4]; unsigned hw_[2]; \
            _Pragma("unroll") for (int r = 0; r < 4; ++r) { const float z_ = zt_[tt][r]; \
                const float ls_ = fminf(z_, 0.f) - 0.6931471805599453f * __builtin_amdgcn_logf(1.0f + __builtin_amdgcn_exp2f(-1.4426950408889634f * fabsf(z_))); \
                lg_[r] = fmaxf(ls_ * 0.0625f, -0.5f); } \
            hw_[0] = cvtpk(lg_[0], lg_[1]); hw_[1] = cvtpk(lg_[2], lg_[3]); \
            lo_[0] = lg_[0] - bflo(hw_[0]); lo_[1] = lg_[1] - bfhi(hw_[0]); lo_[2] = lg_[2] - bflo(hw_[1]); lo_[3] = lg_[3] - bfhi(hw_[1]); \
            const unsigned lw0_ = cvtpk(lo_[0], lo_[1]), lw1_ = cvtpk(lo_[2], lo_[3]); \
            if (tt & 1) { ahi_[tt >> 1].z = hw_[0]; ahi_[tt >> 1].w = hw_[1]; alo_[tt >> 1].z = lw0_; alo_[tt >> 1].w = lw1_; } else { ahi_[tt >> 1].x = hw_[0]; ahi_[tt >> 1].y = hw_[1]; alo_[tt >> 1].x = lw0_; alo_[tt >> 1].y = lw1_; } } \
        const bf16x8 AH0_ = __builtin_bit_cast(bf16x8, ahi_[0]), AL0_ = __builtin_bit_cast(bf16x8, alo_[0]), AH1_ = __builtin_bit_cast(bf16x8, ahi_[1]), AL1_ = __builtin_bit_cast(bf16x8, alo_[1]); \
        const f32x4 z4_ = {0.f, 0.f, 0.f, 0.f}; f32x4 bq_[4]; \
        bq_[0] = MFMA16(AH0_, tri0, z4_); bq_[0] = MFMA16(AL0_, tri0, bq_[0]); \
        bq_[1] = MFMA16(AH0_, tri1, z4_); bq_[1] = MFMA16(AL0_, tri1, bq_[1]); \
        f32x4 tot_ = MFMA16(AH0_, ones, z4_); tot_ = MFMA16(AL0_, ones, tot_); \
        bq_[2] = MFMA16(AH1_, tri0, tot_); bq_[2] = MFMA16(AL1_, tri0, bq_[2]); \
        bq_[3] = MFMA16(AH1_, tri1, tot_); bq_[3] = MFMA16(AL1_, tri1, bq_[3]); \
        if (fr == 15) { f32x4 d_; _Pragma("unroll") for (int r = 0; r < 4; ++r) d_[r] = __builtin_amdgcn_exp2f(1.4426950408889634f * bq_[3][r]); \
            *(LAS f32x4*)(L + GL_DEC + (bsel) * 512 + 4 * (16 * w + 4 * fq)) = d_; } \
        _Pragma("unroll") for (int tq = 0; tq < 4; ++tq) { const u32x2 qw_ = pq[tq], kw_ = pk[tq]; \
            float e_[4], ei_[4]; \
            _Pragma("unroll") for (int r = 0; r < 4; ++r) { const float bl_ = 1.4426950408889634f * bq_[tq][r]; if (MODE == 1) e_[r] = __builtin_amdgcn_exp2f(bl_); ei_[r] = __builtin_amdgcn_exp2f(-bl_); } \
            u32x2 qo_, ko_; if (MODE == 1) { qo_.x = cvtpk(bflo(qw_.x) * e_[0], bfhi(qw_.x) * e_[1]); qo_.y = cvtpk(bflo(qw_.y) * e_[2], bfhi(qw_.y) * e_[3]); } \
            ko_.x = cvtpk(bflo(kw_.x) * ei_[0], bfhi(kw_.x) * ei_[1]); ko_.y = cvtpk(bflo(kw_.y) * ei_[2], bfhi(kw_.y) * ei_[3]); \
            if (MODE == 1) *(LAS u32x2*)(L + aW_ + tq * 4096) = qo_; *(LAS u32x2*)(L + aW_ + GL_KI + tq * 4096) = ko_; } \
    } while (0)

    v4u plr[4]; u32x2 pq[4] = {}, pk[4];
    GL_DMA_V(n0, n0 & 1);
    GL_LOAD(n0); GL_LOAD_LR(n0);
    GL_STAGE_A(n0 & 1);
    GL_LOAD(n0 + 1); GL_LOAD_LR(n0 + 1);
    asm volatile("s_waitcnt vmcnt(0)" ::: "memory");
    __syncthreads();
    for (int n = n0; n < n1e; ++n) {
        const int bs = n & 1;
        if (MODE == 1) {
            GL_LANE();
            const int fF = ((fr & 3) << 2) | ((fr >> 2) & 3);
            const unsigned aB = (unsigned)((fr << 8) | ((fq ^ fF) << 4)) + bs * GL_QKSZ;
            const unsigned aPw = (unsigned)((fr << 7) | (((fq >> 1) ^ ((fr >> 1) & 7)) << 4) | ((fq & 1) << 3)) + GL_P;
            const int tq = w & 3;
#pragma unroll
            for (int tkk = 0; tkk < 2; ++tkk) { const int tk = 2 * (w >> 2) + tkk; f32x4 acc = {0.f, 0.f, 0.f, 0.f};
                if (tk <= tq) {
#pragma unroll
                    for (int kk = 0; kk < 4; ++kk) { const bf16x8 a = *(const LAS bf16x8*)(L + (aB ^ (kk << 6)) + GL_KI + tk * 4096), bb = *(const LAS bf16x8*)(L + (aB ^ (kk << 6)) + tq * 4096); acc = MFMA16(a, bb, acc); }
#pragma unroll
                    for (int r = 0; r < 4; ++r) { const int tokk = 16 * tk + 4 * fq + r, tokq = 16 * tq + fr; const bool keep = dir ? (tokk < tokq) : (tokk <= tokq); acc[r] = keep ? acc[r] : 0.f; }
                }
                u32x2 pw; pw.x = cvtpk(acc[0], acc[1]); pw.y = cvtpk(acc[2], acc[3]);
                *(LAS u32x2*)(L + (aPw ^ (tk << 5)) + tq * 2048) = pw; }
        }
        __builtin_amdgcn_sched_barrier(0);
        if (n + 1 < n1e) { GL_STAGE_A(bs ^ 1); }
        __builtin_amdgcn_sched_barrier(0);
        if (MODE == 1) { asm volatile("s_waitcnt vmcnt(0)" ::: "memory"); __syncthreads(); }
        if (n + 2 < n1e) { GL_LOAD(n + 2); GL_LOAD_LR(n + 2); }
        if (n + 1 < n1e) { GL_DMA_V(n + 1, bs ^ 1); }
        if (dump && F.tid < 128) dprod *= *(const LAS float*)(L + GL_DEC + bs * 512 + 4 * F.tid);
        {
            GL_LANE();
            const int i16 = ln_ & 15, q4 = i16 >> 2, p4 = i16 & 3, h16 = (ln_ >> 4) & 1;
            const int fR = ((r32 & 3) << 2) | ((r32 >> 2) & 3);
            const unsigned aV = (unsigned)(((8 * hi + q4) << 9) | (((4 * w + 2 * h16 + (p4 >> 1)) ^ (q4 << 2)) << 4) | ((p4 & 1) << 3)) + GL_V0 + bs * GL_VSZ;
            const unsigned aC = (unsigned)((r32 << 8) | (fR << 4) | (hi << 3)) + bs * GL_QKSZ;
            const unsigned aPr = (unsigned)((r32 << 7) | ((hi ^ ((r32 >> 1) & 7)) << 4)) + GL_P;
            const unsigned aK0 = (unsigned)(((8 * hi + q4) << 8) | ((((2 * h16 + (p4 >> 1)) ^ ((q4 << 2) | ((2 * hi) & 3))) & 15) << 4) | ((p4 & 1) << 3)) + bs * GL_QKSZ + GL_KI;
            const unsigned aK1 = (unsigned)(((8 * hi + q4 + 4) << 8) | ((((2 * h16 + (p4 >> 1)) ^ ((q4 << 2) | ((2 * hi + 1) & 3))) & 15) << 4) | ((p4 & 1) << 3)) + bs * GL_QKSZ + GL_KI;
            const unsigned aD = GL_DEC + bs * 512 + 16 * hi;
            bf16x8 vf[4];
#pragma unroll
            for (int s = 0; s < 4; ++s) { const s16x4 lo = tr_rd(L + aV + s * 8192), hh = tr_rd(L + aV + s * 8192 + 2048);
                vf[s] = (bf16x8){lo[0], lo[1], lo[2], lo[3], hh[0], hh[1], hh[2], hh[3]}; }
#define GL_QDF(f, a) ({ const u32x2 q0_ = *(const LAS u32x2*)(L + (aC ^ ((2 * (f)) << 4)) + (a) * 8192), q1_ = *(const LAS u32x2*)(L + (aC ^ ((2 * (f) + 1) << 4)) + (a) * 8192); (v4u){q0_.x, q0_.y, q1_.x, q1_.y}; })
#define GL_KIF(f) ({ const s16x4 lo_ = tr_rd(L + (aK0 ^ (((f) >> 2) << 6)) + ((f) & 3) * 4096), hh_ = tr_rd(L + (aK1 ^ (((f) >> 2) << 6)) + ((f) & 3) * 4096); (bf16x8){lo_[0], lo_[1], lo_[2], lo_[3], hh_[0], hh_[1], hh_[2], hh_[3]}; })
            if (MODE == 1) {
#pragma unroll
            for (int a = 0; a < 2; ++a) {
                f32x16 oT;
#pragma unroll
                for (int r = 0; r < 16; ++r) oT[r] = 0.f;
                v4u qf[4]; bf16x8 pf[4];
                qf[0] = GL_QDF(0, a); qf[1] = GL_QDF(1, a); qf[2] = GL_QDF(2, a);
                __builtin_amdgcn_sched_barrier(0);
#pragma unroll
                for (int f = 0; f < 8; ++f) {
                    if (f + 3 < 8) qf[(f + 3) & 3] = GL_QDF(f + 3, a);
                    if (f == 6) { pf[0] = *(const LAS bf16x8*)(L + (aPr ^ (0 << 5)) + a * 4096); pf[1] = *(const LAS bf16x8*)(L + (aPr ^ (1 << 5)) + a * 4096); }
                    if (f == 7) { pf[2] = *(const LAS bf16x8*)(L + (aPr ^ (2 << 5)) + a * 4096); pf[3] = *(const LAS bf16x8*)(L + (aPr ^ (3 << 5)) + a * 4096); }
                    oT = MFMA32(pack_step(S[f >> 1], f & 1), __builtin_bit_cast(bf16x8, qf[f & 3]), oT);
                    __builtin_amdgcn_sched_barrier(0); }
#pragma unroll
                for (int s = 0; s < 4; ++s) oT = MFMA32(vf[s], pf[s], oT);
                { const unsigned ost = GL_OST + w * GL_OSTW;
#pragma unroll
                  for (int g = 0; g < 4; ++g) { u32x2 ow; ow.x = cvtpk(oT[4 * g], oT[4 * g + 1]); ow.y = cvtpk(oT[4 * g + 2], oT[4 * g + 3]); *(LAS u32x2*)(L + ost + r32 * 80 + 16 * g + 8 * hi) = ow; }
                  asm volatile("s_waitcnt lgkmcnt(0)" ::: "memory");
#pragma unroll
                  for (int i = 0; i < 2; ++i) { const int tk = (ln_ >> 2) + 16 * i; const v4u ov = *(const LAS v4u*)(L + ost + tk * 80 + 16 * (ln_ & 3));
                      *(v4u*)(O + GL_ROW(n, 32 * a + tk) * 1024 + h * 256 + 32 * w + 8 * (ln_ & 3)) = ov; }
                  asm volatile("s_waitcnt lgkmcnt(0)" ::: "memory"); }
            }
            }
            {
                bf16x8 kf[4]; kf[0] = GL_KIF(0); kf[1] = GL_KIF(1); kf[2] = GL_KIF(2);
                f32x4 d4[4];
                __builtin_amdgcn_sched_barrier(0);
#pragma unroll
                for (int f = 0; f < 16; ++f) {
                    if (f + 3 < 16) kf[(f + 3) & 3] = GL_KIF(f + 3);
                    if ((f & 3) == 1) {
#pragma unroll
                        for (int g = 0; g < 4; ++g) d4[g] = *(const LAS f32x4*)(L + aD + 128 * (f >> 2) + 32 * g); }
                    S[f >> 2] = MFMA32(kf[f & 3], vf[f & 3], S[f >> 2]);
                    if ((f & 3) == 3) { const int j = f >> 2;
#pragma unroll
                        for (int g = 0; g < 4; ++g)
#pragma unroll
                            for (int e = 0; e < 4; ++e) S[j][4 * g + e] *= d4[g][e]; }
                    __builtin_amdgcn_sched_barrier(0);
                }
            }
#undef GL_QDF
#undef GL_KIF
        }
        if (MODE == 0) asm volatile("s_waitcnt vmcnt(0)" ::: "memory");
        __syncthreads();
    }
    if (dump) {
        float* sl = gl_sloc(F) + ((size_t)(item * 8 + w) * 64) * 64 + F.lane;
#pragma unroll
        for (int j = 0; j < 4; ++j)
#pragma unroll
            for (int r = 0; r < 16; ++r) sl[(size_t)(j * 16 + r) * 64] = S[j][r];
        if (F.tid < 128) gl_dseg(F)[(size_t)item * 128 + F.tid] = dprod; }
#undef GL_STAGE_A
#undef GL_LOAD
#undef GL_LOAD_LR
#undef GL_DMA_V
#undef GL_LANE
#undef GL_ROW
#undef GL_OPAQUE
}

constexpr int CW_SWAQ = 64;
constexpr int SWA_ITEMS = BATCH * 2 * 32 * 2;
__device__ __forceinline__ void swa_mfma(Frame& F, int dummy_o = 0, int abl = 0, int max_items = 1 << 30, int limit = 1 << 30) {
    const int lane = F.lane, w = F.wave, r32 = lane & 31, hi = lane >> 5, tid = F.tid;
    const int g16 = lane >> 4, i16 = lane & 15, q4 = i16 >> 2, p4 = i16 & 3, h16 = g16 & 1;
    LAS unsigned char* L = F.lds + RING_OFF;
    volatile LAS unsigned* qword = F.MISC + 16;
    unsigned step = 0;
    bf16* SQp = F.SQ(); const bf16* SKp = F.SK(); const bf16* SVp = F.SV(); const float* sinksp = inp(I_SINKS);
    bool fastsm;
    { const float* gq = inp(I_GQ); const float* gk = inp(I_GK);
      const float a = wave_max(fmaxf(fabsf(gq[lane]), fabsf(gq[lane + 64]))), b2 = wave_max(fmaxf(fabsf(gk[lane]), fabsf(gk[lane + 64]))), sk = wave_max(lane < 8 ? fabsf(sinksp[lane]) : 0.f);
      fastsm = __builtin_amdgcn_readfirstlane((16.4f * a * b2 + 1.4426950408889634f * sk < 60.f) ? 1 : 0) != 0; }
    if (tid == 0 && qword[1] == 0u) { qword[0] = __hip_atomic_fetch_add(F.ctl + CW_SWAQ, 1u, __ATOMIC_RELAXED, __HIP_MEMORY_SCOPE_AGENT); qword[1] = 1u; }
    __syncthreads();
    int item = (int)qword[0], done = 0;
    while (item < SWA_ITEMS && done < max_items) {
        ++done;
        unsigned nxt = 0xffffffffu;
        if (tid == 0 && item < limit) nxt = __hip_atomic_fetch_add(F.ctl + CW_SWAQ, 1u, __ATOMIC_RELAXED, __HIP_MEMORY_SCOPE_AGENT);
        const int hp = item & 1, n = (item >> 1) & 31, kvh = (item >> 6) & 1, b = item >> 7;
        const int head = 4 * kvh + 2 * hp + (w >> 2), qt = w & 3, qi = 128 * n + 32 * qt + r32;
        const size_t rowb = (size_t)b * SEQ;
        bf16* qp = SQp + (rowb + qi) * 1024 + head * 128;
        bf16x8 qf[8];
        { LAS unsigned char* qst = L + 65536 + w * 8704; const bf16* qb = SQp + (rowb + 128 * n + 32 * qt) * 1024 + head * 128;
          const int slot = lane >> 3, c = lane & 7;
#if QK_Q_IN_SWA
          const float* ROPEp = F.ROPE(); const float* gqp = inp(I_GQ);
          v4u q1[4], q2[4]; f32x4 cs[4][4];
#pragma unroll
          for (int u = 0; u < 4; ++u) { const int row = 8 * u + slot; const bf16* p = qb + (size_t)row * 1024;
              q1[u] = (abl & 64) ? (v4u){0u, 0u, 0u, 0u} : *(const v4u*)(p + 8 * c); q2[u] = (abl & 64) ? (v4u){0u, 0u, 0u, 0u} : *(const v4u*)(p + 64 + 8 * c);
              const f32x4* rp = (const f32x4*)(ROPEp + 2 * ((128 * n + 32 * qt + row) * 64 + 8 * c));
#pragma unroll
              for (int j = 0; j < 4; ++j) cs[u][j] = rp[j]; }
#pragma unroll
          for (int u = 0; u < 4; ++u) { const int row = 8 * u + slot; v4u w1, w2; qk_xform(q1[u], q2[u], cs[u], gqp, c, 0.08838834764831845f * 1.4426950408889634f, w1, w2);
              *(LAS v4u*)(qst + row * 272 + 16 * c) = w1; *(LAS v4u*)(qst + row * 272 + 128 + 16 * c) = w2; }
#else
          v4u q1[4], q2[4];
#pragma unroll
          for (int u = 0; u < 4; ++u) { const int row = 8 * u + slot; const bf16* p = qb + (size_t)row * 1024; q1[u] = *(const v4u*)(p + 8 * c); q2[u] = *(const v4u*)(p + 64 + 8 * c); }
#pragma unroll
          for (int u = 0; u < 4; ++u) { const int row = 8 * u + slot; *(LAS v4u*)(qst + row * 272 + 16 * c) = q1[u]; *(LAS v4u*)(qst + row * 272 + 128 + 16 * c) = q2[u]; }
#endif
          asm volatile("s_waitcnt lgkmcnt(0)" ::: "memory");
#pragma unroll
          for (int s = 0; s < 8; ++s) qf[s] = *(const LAS bf16x8*)(qst + r32 * 272 + 16 * (2 * s + hi));
          asm volatile("s_waitcnt lgkmcnt(0)" ::: "memory"); }
        float m = sinksp[head] * 1.4426950408889634f, l = hi ? 0.f : 1.f;
        f32x16 O[4];
#pragma unroll
        for (int dt = 0; dt < 4; ++dt)
#pragma unroll
            for (int r = 0; r < 16; ++r) O[dt][r] = 0.f;
        const int t_lo = (n == 0) ? 2 : 0, t_hi = (n == 31) ? 4 : 6;
        const bf16* kg = SKp + rowb * 256 + kvh * 128; const bf16* vg = SVp + rowb * 256 + kvh * 128;
        v4u kr[2], vr[2];
#define SW_LOAD(t_) do { const int k0_ = 128 * (n - 1) + 64 * (t_); _Pragma("unroll") for (int i_ = 0; i_ < 2; ++i_) { const int c_ = tid + 512 * i_, key_ = c_ >> 4, ch_ = c_ & 15; \
            kr[i_] = *(const v4u*)(kg + (size_t)(k0_ + key_) * 256 + 8 * ch_); vr[i_] = *(const v4u*)(vg + (size_t)(k0_ + key_) * 256 + 8 * ch_); } } while (0)
#define SW_STORE(bsel) do { _Pragma("unroll") for (int i_ = 0; i_ < 2; ++i_) { const int c_ = tid + 512 * i_, key_ = c_ >> 4, ch_ = c_ & 15; \
            *(LAS v4u*)(L + (bsel) * 32768 + qk_off(key_, ch_)) = kr[i_]; *(LAS v4u*)(L + (bsel) * 32768 + 16384 + qk_off(key_, ch_)) = vr[i_]; } } while (0)
        if (!(abl & 8)) SW_LOAD(t_lo); else { kr[0] = kr[1] = vr[0] = vr[1] = (v4u){0u, 0u, 0u, 0u}; }
        for (int t = t_lo; t < t_hi; ++t) {
            const int bs = step & 1; ++step;
            if (!(abl & 16)) SW_STORE(bs);
            __syncthreads();
            if (t + 1 < t_hi && !(abl & 8)) SW_LOAD(t + 1);
            const int k0 = 128 * (n - 1) + 64 * t, qlo = 128 * n + 32 * qt;
            if (k0 + 63 >= qlo - 128 && k0 <= qlo + 31 + 128 && !(abl & 32)) {
                LAS unsigned char* K = L + bs * 32768; LAS unsigned char* V = K + 16384;
                f32x16 p0, p1;
#pragma unroll
                for (int r = 0; r < 16; ++r) { p0[r] = 0.f; p1[r] = 0.f; }
                unsigned aKr = (unsigned)(bs * 32768) + (unsigned)((r32 << 8) | ((hi ^ (((r32 & 3) << 2) | ((r32 >> 2) & 3))) << 4)); asm volatile("" : "+v"(aKr));
#define SW_KF(s_, half) (*(const LAS bf16x8*)(L + (aKr ^ ((2 * (s_)) << 4)) + (half) * 8192))
                bf16x8 ka[4], kb[4];
                ka[0] = SW_KF(0, 0); kb[0] = SW_KF(0, 1); ka[1] = SW_KF(1, 0); kb[1] = SW_KF(1, 1); ka[2] = SW_KF(2, 0); kb[2] = SW_KF(2, 1);
                __builtin_amdgcn_sched_barrier(0);
#pragma unroll
                for (int s = 0; s < 8; ++s) {
                    if (s + 3 < 8) { ka[(s + 3) & 3] = SW_KF(s + 3, 0); kb[(s + 3) & 3] = SW_KF(s + 3, 1); }
                    if (!(abl & 1)) { p0 = MFMA32(ka[s & 3], qf[s], p0); p1 = MFMA32(kb[s & 3], qf[s], p1); }
                    __builtin_amdgcn_sched_barrier(0); }
#undef SW_KF
                if (!(abl & 2)) {
                const bool needmask = !(k0 + 63 - qlo <= 128 && qlo + 31 - k0 <= 128);
                if (needmask) {
#pragma unroll
                    for (int r = 0; r < 16; ++r) { const int kj = k0 + (r & 3) + 8 * (r >> 2) + 4 * hi;
                        p0[r] = ((unsigned)(qi - kj + 128) <= 256u) ? p0[r] : -INFINITY; p1[r] = ((unsigned)(qi - kj - 32 + 128) <= 256u) ? p1[r] : -INFINITY; } }
                float mn = m, alpha = 1.f;
                if (!fastsm) { float mloc = -INFINITY;
#pragma unroll
                    for (int r = 0; r < 16; ++r) mloc = fmaxf(mloc, fmaxf(p0[r], p1[r]));
                    mloc = fmaxf(mloc, __shfl_xor(mloc, 32));
                    mn = fmaxf(m, mloc); alpha = __builtin_amdgcn_exp2f(m - mn); m = mn; }
                float ls = 0.f;
#pragma unroll
                for (int r = 0; r < 16; ++r) { p0[r] = __builtin_amdgcn_exp2f(p0[r] - mn); p1[r] = __builtin_amdgcn_exp2f(p1[r] - mn); ls += p0[r] + p1[r]; }
                l = l * alpha + ls;
                if (!fastsm) {
#pragma unroll
                    for (int dt = 0; dt < 4; ++dt)
#pragma unroll
                        for (int r = 0; r < 16; ++r) O[dt][r] *= alpha; }
                }
                bf16x8 pb[4]; pb[0] = pack_step(p0, 0); pb[1] = pack_step(p0, 1); pb[2] = pack_step(p1, 0); pb[3] = pack_step(p1, 1);
                unsigned aVr0 = (unsigned)(bs * 32768 + 16384) + (unsigned)(((4 * hi + q4) << 8) | ((((2 * h16 + (p4 >> 1)) ^ ((q4 << 2) | hi)) & 15) << 4) | ((p4 & 1) << 3));
                unsigned aVr1 = (unsigned)(bs * 32768 + 16384) + (unsigned)(((4 * hi + q4 + 8) << 8) | ((((2 * h16 + (p4 >> 1)) ^ ((q4 << 2) | (2 + hi))) & 15) << 4) | ((p4 & 1) << 3));
                asm volatile("" : "+v"(aVr0), "+v"(aVr1));
#define SW_VF(f_) ({ const s16x4 lo_ = tr_rd(L + (aVr0 ^ (((f_) >> 2) << 6)) + ((f_) & 3) * 4096), hh_ = tr_rd(L + (aVr1 ^ (((f_) >> 2) << 6)) + ((f_) & 3) * 4096); (bf16x8){lo_[0], lo_[1], lo_[2], lo_[3], hh_[0], hh_[1], hh_[2], hh_[3]}; })
                bf16x8 vf[4]; vf[0] = SW_VF(0); vf[1] = SW_VF(1); vf[2] = SW_VF(2);
                __builtin_amdgcn_sched_barrier(0);
#pragma unroll
                for (int f = 0; f < 16; ++f) {
                    if (f + 3 < 16) vf[(f + 3) & 3] = SW_VF(f + 3);
                    if (!(abl & 4)) O[f >> 2] = MFMA32(vf[f & 3], pb[f & 3], O[f >> 2]);
                    __builtin_amdgcn_sched_barrier(0); }
#undef SW_VF
            }
        }
#undef SW_LOAD
#undef SW_STORE
        l += __shfl_xor(l, 32);
        const float inv = 1.0f / l;
        if (!(abl & 64)) {
            LAS unsigned char* ost = L + 65536 + w * 8704;
#pragma unroll
            for (int dt = 0; dt < 4; ++dt)
#pragma unroll
                for (int g = 0; g < 4; ++g) { u32x2 ow; ow.x = cvtpk(O[dt][4 * g] * inv, O[dt][4 * g + 1] * inv); ow.y = cvtpk(O[dt][4 * g + 2] * inv, O[dt][4 * g + 3] * inv);
                    *(LAS u32x2*)(ost + r32 * 272 + 2 * (32 * dt + 8 * g + 4 * hi)) = ow; }
            asm volatile("s_waitcnt lgkmcnt(0)" ::: "memory");
            bf16* ob = dummy_o ? (bf16*)(F.ws + WS_DUMMY) + (size_t)((128 * n + 32 * qt) & 1023) * 1024 + head * 128 : SQp + (rowb + 128 * n + 32 * qt) * 1024 + head * 128;
#pragma unroll
            for (int i = 0; i < 8; ++i) { const int row = 4 * i + (lane >> 4), ch = lane & 15; const v4u ov = *(const LAS v4u*)(ost + row * 272 + 16 * ch); *(v4u*)(ob + (size_t)row * 1024 + 8 * ch) = ov; }
            asm volatile("s_waitcnt lgkmcnt(0)" ::: "memory");
        }
        if (tid == 0) { qword[0] = nxt; qword[1] = (nxt != 0xffffffffu) ? 1u : 0u; }
        __syncthreads();
        const bool have = qword[1] != 0u; item = have ? (int)qword[0] : SWA_ITEMS;
        __syncthreads();
    }
}

constexpr int N_PHASES = 10;
constexpr int SWA_PHASE3_LIMIT = 600;
#ifndef STAGGER_US
#define STAGGER_US 0
#endif
__device__ __forceinline__ void stagger_wait(int us) { if (us > 0 && (blockIdx.x & 8)) { const unsigned long long t0 = __builtin_amdgcn_s_memrealtime(); while (__builtin_amdgcn_s_memrealtime() - t0 < (unsigned long long)us * 100ull) __builtin_amdgcn_s_sleep(8); } }
#ifndef PROBE_REP
#define PROBE_REP -1
#endif
#ifndef PROBE_N
#define PROBE_N 3
#endif
#ifndef PROBE_ABL
#define PROBE_ABL 0
#endif
static_assert(GLA_LDS_END <= LDSCTL_OFF, "GLA LDS map");
struct Args { const float* in[17]; float* out; unsigned char* ws; int ph_lo, ph_hi, use_bar, pad; };
__global__ void __launch_bounds__(NWAVES * 64, 2) mk_fwd(Args args) {
    extern __shared__ __attribute__((aligned(16))) unsigned char lds[];
    Frame F;
    F.lds = (LAS unsigned char*)lds;
    F.MISC = (volatile LAS unsigned*)(F.lds + MISC_OFF);
    F.tid = threadIdx.x; F.lane = F.tid & 63; F.wave = __builtin_amdgcn_readfirstlane(F.tid >> 6);
    F.G = gridDim.x; { const int bx = blockIdx.x; F.vcu = (F.G % 8 == 0) ? (bx % 8) * (F.G / 8) + bx / 8 : bx; }
    F.ws = args.ws; F.out = args.out;
    F.ctl = (gu32*)(args.ws + WS_CTL);
    for (int u = F.tid; u < (LDS_BYTES - LDSCTL_OFF) / 4; u += NWAVES * 64) ((LAS unsigned*)(F.lds + LDSCTL_OFF))[u] = 0u;
    __syncthreads();
    XcdBarrier bar; bar.bar = (unsigned*)(F.ctl + CW_BAR); bar.x = 0; bar.st = nullptr;
    if (args.use_bar) bar = xcd_barrier_post((unsigned*)(F.ctl + CW_BAR), F.MISC + 8);
    const int lo = args.ph_lo, hi = args.ph_hi;
#define IN(k) (lo <= (k) && (k) < hi)
#define SEAM(k) do { if (IN(k) && IN((k) + 1)) xcd_barrier(bar); } while (0)

    if (IN(0)) { p0_prologue(F); } SEAM(0);
    if (IN(1)) {
#if PROBE_REP == 11
        p1_lr(F);
#endif
        stagger_wait(STAGGER_US);
        pg8::Gemm g{F.XN(), F.WIN(), M, NPROJ, DM}; pg8::StaticOrder S; S.init(M, NPROJ, F.G, (int)blockIdx.x);
        static_assert(pg8::EpiProj::O_QG == WS_QG && pg8::EpiProj::O_KG == WS_KG && pg8::EpiProj::O_VG == WS_VG && pg8::EpiProj::O_R == WS_R && pg8::EpiProj::O_SQ == WS_SQ && pg8::EpiProj::O_SK == WS_SK && pg8::EpiProj::O_SV == WS_SV && pg8::EpiProj::O_GA == WS_GA && pg8::EpiProj::O_GB == WS_GB, "EpiProj offsets");
        pg8::EpiProj E{F.ws, args.pad & 128};
        pg8::gemm_phase<pg8::EpiProj, pg8::StaticOrder, true, true>(F.lds + RING_OFF, g, S, E);
    } SEAM(1);
    if (IN(2)) { p1b_qknorm_rope(F, args.pad & 8); } SEAM(2);
    if (IN(3)) { if ((args.pad & 3) != 2) gla_mfma<0>(F, F.vcu); __syncthreads(); if ((args.pad & 3) != 1) swa_mfma(F, args.pad & 8, args.pad >> 8); } SEAM(3);
    if (IN(4)) { gla_mfma<1>(F, F.vcu); } SEAM(4);
    if (IN(5)) { p2c_combine(F, args.pad & 8); } SEAM(5);
    if (IN(6)) {
        pg8::Gemm g{F.R(), F.WG(), M, DM, DM, F.SQ(), F.WS_()}; pg8::StaticOrder S; S.init(M, DM, F.G, (int)blockIdx.x);
        pg8::EpiMerge2 E{F.GA(), F.GB(), F.MERGED()};
        pg8::gemm_phase<pg8::EpiMerge2, pg8::StaticOrder, true, true, true>(F.lds + RING_OFF, g, S, E);
    } SEAM(6);
    if (IN(7)) {
        pg8::Gemm g{F.MERGED(), F.WOUT(), M, DM, DM}; pg8::StaticOrder S; S.init(M, DM, F.G, (int)blockIdx.x);
        pg8::EpiX1 E{inp(I_X), F.X1B(), F.SSQ()};
        pg8::gemm_phase<pg8::EpiX1, pg8::StaticOrder, true, true>(F.lds + RING_OFF, g, S, E);
    } SEAM(7);
    if (IN(8)) {
        stagger_wait(STAGGER_US);
        pg8::Gemm g{F.X1B(), F.WFI(), M, 2 * DFF, DM}; pg8::StaticOrder S; S.init(M, 2 * DFF, F.G, (int)blockIdx.x);
        pg8::EpiSwiGLU E{F.SSQ(), F.H()};
        pg8::gemm_phase<pg8::EpiSwiGLU, pg8::StaticOrder, true, true>(F.lds + RING_OFF, g, S, E);
    } SEAM(8);
    if (IN(9)) {
        pg8::Gemm g{F.H(), F.WFO(), M, DM, DFF}; pg8::StaticOrder S; S.init(M, DM, F.G, (int)blockIdx.x);
        pg8::EpiResid E{F.X1B(), F.out};
        pg8::gemm_phase<pg8::EpiResid, pg8::StaticOrder, true, true>(F.lds + RING_OFF, g, S, E);
    }
#undef IN
#undef SEAM
}

#ifndef MK_ONE_LAUNCH
#define MK_ONE_LAUNCH 1
#endif
extern "C" void kernel_launch(void* const* d_in, const int* in_sizes, int n_in, void* d_out, int out_size, void* d_ws, size_t ws_size, hipStream_t stream) {
    static int grid = 0;
    if (grid == 0) {
        if (n_in != 17 || in_sizes[0] != M * DM || out_size != M * DM || ws_size < WS_END + 33 * MiB) { fprintf(stderr, "kernel_launch: shape/workspace mismatch (n_in %d, in0 %d, out %d, ws %zu); nothing launched\n", n_in, n_in > 0 ? in_sizes[0] : -1, out_size, ws_size); grid = -1; return; }
        int dev = 0, cus = 0;
        if (hipGetDevice(&dev) != hipSuccess || hipDeviceGetAttribute(&cus, hipDeviceAttributeMultiprocessorCount, dev) != hipSuccess) { grid = -1; return; }
        if (hipFuncSetAttribute((const void*)mk_fwd, hipFuncAttributeMaxDynamicSharedMemorySize, LDS_BYTES) != hipSuccess) { fprintf(stderr, "kernel_launch: hipFuncSetAttribute failed\n"); grid = -1; return; }
        (void)hipGetLastError();
        grid = cus;
        if (grid != 256) fprintf(stderr, "kernel_launch: %d CUs; built for 256\n", grid);
    }
    if (grid < 0) return;
    (void)hipMemsetAsync((char*)d_ws + WS_CTL, 0, CTL_ZERO_BYTES, stream);
    Args a{};
    for (int i = 0; i < 17; ++i) a.in[i] = (const float*)d_in[i];
    a.out = (float*)d_out; a.ws = (unsigned char*)d_ws;
#if PROBE_REP == -1
    a.ph_lo = 0; a.ph_hi = N_PHASES; a.use_bar = 1;
    hipLaunchKernelGGL(mk_fwd, dim3(grid), dim3(NWAVES * 64), LDS_BYTES, stream, a);
#else
    for (int p = 0; p < N_PHASES; ++p) { const int nrep = (p == PROBE_REP) ? PROBE_N : 1;
        if (p == 2 && PROBE_REP == 21) {
            a.ph_lo = 2; a.ph_hi = 3; a.use_bar = 0;
            for (int r = 0; r + 1 < PROBE_N; ++r) { a.pad = 2 | 8; hipLaunchKernelGGL(mk_fwd, dim3(grid), dim3(NWAVES * 64), LDS_BYTES, stream, a); }
            a.pad = 0; hipLaunchKernelGGL(mk_fwd, dim3(grid), dim3(NWAVES * 64), LDS_BYTES, stream, a); continue; }
        if (p == 4 && PROBE_REP == 40) {
            a.ph_lo = 4; a.ph_hi = 5; a.use_bar = 0;
            for (int r = 0; r + 1 < PROBE_N; ++r) { a.pad = 8; hipLaunchKernelGGL(mk_fwd, dim3(grid), dim3(NWAVES * 64), LDS_BYTES, stream, a); }
            a.pad = 0; hipLaunchKernelGGL(mk_fwd, dim3(grid), dim3(NWAVES * 64), LDS_BYTES, stream, a); continue; }
        if (p == 2 && PROBE_REP == 20) {
            a.ph_lo = 2; a.ph_hi = 3; a.use_bar = 0;
            for (int r = 0; r + 1 < PROBE_N; ++r) { a.pad = 5; hipLaunchKernelGGL(mk_fwd, dim3(grid), dim3(NWAVES * 64), LDS_BYTES, stream, a); }
            a.pad = 0; hipLaunchKernelGGL(mk_fwd, dim3(grid), dim3(NWAVES * 64), LDS_BYTES, stream, a); continue; }
        if (p == 1 && PROBE_REP == 11) {
            a.ph_lo = 1; a.ph_hi = 2; a.use_bar = 0; a.pad = 16; hipLaunchKernelGGL(mk_fwd, dim3(grid), dim3(NWAVES * 64), LDS_BYTES, stream, a); a.pad = 0; continue; }
        if (p == 1 && PROBE_REP == 12) {
            a.ph_lo = 1; a.ph_hi = 2; a.use_bar = 0;
            for (int r = 0; r + 1 < PROBE_N; ++r) { a.pad = 128; hipLaunchKernelGGL(mk_fwd, dim3(grid), dim3(NWAVES * 64), LDS_BYTES, stream, a); }
            a.pad = 0; hipLaunchKernelGGL(mk_fwd, dim3(grid), dim3(NWAVES * 64), LDS_BYTES, stream, a); continue; }
        if (p == 4 && PROBE_REP == 41) {
            a.ph_lo = 4; a.ph_hi = 5; a.use_bar = 0;
            for (int r = 0; r + 1 < PROBE_N; ++r) { a.pad = 4 | (PROBE_ABL << 8); hipLaunchKernelGGL(mk_fwd, dim3(grid), dim3(NWAVES * 64), LDS_BYTES, stream, a); }
            a.pad = 0; hipLaunchKernelGGL(mk_fwd, dim3(grid), dim3(NWAVES * 64), LDS_BYTES, stream, a); continue; }
        if (p == 3 && PROBE_REP == 36) {
            a.ph_lo = 3; a.ph_hi = 4; a.use_bar = 0;
            for (int r = 0; r + 1 < PROBE_N; ++r) { a.pad = 1; hipLaunchKernelGGL(mk_fwd, dim3(grid), dim3(NWAVES * 64), LDS_BYTES, stream, a); }
            a.pad = 0; hipLaunchKernelGGL(mk_fwd, dim3(grid), dim3(NWAVES * 64), LDS_BYTES, stream, a); continue; }
        if (p == 3 && PROBE_REP == 37) {
            a.ph_lo = 3; a.ph_hi = 4; a.use_bar = 0;
            for (int r = 0; r + 1 < PROBE_N; ++r) { a.pad = 8; hipLaunchKernelGGL(mk_fwd, dim3(grid), dim3(NWAVES * 64), LDS_BYTES, stream, a); (void)hipMemsetAsync((char*)d_ws + WS_CTL, 0, 4096, stream); }
            a.pad = 0; hipLaunchKernelGGL(mk_fwd, dim3(grid), dim3(NWAVES * 64), LDS_BYTES, stream, a); continue; }
        if (p == 3 && PROBE_REP == 35) {
            a.ph_lo = 3; a.ph_hi = 4; a.use_bar = 0;
            for (int r = 0; r + 1 < PROBE_N; ++r) { a.pad = 2 | 8 | (PROBE_ABL << 8); hipLaunchKernelGGL(mk_fwd, dim3(grid), dim3(NWAVES * 64), LDS_BYTES, stream, a); (void)hipMemsetAsync((char*)d_ws + WS_CTL, 0, 4096, stream); }
            a.pad = 0; hipLaunchKernelGGL(mk_fwd, dim3(grid), dim3(NWAVES * 64), LDS_BYTES, stream, a); continue; }
        if (p == 3 && PROBE_REP >= 30 && PROBE_REP < 40) {
            a.ph_lo = 3; a.ph_hi = 4; a.use_bar = 0;
            for (int r = 0; r < (PROBE_REP == 30 ? 1 : PROBE_N); ++r) { a.pad = (r + 1 < (PROBE_REP == 30 ? 1 : PROBE_N)) ? 5 : 1; hipLaunchKernelGGL(mk_fwd, dim3(grid), dim3(NWAVES * 64), LDS_BYTES, stream, a); }
            a.pad = 2; hipLaunchKernelGGL(mk_fwd, dim3(grid), dim3(NWAVES * 64), LDS_BYTES, stream, a); a.pad = 0; continue; }
        for (int r = 0; r < nrep; ++r) { a.ph_lo = p; a.ph_hi = p + 1; a.use_bar = 0; hipLaunchKernelGGL(mk_fwd, dim3(grid), dim3(NWAVES * 64), LDS_BYTES, stream, a); } }
#endif
}
```

```cpp
#include <hip/hip_runtime.h>
#include <cstdio>
#include <cstdint>
#include <cmath>
namespace pg8 {
#define PG8_LAS __attribute__((address_space(3)))
typedef unsigned short bf16_t;
typedef short bf16x8 __attribute__((ext_vector_type(8)));
typedef float f32x4 __attribute__((ext_vector_type(4)));
typedef unsigned u32x4 __attribute__((ext_vector_type(4)));
constexpr int BM = 256, BK = 64, HALF = 128, HTB = HALF * BK * 2  , STAGE_BYTES = 8 * HTB, NXCD = 8, WGM = 8;

__host__ __device__ __forceinline__ int lds_byte(int r, int c) { const int st = (r >> 4) * 2 + (c >> 5), rr = r & 15, cc = c & 31, ob = rr * 64 + cc * 2; return st * 1024 + (ob ^ (((ob >> 9) & 1) << 5)); }
__host__ __device__ __forceinline__ void stage_rc(int b, int& R, int& C) { const int st = b / 1024, sb = b % 1024, swz = sb ^ (((sb >> 9) & 1) << 5); R = (st >> 1) * 16 + swz / 64; C = (st & 1) * 32 + (swz % 64) / 2; }
__host__ __device__ __forceinline__ int perm32(int rho) { const int n = rho >> 4, i = rho & 15; return 8 * (i >> 2) + 4 * n + (i & 3); }

template <class E> struct epi_has_post { static constexpr bool v = false; };
struct Unit { int pm, pn; };
struct Gemm { const bf16_t* A; const bf16_t* Bt; int M, N, K; const bf16_t* A2 = nullptr; const bf16_t* Bt2 = nullptr; };

struct StaticOrder {
    int nM, nN, nwg, G, c;
    __host__ __device__ void init(int M, int N, int G_, int c_) { nM = M / BM; nN = N / BM; nwg = nM * nN; G = G_; c = c_; }
    __host__ __device__ bool next(int i, Unit& u) const {
        const long L = (long)i * G + c; if (L >= nwg) return false;
        int wgid = (int)L; { const int q = nwg / NXCD, r = nwg % NXCD, xcd = wgid % NXCD, off = wgid / NXCD; wgid = (xcd < r ? xcd * (q + 1) : r * (q + 1) + (xcd - r) * q) + off; }
        const int nig = WGM * nN, gid = wgid / nig, fm = gid * WGM, gsz = (nM - fm) < WGM ? (nM - fm) : WGM;
        u.pm = fm + ((wgid % nig) % gsz); u.pn = (wgid % nig) / gsz; return true;
    }
    __device__ __forceinline__ void a_ready(const Unit&) const {}
    __device__ __forceinline__ void done(const Unit&) const {}
};

__device__ __forceinline__ unsigned cvt_pk_bf16(float lo, float hi) { unsigned r; asm volatile("v_cvt_pk_bf16_f32 %0, %1, %2" : "=v"(r) : "v"(lo), "v"(hi)); return r; }
typedef float f32x2 __attribute__((ext_vector_type(2)));
typedef unsigned u32x2 __attribute__((ext_vector_type(2)));
__device__ __forceinline__ float bflo(unsigned w) { return __uint_as_float(w << 16); }
__device__ __forceinline__ float bfhi(unsigned w) { return __uint_as_float(w & 0xffff0000u); }
__device__ __forceinline__ float sigm(float x) { return __builtin_amdgcn_rcpf(1.0f + __builtin_amdgcn_exp2f(-1.4426950408889634f * x)); }

struct EpiProj {
    static constexpr bool PERM = true, AFTER_DRAIN = false;
    static constexpr size_t MB = 1u << 20, O_QG = 48 * MB, O_KG = 80 * MB, O_VG = 112 * MB, O_R = 176 * MB, O_SQ = 240 * MB, O_SK = 304 * MB, O_SV = 320 * MB, O_GA = 336 * MB, O_GB = 400 * MB;
    unsigned char* ws; int skip;
    __device__ __forceinline__ void operator()(const f32x4 (&acc)[2][2][4][2], const Unit& u, int wr, int wc, int fr, int fq) const { part(acc, u, wr, wc, fr, fq, 0); part(acc, u, wr, wc, fr, fq, 1); }
    __device__ __forceinline__ void part(const f32x4 (&acc)[2][2][4][2], const Unit& u, int wr, int wc, int fr, int fq, const int ai) const {
        if (skip) { asm volatile("" :: "v"(acc[0][0][0][0]), "v"(acc[1][1][3][1])); return; }
        const int pn = u.pn; size_t off; int ldc, ct; float sc = 1.f;
        if (pn < 2) { off = O_QG; ldc = 512; ct = pn * 256; sc = 0.08838834764831845f; }
        else if (pn < 4) { off = O_KG; ldc = 512; ct = (pn - 2) * 256; }
        else if (pn < 8) { off = O_VG; ldc = 1024; ct = (pn - 4) * 256; }
        else if (pn < 12) { off = O_R; ldc = 1024; ct = (pn - 8) * 256; }
        else if (pn < 16) { off = O_SQ; ldc = 1024; ct = (pn - 12) * 256; }
        else if (pn == 16) { off = O_SK; ldc = 256; ct = 0; }
        else if (pn == 17) { off = O_SV; ldc = 256; ct = 0; }
        else if (pn < 22) { off = O_GA; ldc = 1024; ct = (pn - 18) * 256; }
        else { off = O_GB; ldc = 1024; ct = (pn - 22) * 256; }
        bf16_t* base = (bf16_t*)(ws + off);
        const int row0 = u.pm * BM + wr * 64 + fr, col0 = ct + wc * 32 + 8 * fq;
#pragma unroll
            for (int m = 0; m < 4; ++m) { bf16_t* rowp = base + (size_t)(row0 + ai * HALF + m * 16) * ldc + col0;
#pragma unroll
                for (int bj = 0; bj < 2; ++bj) { const f32x4 v0 = acc[ai][bj][m][0] * sc, v1 = acc[ai][bj][m][1] * sc;
                    u32x4 w; w.x = cvt_pk_bf16(v0[0], v0[1]); w.y = cvt_pk_bf16(v0[2], v0[3]); w.z = cvt_pk_bf16(v1[0], v1[1]); w.w = cvt_pk_bf16(v1[2], v1[3]);
                    *(u32x4*)(rowp + bj * HALF) = w; } }
    }
};
struct QkPost {
    bf16_t *SQ, *SK; const float *rope, *g_q, *g_k; float qsc;
    __device__ __forceinline__ void post(const Unit& u, int tid) const {
        const int wave = tid >> 6, lane = tid & 63, slot = lane >> 3, c = lane & 7; const bool isq = u.pn < 16;
        bf16_t* base = isq ? SQ + (size_t)(u.pn - 12) * 256 : SK; const int ldc = isq ? 1024 : 256; const float* gn = isq ? g_q : g_k; const float sc = isq ? qsc : 1.f;
        const f32x4 g10 = *(const f32x4*)(gn + 8 * c), g11 = *(const f32x4*)(gn + 8 * c + 4), g20 = *(const f32x4*)(gn + 64 + 8 * c), g21 = *(const f32x4*)(gn + 64 + 8 * c + 4);
#pragma unroll 1
        for (int rd = 0; rd < 2; ++rd) {
            u32x4 a1[4], a2[4]; f32x4 cs[4][4]; bf16_t* pp[4];
#pragma unroll
            for (int q = 0; q < 4; ++q) { const int idx = ((rd * 4 + q) * 8 + wave) * 8 + slot, row = u.pm * BM + (idx >> 1), pos = row & 4095;
                pp[q] = base + (size_t)row * ldc + (idx & 1) * 128; a1[q] = *(const u32x4*)(pp[q] + 8 * c); a2[q] = *(const u32x4*)(pp[q] + 64 + 8 * c);
                const f32x4* rp = (const f32x4*)(rope + 2 * (pos * 64 + 8 * c));
#pragma unroll
                for (int j = 0; j < 4; ++j) cs[q][j] = rp[j]; }
#pragma unroll
            for (int q = 0; q < 4; ++q) { float x1[8], x2[8];
                x1[0] = bflo(a1[q].x); x1[1] = bfhi(a1[q].x); x1[2] = bflo(a1[q].y); x1[3] = bfhi(a1[q].y); x1[4] = bflo(a1[q].z); x1[5] = bfhi(a1[q].z); x1[6] = bflo(a1[q].w); x1[7] = bfhi(a1[q].w);
                x2[0] = bflo(a2[q].x); x2[1] = bfhi(a2[q].x); x2[2] = bflo(a2[q].y); x2[3] = bfhi(a2[q].y); x2[4] = bflo(a2[q].z); x2[5] = bfhi(a2[q].z); x2[6] = bflo(a2[q].w); x2[7] = bfhi(a2[q].w);
                float ss = 0.f;
#pragma unroll
                for (int e = 0; e < 8; ++e) ss += x1[e] * x1[e] + x2[e] * x2[e];
                ss += __shfl_xor(ss, 1); ss += __shfl_xor(ss, 2); ss += __shfl_xor(ss, 4);
                const float rstd = sc * __builtin_amdgcn_rsqf(ss * (1.f / 128.f) + 1e-6f);
                float o1[8], o2[8];
#pragma unroll
                for (int e = 0; e < 8; ++e) { const float y1 = x1[e] * rstd * (e < 4 ? g10[e & 3] : g11[e & 3]), y2 = x2[e] * rstd * (e < 4 ? g20[e & 3] : g21[e & 3]);
                    const float cc = cs[q][e >> 1][2 * (e & 1)], sn = cs[q][e >> 1][2 * (e & 1) + 1]; o1[e] = y1 * cc - y2 * sn; o2[e] = y2 * cc + y1 * sn; }
                u32x4 w1, w2; w1.x = cvt_pk_bf16(o1[0], o1[1]); w1.y = cvt_pk_bf16(o1[2], o1[3]); w1.z = cvt_pk_bf16(o1[4], o1[5]); w1.w = cvt_pk_bf16(o1[6], o1[7]);
                w2.x = cvt_pk_bf16(o2[0], o2[1]); w2.y = cvt_pk_bf16(o2[2], o2[3]); w2.z = cvt_pk_bf16(o2[4], o2[5]); w2.w = cvt_pk_bf16(o2[6], o2[7]);
                *(u32x4*)(pp[q] + 8 * c) = w1; *(u32x4*)(pp[q] + 64 + 8 * c) = w2; }
        }
    }
};
struct EpiMerge2 {
    static constexpr bool PERM = true, AFTER_DRAIN = false;
    const bf16_t* ga; const bf16_t* gb; bf16_t* out;
    __device__ __forceinline__ void mid(f32x4 (&acc)[2][2][4][2], const Unit& u, int wr, int wc, int fr, int fq) const {
        int row0 = u.pm * BM + wr * 64 + fr, col0 = u.pn * BM + wc * 32 + 8 * fq; asm volatile("" : "+v"(row0), "+v"(col0));
#pragma unroll
        for (int ai = 0; ai < 2; ++ai)
#pragma unroll
            for (int m = 0; m < 4; ++m) { const size_t off = (size_t)(row0 + ai * HALF + m * 16) * 1024 + col0;
#pragma unroll
                for (int bj = 0; bj < 2; ++bj) { const size_t o2 = off + bj * HALF; const u32x4 a = *(const u32x4*)(ga + o2), b = *(const u32x4*)(gb + o2);
#define PG8_RATIO(aw, bw) ((1.0f + __builtin_amdgcn_exp2f(-1.4426950408889634f * (bw))) * __builtin_amdgcn_rcpf(1.0f + __builtin_amdgcn_exp2f(-1.4426950408889634f * (aw))))
                    acc[ai][bj][m][0][0] *= PG8_RATIO(bflo(a.x), bflo(b.x)); acc[ai][bj][m][0][1] *= PG8_RATIO(bfhi(a.x), bfhi(b.x)); acc[ai][bj][m][0][2] *= PG8_RATIO(bflo(a.y), bflo(b.y)); acc[ai][bj][m][0][3] *= PG8_RATIO(bfhi(a.y), bfhi(b.y));
                    acc[ai][bj][m][1][0] *= PG8_RATIO(bflo(a.z), bflo(b.z)); acc[ai][bj][m][1][1] *= PG8_RATIO(bfhi(a.z), bfhi(b.z)); acc[ai][bj][m][1][2] *= PG8_RATIO(bflo(a.w), bflo(b.w)); acc[ai][bj][m][1][3] *= PG8_RATIO(bfhi(a.w), bfhi(b.w));
#undef PG8_RATIO
                }
                if (m & 1) asm volatile("" ::: "memory"); }
    }
    __device__ __forceinline__ void operator()(const f32x4 (&acc)[2][2][4][2], const Unit& u, int wr, int wc, int fr, int fq) const {
        int row0 = u.pm * BM + wr * 64 + fr, col0 = u.pn * BM + wc * 32 + 8 * fq; asm volatile("" : "+v"(row0), "+v"(col0));
#pragma unroll
        for (int ai = 0; ai < 2; ++ai)
#pragma unroll
            for (int m = 0; m < 4; ++m) { const size_t off = (size_t)(row0 + ai * HALF + m * 16) * 1024 + col0;
#pragma unroll
                for (int bj = 0; bj < 2; ++bj) { const size_t o2 = off + bj * HALF; const u32x4 g = *(const u32x4*)(gb + o2);
                    const f32x4 a0 = acc[ai][bj][m][0], a1 = acc[ai][bj][m][1];
                    u32x4 w; w.x = cvt_pk_bf16(a0[0] * sigm(bflo(g.x)), a0[1] * sigm(bfhi(g.x))); w.y = cvt_pk_bf16(a0[2] * sigm(bflo(g.y)), a0[3] * sigm(bfhi(g.y)));
                    w.z = cvt_pk_bf16(a1[0] * sigm(bflo(g.z)), a1[1] * sigm(bfhi(g.z))); w.w = cvt_pk_bf16(a1[2] * sigm(bflo(g.w)), a1[3] * sigm(bfhi(g.w)));
                    *(u32x4*)(out + o2) = w; } }
    }
};
struct EpiX1 {
    static constexpr bool PERM = true, AFTER_DRAIN = false;
    const float* x; bf16_t* xb; float* ssq;
    __device__ __forceinline__ void operator()(const f32x4 (&acc)[2][2][4][2], const Unit& u, int wr, int wc, int fr, int fq) const {
        const int row0 = u.pm * BM + wr * 64 + fr, col0 = u.pn * BM + wc * 32 + 8 * fq;
#pragma unroll
        for (int ai = 0; ai < 2; ++ai)
#pragma unroll
            for (int m = 0; m < 4; ++m) { const int row = row0 + ai * HALF + m * 16; const size_t off = (size_t)row * 1024 + col0; float s = 0.f;
#pragma unroll
                for (int bj = 0; bj < 2; ++bj) { const size_t o2 = off + bj * HALF;
                    const f32x4 v0 = *(const f32x4*)(x + o2) + acc[ai][bj][m][0], v1 = *(const f32x4*)(x + o2 + 4) + acc[ai][bj][m][1];
                    s += ((v0[0] * v0[0] + v0[1] * v0[1]) + (v0[2] * v0[2] + v0[3] * v0[3])) + ((v1[0] * v1[0] + v1[1] * v1[1]) + (v1[2] * v1[2] + v1[3] * v1[3]));
                    u32x4 w; w.x = cvt_pk_bf16(v0[0], v0[1]); w.y = cvt_pk_bf16(v0[2], v0[3]); w.z = cvt_pk_bf16(v1[0], v1[1]); w.w = cvt_pk_bf16(v1[2], v1[3]); *(u32x4*)(xb + o2) = w; }
                s += __shfl_xor(s, 16); s += __shfl_xor(s, 32);
                if (fq == 0) ssq[(size_t)row * 16 + u.pn * 4 + wc] = s; }
    }
};
struct EpiSwiGLU {
    static constexpr bool PERM = true, AFTER_DRAIN = false;
    const float* ssq; bf16_t* H;
    __device__ __forceinline__ void operator()(const f32x4 (&acc)[2][2][4][2], const Unit& u, int wr, int wc, int fr, int fq) const {
        const int row0 = u.pm * BM + wr * 64 + fr, col0 = u.pn * HALF + wc * 32 + 8 * fq;
#pragma unroll
        for (int ai = 0; ai < 2; ++ai)
#pragma unroll
            for (int m = 0; m < 4; ++m) { const int row = row0 + ai * HALF + m * 16; const f32x4* sp = (const f32x4*)(ssq + (size_t)row * 16);
                const f32x4 s0 = sp[0], s1 = sp[1], s2 = sp[2], s3 = sp[3]; const f32x4 st = (s0 + s1) + (s2 + s3);
                const float rstd = __builtin_amdgcn_rsqf(((st[0] + st[1]) + (st[2] + st[3])) * (1.0f / 1024.0f) + 1e-6f);
                float hv[8];
#pragma unroll
                for (int n = 0; n < 2; ++n)
#pragma unroll
                    for (int e = 0; e < 4; ++e) { const float g = acc[ai][0][m][n][e] * rstd, up = acc[ai][1][m][n][e] * rstd; hv[4 * n + e] = g * sigm(g) * up; }
                u32x4 w; w.x = cvt_pk_bf16(hv[0], hv[1]); w.y = cvt_pk_bf16(hv[2], hv[3]); w.z = cvt_pk_bf16(hv[4], hv[5]); w.w = cvt_pk_bf16(hv[6], hv[7]);
                *(u32x4*)(H + (size_t)row * 2816 + col0) = w; }
    }
};
struct EpiResid {
    static constexpr bool PERM = true, AFTER_DRAIN = false;
    const bf16_t* xb; float* out;
    __device__ __forceinline__ void operator()(const f32x4 (&acc)[2][2][4][2], const Unit& u, int wr, int wc, int fr, int fq) const {
        const int row0 = u.pm * BM + wr * 64 + fr, col0 = u.pn * BM + wc * 32 + 8 * fq;
#pragma unroll
        for (int ai = 0; ai < 2; ++ai)
#pragma unroll
            for (int m = 0; m < 4; ++m) { const size_t off = (size_t)(row0 + ai * HALF + m * 16) * 1024 + col0;
#pragma unroll
                for (int bj = 0; bj < 2; ++bj) { const size_t o2 = off + bj * HALF; const u32x4 xw = *(const u32x4*)(xb + o2);
                    *(f32x4*)(out + o2) = (f32x4){bflo(xw.x), bfhi(xw.x), bflo(xw.y), bfhi(xw.y)} + acc[ai][bj][m][0];
                    *(f32x4*)(out + o2 + 4) = (f32x4){bflo(xw.z), bfhi(xw.z), bflo(xw.w), bfhi(xw.w)} + acc[ai][bj][m][1]; } }
    }
};

template <class Epi, class Sched, bool ALIGN_EPI = false, bool SP2 = false, bool DUAL = false, bool SPLIT_EPI = false>
__device__ __forceinline__ void gemm_phase(PG8_LAS unsigned char* lds, const Gemm g, const Sched& S, const Epi& E) {
    const int tid = threadIdx.x, wid = __builtin_amdgcn_readfirstlane(tid >> 6), lane = tid & 63, wr = wid >> 2, wc = wid & 3, fr = lane & 15, fq = lane >> 4;
    const int K = g.K, TS = K / BK, nt = DUAL ? 2 * TS : TS;
    unsigned voffA[2], voffB[2];
#pragma unroll
    for (int i = 0; i < 2; ++i) { int R, C; stage_rc(tid * 16 + i * 8192, R, C); const int Rb = Epi::PERM ? ((R & ~31) + perm32(R & 31)) : R;
        voffA[i] = (unsigned)(R * K + C) * 2u; voffB[i] = (unsigned)(Rb * K + C) * 2u; }
    const size_t kstep = (size_t)(BK * 2);
    const size_t hstep = (size_t)HALF * K * 2;
    const size_t tstep = 2 * hstep;
    const unsigned ldsw = (unsigned)wid * 1024u;
    const int aoff = lds_byte(wr * 64 + fr, fq * 8), boff = lds_byte(wc * 32 + fr, fq * 8);
#define PG8_SA(b, h) (((b) * 2 + (h)) * HTB)
#define PG8_SB(b, h) ((4 + (b) * 2 + (h)) * HTB)
#define PG8_STAGE(bufoff, gbase, voff) do { _Pragma("unroll") for (int _i = 0; _i < 2; ++_i) \
        __builtin_amdgcn_global_load_lds((const unsigned*)((const char*)(gbase) + (voff)[_i]), (PG8_LAS unsigned*)(lds + (bufoff) + ldsw + _i * 8192), 16, 0, 0); } while (0)
#define PG8_LDA(dst, b, h) do { _Pragma("unroll") for (int m = 0; m < 4; ++m) _Pragma("unroll") for (int k = 0; k < 2; ++k) dst[m][k] = *(const PG8_LAS bf16x8*)(lds + PG8_SA(b, h) + aoff + m * 2048 + k * 1024); } while (0)
#define PG8_LDB(dst, b, h) do { _Pragma("unroll") for (int n = 0; n < 2; ++n) _Pragma("unroll") for (int k = 0; k < 2; ++k) dst[n][k] = *(const PG8_LAS bf16x8*)(lds + PG8_SB(b, h) + boff + n * 2048 + k * 1024); } while (0)
#define PG8_MMA(ai, bj, At, Bt) do { __builtin_amdgcn_s_setprio(1); _Pragma("unroll") for (int m = 0; m < 4; ++m) _Pragma("unroll") for (int n = 0; n < 2; ++n) _Pragma("unroll") for (int k = 0; k < 2; ++k) \
        acc[ai][bj][m][n] = __builtin_amdgcn_mfma_f32_16x16x32_bf16(Bt[n][k], At[m][k], acc[ai][bj][m][n], 0, 0, 0); __builtin_amdgcn_s_setprio(0); } while (0)
#define PG8_WAIT_V(n) asm volatile("s_waitcnt vmcnt(" #n ")" ::: "memory")
#define PG8_WAIT_L(n) asm volatile("s_waitcnt lgkmcnt(" #n ")" ::: "memory")
#define PG8_BAR __builtin_amdgcn_s_barrier()
#define PG8_SCHED __builtin_amdgcn_sched_barrier(0)
    Unit cur, nxt, prev; int ui = 0; bool have_prev = false; (void)prev; (void)have_prev;
    static_assert(!SPLIT_EPI || (SP2 && !ALIGN_EPI && !DUAL && !Epi::AFTER_DRAIN), "SPLIT_EPI geometry");
    if (!S.next(0, cur)) return;
    f32x4 acc[2][2][4][2];
#pragma unroll
    for (int a = 0; a < 2; ++a)
#pragma unroll
        for (int b = 0; b < 2; ++b)
#pragma unroll
            for (int m = 0; m < 4; ++m)
#pragma unroll
                for (int n = 0; n < 2; ++n) acc[a][b][m][n] = (f32x4){0.f, 0.f, 0.f, 0.f};
    bf16x8 At[4][2], B0[2][2], B1[2][2];
    const char* cA = (const char*)g.A + (size_t)cur.pm * tstep; const char* cB = (const char*)g.Bt + (size_t)cur.pn * tstep;
    const char* cA2 = DUAL ? (const char*)g.A2 + (size_t)cur.pm * tstep - (size_t)TS * kstep : cA; const char* cB2 = DUAL ? (const char*)g.Bt2 + (size_t)cur.pn * tstep - (size_t)TS * kstep : cB;
    S.a_ready(cur);
    if constexpr (SP2) {
        PG8_STAGE(PG8_SB(0, 0), cB, voffB); PG8_STAGE(PG8_SB(0, 1), cB + hstep, voffB); PG8_STAGE(PG8_SA(0, 0), cA, voffA); PG8_STAGE(PG8_SA(0, 1), cA + hstep, voffA);
        if (wr == 1) PG8_BAR;
        PG8_WAIT_V(2); PG8_BAR;
        PG8_STAGE(PG8_SB(1, 0), cB + kstep, voffB); PG8_STAGE(PG8_SA(1, 0), cA + kstep, voffA); PG8_STAGE(PG8_SB(1, 1), cB + hstep + kstep, voffB);
        PG8_WAIT_V(6); PG8_BAR;
    } else {
        PG8_STAGE(PG8_SB(0, 0), cB, voffB); PG8_STAGE(PG8_SA(0, 0), cA, voffA); PG8_STAGE(PG8_SB(0, 1), cB + hstep, voffB); PG8_STAGE(PG8_SA(0, 1), cA + hstep, voffA);
        if (wr == 1) PG8_BAR;
        PG8_WAIT_V(4); PG8_BAR;
        PG8_STAGE(PG8_SB(1, 0), cB + kstep, voffB); PG8_STAGE(PG8_SA(1, 0), cA + kstep, voffA); PG8_STAGE(PG8_SB(1, 1), cB + hstep + kstep, voffB);
        PG8_WAIT_V(6); PG8_BAR;
    }
    for (;;) {
        const bool has_next = S.next(ui + 1, nxt);
        const char* nA = has_next ? (const char*)g.A + (size_t)nxt.pm * tstep : cA; const char* nB = has_next ? (const char*)g.Bt + (size_t)nxt.pn * tstep : cB;
        const char* nA2 = (DUAL && has_next) ? (const char*)g.A2 + (size_t)nxt.pm * tstep - (size_t)TS * kstep : cA2; const char* nB2 = (DUAL && has_next) ? (const char*)g.Bt2 + (size_t)nxt.pn * tstep - (size_t)TS * kstep : cB2;
#pragma unroll
        for (int seg = 0; seg < (DUAL ? 2 : 1); ++seg) {
        if constexpr (DUAL) { if (seg == 1) E.mid(acc, cur, wr, wc, fr, fq); }
        for (int t = (seg ? TS : 0); t < ((DUAL && seg == 0) ? TS : nt); t += 2) {
            const bool last = (t == nt - 2);
            const char* a1 = ((DUAL && t + 1 >= TS) ? cA2 : cA) + (size_t)(t + 1) * kstep;
            const char* a2 = last ? nA : ((DUAL && t + 2 >= TS) ? cA2 : cA) + (size_t)(t + 2) * kstep; const char* b2 = last ? nB : ((DUAL && t + 2 >= TS) ? cB2 : cB) + (size_t)(t + 2) * kstep;
            const char* a3 = a2 + kstep; const char* b3 = b2 + kstep;
            if (last && has_next) S.a_ready(nxt);
            if constexpr (SP2) {
            PG8_LDB(B0, 0, 0); PG8_LDB(B1, 0, 1); PG8_SCHED; PG8_LDA(At, 0, 0); PG8_STAGE(PG8_SA(1, 1), a1 + hstep, voffA);
            PG8_WAIT_V(8); PG8_WAIT_L(0); PG8_BAR;
            if constexpr (SPLIT_EPI) { if (t == 0 && have_prev) { E.part(acc, prev, wr, wc, fr, fq, 1);
                _Pragma("unroll") for (int b_ = 0; b_ < 2; ++b_) _Pragma("unroll") for (int m_ = 0; m_ < 4; ++m_) _Pragma("unroll") for (int n_ = 0; n_ < 2; ++n_) acc[1][b_][m_][n_] = (f32x4){0.f, 0.f, 0.f, 0.f}; } }
            PG8_MMA(0, 0, At, B0); PG8_MMA(0, 1, At, B1); PG8_BAR; PG8_SCHED;
            PG8_LDA(At, 0, 1); PG8_STAGE(PG8_SB(0, 0), b2, voffB); PG8_STAGE(PG8_SB(0, 1), b2 + hstep, voffB); PG8_STAGE(PG8_SA(0, 0), a2, voffA);
            PG8_WAIT_V(8); PG8_WAIT_L(0); PG8_BAR; PG8_MMA(1, 0, At, B0); PG8_MMA(1, 1, At, B1); PG8_BAR; PG8_SCHED;
            PG8_LDB(B0, 1, 0); PG8_LDB(B1, 1, 1); PG8_SCHED; PG8_LDA(At, 1, 0); PG8_STAGE(PG8_SA(0, 1), a2 + hstep, voffA);
            PG8_WAIT_V(8); PG8_WAIT_L(0); PG8_BAR; PG8_MMA(0, 0, At, B0); PG8_MMA(0, 1, At, B1); PG8_BAR; PG8_SCHED;
            PG8_LDA(At, 1, 1); PG8_STAGE(PG8_SB(1, 0), b3, voffB); PG8_STAGE(PG8_SB(1, 1), b3 + hstep, voffB); PG8_STAGE(PG8_SA(1, 0), a3, voffA);
            PG8_WAIT_V(8); PG8_WAIT_L(0); PG8_BAR;
            if constexpr (SPLIT_EPI) { if (last) { E.part(acc, cur, wr, wc, fr, fq, 0);
                _Pragma("unroll") for (int b_ = 0; b_ < 2; ++b_) _Pragma("unroll") for (int m_ = 0; m_ < 4; ++m_) _Pragma("unroll") for (int n_ = 0; n_ < 2; ++n_) acc[0][b_][m_][n_] = (f32x4){0.f, 0.f, 0.f, 0.f}; } }
            PG8_MMA(1, 0, At, B0); PG8_MMA(1, 1, At, B1); PG8_BAR; PG8_SCHED;
            } else {
            PG8_LDB(B0, 0, 0); PG8_SCHED; PG8_LDA(At, 0, 0); PG8_STAGE(PG8_SA(1, 1), a1 + hstep, voffA);
            PG8_WAIT_L(8); PG8_BAR; PG8_WAIT_L(0); PG8_MMA(0, 0, At, B0); PG8_BAR; PG8_SCHED;
            PG8_LDB(B1, 0, 1); PG8_STAGE(PG8_SB(0, 0), b2, voffB);
            PG8_BAR; PG8_WAIT_L(0); PG8_MMA(0, 1, At, B1); PG8_BAR;
            PG8_LDA(At, 0, 1); PG8_STAGE(PG8_SA(0, 0), a2, voffA);
            PG8_BAR; PG8_WAIT_L(0); PG8_MMA(1, 0, At, B0); PG8_BAR; PG8_SCHED;
            PG8_STAGE(PG8_SB(0, 1), b2 + hstep, voffB);
            PG8_WAIT_V(6); PG8_BAR; PG8_MMA(1, 1, At, B1); PG8_BAR;
            PG8_LDB(B0, 1, 0); PG8_SCHED; PG8_LDA(At, 1, 0); PG8_STAGE(PG8_SA(0, 1), a2 + hstep, voffA);
            PG8_WAIT_L(8); PG8_BAR; PG8_WAIT_L(0); PG8_MMA(0, 0, At, B0); PG8_BAR; PG8_SCHED;
            PG8_LDB(B1, 1, 1); PG8_STAGE(PG8_SB(1, 0), b3, voffB);
            PG8_BAR; PG8_WAIT_L(0); PG8_MMA(0, 1, At, B1); PG8_BAR;
            PG8_LDA(At, 1, 1); PG8_STAGE(PG8_SA(1, 0), a3, voffA);
            PG8_BAR; PG8_WAIT_L(0); PG8_MMA(1, 0, At, B0); PG8_BAR; PG8_SCHED;
            PG8_STAGE(PG8_SB(1, 1), b3 + hstep, voffB);
            PG8_WAIT_V(6); PG8_BAR; PG8_MMA(1, 1, At, B1); PG8_BAR;
            }
        }
        }
        if constexpr (SPLIT_EPI) { prev = cur; have_prev = true; if (!has_next) break; cur = nxt; cA = nA; cB = nB; cA2 = nA2; cB2 = nB2; ++ui; continue; }
        if constexpr (ALIGN_EPI) { if (wr == 0) PG8_BAR; }
        if constexpr (!Epi::AFTER_DRAIN) { E(acc, cur, wr, wc, fr, fq); S.done(cur); }
        if constexpr (ALIGN_EPI && epi_has_post<Epi>::v) {
            if (E.need_post(cur)) { PG8_WAIT_V(0); PG8_WAIT_L(0); PG8_BAR; asm volatile("" ::: "memory"); E.post(cur, tid); } }
        if (!has_next) break;
#pragma unroll
        for (int a = 0; a < 2; ++a)
#pragma unroll
            for (int b = 0; b < 2; ++b)
#pragma unroll
                for (int m = 0; m < 4; ++m)
#pragma unroll
                    for (int n = 0; n < 2; ++n) acc[a][b][m][n] = (f32x4){0.f, 0.f, 0.f, 0.f};
        cur = nxt; cA = nA; cB = nB; cA2 = nA2; cB2 = nB2; ++ui;
        if constexpr (ALIGN_EPI) { if (wr == 1) PG8_BAR; }
    }
    PG8_WAIT_V(0);
    if constexpr (!ALIGN_EPI) { if (wr == 0) PG8_BAR; }
    PG8_BAR;
    if constexpr (Epi::AFTER_DRAIN) { E.fused(acc, cur, wr, wc, fr, fq, lds, wid, lane); S.done(cur); }
    if constexpr (SPLIT_EPI) { if (have_prev) E.part(acc, prev, wr, wc, fr, fq, 1); }
#undef PG8_SA
#undef PG8_SB
#undef PG8_STAGE
#undef PG8_LDA
#undef PG8_LDB
#undef PG8_MMA
#undef PG8_WAIT_V
#undef PG8_WAIT_L
#undef PG8_BAR
#undef PG8_SCHED
}
}
#define GAS __attribute__((address_space(1)))
#define LAS __attribute__((address_space(3)))
typedef unsigned short bf16;
typedef unsigned v4u __attribute__((ext_vector_type(4)));
typedef float f32x4 __attribute__((ext_vector_type(4)));
typedef short bf16x8 __attribute__((ext_vector_type(8)));
typedef GAS unsigned gu32;
typedef GAS unsigned long long gu64;
#define RLX_AGENT __ATOMIC_RELAXED, __HIP_MEMORY_SCOPE_AGENT
#define LDS_WAIT() asm volatile("s_waitcnt lgkmcnt(0)" ::: "memory")
#define VM_WAIT() asm volatile("s_waitcnt vmcnt(0)" ::: "memory")
__device__ __forceinline__ unsigned long long rt() { return __builtin_amdgcn_s_memrealtime(); }
__device__ __forceinline__ unsigned f2bf(float f) { unsigned u = __builtin_bit_cast(unsigned, f); return (u + 0x7fffu + ((u >> 16) & 1u)) >> 16; }
__device__ __forceinline__ unsigned pk2(float lo, float hi) { return f2bf(lo) | (f2bf(hi) << 16); }
constexpr int NWAVES = 8;
#ifndef GLA_MFMA
#define GLA_MFMA 1
#endif
#ifndef SWA_MFMA
#define SWA_MFMA 1
#endif
constexpr int BATCH = 8, SEQ = 4096, DM = 1024, M = BATCH * SEQ;
constexpr int NPROJ = 6656;
constexpr int DFF = 2816;
constexpr float EPS = 1e-6f;
constexpr size_t MiB = 1u << 20;
constexpr size_t WS_CTL = 0, CTL_ZERO_BYTES = 1 * MiB;
constexpr size_t WS_WIN = 1 * MiB;
constexpr size_t WS_WLR = 14 * MiB;
constexpr size_t WS_WG = 15 * MiB, WS_WS = 17 * MiB, WS_WOUT = 19 * MiB;
constexpr size_t WS_WFI = 21 * MiB;
constexpr size_t WS_WFO = 32 * MiB;
constexpr size_t WS_ROPE = 38 * MiB;
constexpr size_t WS_LR = 40 * MiB;
constexpr size_t WS_SSQ = 44 * MiB;
constexpr size_t WS_QG = 48 * MiB, WS_KG = 80 * MiB;
constexpr size_t WS_VG = 112 * MiB, WS_R = 176 * MiB, WS_SQ = 240 * MiB;
constexpr size_t WS_SK = 304 * MiB, WS_SV = 320 * MiB;
constexpr size_t WS_GA = 336 * MiB, WS_GB = 400 * MiB;
constexpr size_t WS_END = 464 * MiB;
constexpr size_t WS_DUMMY = 500 * MiB;
constexpr size_t WS_MERGED = WS_VG;
constexpr size_t WS_X1B = WS_QG;
constexpr size_t WS_H = WS_SQ;
static_assert(WS_H + (size_t)M * DFF * 2 <= WS_END, "h overlay");
constexpr int CW_TMO = 0, CW_CODE = 1;
constexpr int CW_BAR = 4096;
constexpr int RING_OFF = 0, RING_BYTES = 131072;
constexpr int LDS_BYTES = 163840;
constexpr int LDSCTL_OFF = LDS_BYTES - 1024, MISC_OFF = LDSCTL_OFF + 320;
static_assert(MISC_OFF + 128 <= LDS_BYTES, "LDS map");

#define XB_TMO      128
#define XB_XCNT(j)  (256  + 64 * (j))
#define XB_XSUB(j)  (1280 + 64 * (j))
#define XB_XGEN(j)  (2304 + 64 * (j))
#define XB_TOP      3328
#define XB_TOPGEN   3392
#define XCD_BAR_WORDS 3456
#define XB_SPIN_CAP (1u << 18)

__device__ __forceinline__ unsigned xb_ld(unsigned* p)              { return __hip_atomic_load(p, __ATOMIC_RELAXED, __HIP_MEMORY_SCOPE_AGENT); }
__device__ __forceinline__ unsigned xb_add(unsigned* p, unsigned v) { return __hip_atomic_fetch_add(p, v, __ATOMIC_RELAXED, __HIP_MEMORY_SCOPE_AGENT); }
__device__ __forceinline__ unsigned xb_xcc_id() { return (unsigned)__builtin_amdgcn_s_getreg((3 << 11) | 20) & 0xFu; }
#define XB_SPIN(cond, bar) do { unsigned _sp = 0; while (cond) { __builtin_amdgcn_s_sleep(1); \
    if ((++_sp & 255u) == 0u) { if (xb_ld(&(bar)[XB_TMO])) break; if (_sp > XB_SPIN_CAP) { atomicAdd(&(bar)[XB_TMO], 1u); break; } } } } while (0)

struct XcdBarrier {
    unsigned* bar; unsigned x;
    volatile LAS unsigned* st;
};

__device__ __forceinline__ XcdBarrier xcd_barrier_post(unsigned* bar, volatile LAS unsigned* st) {
    XcdBarrier b; b.bar = bar; b.x = xb_xcc_id(); b.st = st;
    if (threadIdx.x == 0) (void)xb_add(&bar[XB_XCNT(b.x)], 1u);
    return b;
}
__device__ __forceinline__ void xcd_barrier_complete(unsigned* bar, unsigned x, unsigned& nloc, unsigned& nx) {
    const unsigned G = gridDim.x * gridDim.y * gridDim.z;
    unsigned sum, cnt, mine, sp = 0u;
    for (;;) {
        sum = 0u; cnt = 0u; mine = 0u;
#pragma unroll
        for (unsigned j = 0; j < 16; ++j) { const unsigned c = xb_ld(&bar[XB_XCNT(j)]); sum += c; cnt += (c > 0u) ? 1u : 0u; mine = (j == x) ? c : mine; }
        if (sum == G) break;
        __builtin_amdgcn_s_sleep(1);
        if ((++sp & 255u) == 0u) { if (xb_ld(&bar[XB_TMO])) break; if (sp > XB_SPIN_CAP) { atomicAdd(&bar[XB_TMO], 1u); break; } }
    }
    nloc = mine > 0u ? mine : 1u; nx = cnt > 0u ? cnt : 1u;
}

__device__ __forceinline__ void xcd_barrier(const XcdBarrier& b) {
    asm volatile("s_waitcnt vmcnt(0)" ::: "memory");
    __syncthreads();
    if (threadIdx.x == 0) {
        unsigned* bar = b.bar;
        __builtin_amdgcn_s_waitcnt(0);
        unsigned nloc = b.st[0], nx = b.st[1];
        if (nloc == 0u) { xcd_barrier_complete(bar, b.x, nloc, nx); b.st[0] = nloc; b.st[1] = nx; }
        const unsigned old = xb_add(&bar[XB_XSUB(b.x)], 1u);
        const unsigned gen = old / nloc;
        if (old + 1u == (gen + 1u) * nloc) {
            __builtin_amdgcn_fence(__ATOMIC_RELEASE, "agent");
            asm volatile("s_waitcnt vmcnt(0)" ::: "memory");
            const unsigned og = xb_add(&bar[XB_TOP], 1u);
            const unsigned tg = og / nx;
            if (og + 1u == (tg + 1u) * nx) xb_add(&bar[XB_TOPGEN], 1u);
            else XB_SPIN(xb_ld(&bar[XB_TOPGEN]) == tg, bar);
            __builtin_amdgcn_fence(__ATOMIC_ACQUIRE, "agent");
            xb_add(&bar[XB_XGEN(b.x)], 1u);
            asm volatile("s_waitcnt vmcnt(0)" ::: "memory");
        } else {
            XB_SPIN(xb_ld(&bar[XB_XGEN(b.x)]) == gen, bar);
            __builtin_amdgcn_fence(__ATOMIC_ACQUIRE, "agent");
            asm volatile("s_waitcnt vmcnt(0)" ::: "memory");
        }
    }
    __syncthreads();
}

typedef unsigned u32x2 __attribute__((ext_vector_type(2)));
__device__ __forceinline__ const float* inp(int i) { const float* const* ka = (const float* const*)__builtin_amdgcn_kernarg_segment_ptr(); asm volatile("" : "+s"(ka)); return ka[i]; }
enum { I_X = 0, I_GMIX, I_WIN, I_UPF, I_BIASF, I_UPB, I_BIASB, I_GGLA, I_WOG, I_GQ, I_GK, I_SINKS, I_WOS, I_WOUT, I_GFFN, I_WFI, I_WFO };
struct Frame {
    LAS unsigned char* lds;
    volatile LAS unsigned* MISC;
    gu32* ctl;
    unsigned char* ws; float* out;
    int tid, lane, wave;
    int vcu, G;
#define WSPTR(name, T, off) __device__ __forceinline__ T* name() const { return (T*)(ws + (off)); }
    WSPTR(WIN, bf16, WS_WIN) WSPTR(WLR, bf16, WS_WLR) WSPTR(WG, bf16, WS_WG) WSPTR(WS_, bf16, WS_WS) WSPTR(WOUT, bf16, WS_WOUT) WSPTR(WFI, bf16, WS_WFI) WSPTR(WFO, bf16, WS_WFO)
    WSPTR(ROPE, float, WS_ROPE) WSPTR(LR, float, WS_LR) WSPTR(SSQ, float, WS_SSQ)
    WSPTR(QG, bf16, WS_QG) WSPTR(KG, bf16, WS_KG) WSPTR(VG, bf16, WS_VG) WSPTR(R, bf16, WS_R) WSPTR(SQ, bf16, WS_SQ) WSPTR(SK, bf16, WS_SK) WSPTR(SV, bf16, WS_SV)
    WSPTR(GA, bf16, WS_GA) WSPTR(GB, bf16, WS_GB) WSPTR(MERGED, bf16, WS_MERGED) WSPTR(X1B, bf16, WS_X1B) WSPTR(H, bf16, WS_H)
#undef WSPTR
    __device__ __forceinline__ bf16* XN() const { return (bf16*)out; }
    __device__ __forceinline__ bf16* OF() const { return (bf16*)out; }
    __device__ __forceinline__ bf16* OB() const { return (bf16*)out + (size_t)M * DM; }
};
__device__ __forceinline__ float wave_sum(float v) {
#pragma unroll
    for (int o = 1; o < 64; o <<= 1) v += __shfl_xor(v, o);
    return v;
}
__device__ __forceinline__ float wave_max(float v) {
#pragma unroll
    for (int o = 1; o < 64; o <<= 1) v = fmaxf(v, __shfl_xor(v, o));
    return v;
}
__device__ __forceinline__ float bflo(unsigned w) { return __uint_as_float(w << 16); }
__device__ __forceinline__ float bfhi(unsigned w) { return __uint_as_float(w & 0xffff0000u); }
__device__ __forceinline__ float bf1(bf16 b) { return __uint_as_float((unsigned)b << 16); }

__device__ __forceinline__ void p0_item(const float* W, int ldw, int K, int scol0, bf16* WT, int drow0, int k0, const float* gain, LAS float* scr, int lane) {
    float wv[32];
#pragma unroll
    for (int i = 0; i < 32; ++i) wv[i] = W[(size_t)(k0 + 2 * i + (lane >> 5)) * ldw + scol0 + (lane & 31)];
#pragma unroll
    for (int i = 0; i < 32; ++i) { const int kk = 2 * i + (lane >> 5); float v = wv[i]; if (gain) v *= gain[k0 + kk]; scr[kk * 33 + (lane & 31)] = v; }
    LDS_WAIT(); asm volatile("" ::: "memory");
    const int c = lane & 7;
#pragma unroll
    for (int j = 0; j < 4; ++j) { const int n = (lane >> 3) + 8 * j; const LAS float* s = scr + (8 * c) * 33 + n;
        v4u o; o.x = pk2(s[0 * 33], s[1 * 33]); o.y = pk2(s[2 * 33], s[3 * 33]); o.z = pk2(s[4 * 33], s[5 * 33]); o.w = pk2(s[6 * 33], s[7 * 33]);
        *(GAS v4u*)(WT + (size_t)(drow0 + n) * K + k0 + 8 * c) = o; }
    LDS_WAIT(); asm volatile("" ::: "memory");
}
__device__ __forceinline__ void sincos_d(double a, float& c, float& s) {
    const double n = __builtin_rint(a * 0.6366197723675814);
    double r = __builtin_fma(-n, 1.5707963267948966, a); r = __builtin_fma(-n, 6.123233995736766e-17, r);
    const double r2 = r * r;
    double sp = -1.0 / 1307674368000.0;
    sp = sp * r2 + 1.0 / 6227020800.0; sp = sp * r2 - 1.0 / 39916800.0; sp = sp * r2 + 1.0 / 362880.0; sp = sp * r2 - 1.0 / 5040.0; sp = sp * r2 + 1.0 / 120.0; sp = sp * r2 - 1.0 / 6.0; sp = sp * r2 * r + r;
    double cp = 1.0 / 20922789888000.0;
    cp = cp * r2 - 1.0 / 87178291200.0; cp = cp * r2 + 1.0 / 479001600.0; cp = cp * r2 - 1.0 / 3628800.0; cp = cp * r2 + 1.0 / 40320.0; cp = cp * r2 - 1.0 / 720.0; cp = cp * r2 + 1.0 / 24.0; cp = cp * r2 - 0.5; cp = cp * r2 + 1.0;
    const int q = (int)n & 3;
    const double sv = (q == 0) ? sp : (q == 1) ? cp : (q == 2) ? -sp : -cp;
    const double cv = (q == 0) ? cp : (q == 1) ? -sp : (q == 2) ? -cp : sp;
    c = (float)cv; s = (float)sv;
}
__device__ __forceinline__ void p0_prologue(Frame& F) {
    LAS float* scr = (LAS float*)(F.lds + RING_OFF + F.wave * 8448);
    LAS unsigned char* wlr = F.lds + RING_OFF + 8 * 8448;
    const int gw = F.vcu * NWAVES + F.wave, NGW = F.G * NWAVES;
    {
        const float* wsrc = inp(I_WIN) + (size_t)(2 * F.tid) * 6688 + 3072;
        f32x4 w0[8], w1[8];
#pragma unroll
        for (int j = 0; j < 8; ++j) { w0[j] = *(const f32x4*)(wsrc + 4 * j); w1[j] = *(const f32x4*)(wsrc + 6688 + 4 * j); }
#pragma unroll
        for (int n = 0; n < 32; ++n) { const int fF = ((n & 3) << 2) | ((n >> 2) & 3);
            *(LAS unsigned*)(wlr + 2048 * n + 16 * ((F.tid >> 2) ^ fF) + 4 * (F.tid & 3)) = pk2(w0[n >> 2][n & 3], w1[n >> 2][n & 3]); }
        __syncthreads();
    }
    constexpr int I_IN = 16 * 208, I_LR = 16, I_SQ = 16 * 32, I_FI = 16 * 176, I_FO = 44 * 32;
    constexpr int NITEMS = I_IN + I_LR + 3 * I_SQ + I_FI + I_FO;
    for (int it = gw; it < NITEMS; it += NGW) {
        int r = it;
        if (r < I_IN) { const int kb = r / 208, nb = r % 208, dn0 = 32 * nb, sc0 = dn0 + (dn0 >= 3072 ? 32 : 0); p0_item(inp(I_WIN), 6688, 1024, sc0, F.WIN(), dn0, 64 * kb, nullptr, scr, F.lane); continue; } r -= I_IN;
        if (r < I_LR) { p0_item(inp(I_WIN), 6688, 1024, 3072, F.WLR(), 0, 64 * r, nullptr, scr, F.lane); continue; } r -= I_LR;
        if (r < I_SQ) { p0_item(inp(I_WOG), 1024, 1024, 32 * (r % 32), F.WG(), 32 * (r % 32), 64 * (r / 32), nullptr, scr, F.lane); continue; } r -= I_SQ;
        if (r < I_SQ) { p0_item(inp(I_WOS), 1024, 1024, 32 * (r % 32), F.WS_(), 32 * (r % 32), 64 * (r / 32), nullptr, scr, F.lane); continue; } r -= I_SQ;
        if (r < I_SQ) { p0_item(inp(I_WOUT), 1024, 1024, 32 * (r % 32), F.WOUT(), 32 * (r % 32), 64 * (r / 32), nullptr, scr, F.lane); continue; } r -= I_SQ;
        if (r < I_FI) { const int kb = r / 176, nb = r % 176, dn0 = 32 * nb, tj = dn0 >> 8, wi = dn0 & 255, sc0 = (wi < 128) ? (128 * tj + wi) : (DFF + 128 * tj + (wi - 128));
            p0_item(inp(I_WFI), 2 * DFF, 1024, sc0, F.WFI(), dn0, 64 * kb, inp(I_GFFN), scr, F.lane); continue; } r -= I_FI;
        p0_item(inp(I_WFO), 1024, DFF, 32 * (r % 32), F.WFO(), 32 * (r % 32), 64 * (r / 32), nullptr, scr, F.lane);
    }
    {
        const float* xin = inp(I_X); const float* gmix = inp(I_GMIX); bf16* XNp = F.XN(); bf16* LRp = (bf16*)F.LR();
        f32x4 gm[4];
#pragma unroll
        for (int j = 0; j < 4; ++j) gm[j] = *((const f32x4*)gmix + F.lane + 64 * j);
        for (int g = gw; g < M / 16; g += NGW) {
            for (int it = 0; it < 4; ++it) {
                const int m0 = 16 * g + 4 * it;
                f32x4 v[4][4];
#pragma unroll
                for (int u = 0; u < 4; ++u) { const GAS f32x4* xr = (const GAS f32x4*)(xin + (size_t)(m0 + u) * DM) + F.lane;
#pragma unroll
                    for (int j = 0; j < 4; ++j) v[u][j] = xr[64 * j]; }
#pragma unroll
                for (int u = 0; u < 4; ++u) { float s = 0.f;
#pragma unroll
                    for (int j = 0; j < 4; ++j) s += (v[u][j].x * v[u][j].x + v[u][j].y * v[u][j].y) + (v[u][j].z * v[u][j].z + v[u][j].w * v[u][j].w);
                    const float rstd = 1.0f / sqrtf(wave_sum(s) * (1.f / DM) + EPS);
                    GAS unsigned long long* o8 = (GAS unsigned long long*)(XNp + (size_t)(m0 + u) * DM) + F.lane;
#pragma unroll
                    for (int j = 0; j < 4; ++j) o8[64 * j] = (unsigned long long)pk2(v[u][j].x * rstd * gm[j].x, v[u][j].y * rstd * gm[j].y) | ((unsigned long long)pk2(v[u][j].z * rstd * gm[j].z, v[u][j].w * rstd * gm[j].w) << 32); }
            }
            asm volatile("s_waitcnt vmcnt(0)" ::: "memory");
            int ln = F.lane; asm volatile("" : "+v"(ln));
            const int fr = ln & 15, fq = ln >> 4, fF = ((fr & 3) << 2) | ((fr >> 2) & 3);
            const bf16* ap = XNp + (size_t)(16 * g + fr) * DM + 8 * fq;
            const unsigned aB = (unsigned)(2048 * fr + 16 * (fq ^ fF));
            f32x4 a0 = {0.f, 0.f, 0.f, 0.f}, a1 = {0.f, 0.f, 0.f, 0.f};
#pragma unroll
            for (int hb = 0; hb < 2; ++hb) {
                bf16x8 af[16];
#pragma unroll
                for (int kk = 0; kk < 16; ++kk) af[kk] = *(const bf16x8*)(ap + 32 * (16 * hb + kk));
#pragma unroll
                for (int kk = 0; kk < 16; ++kk) { const int k2 = 16 * hb + kk;
                    const bf16x8 b0 = *(const LAS bf16x8*)(wlr + (aB ^ ((k2 & 3) << 6)) + 256 * (k2 >> 2)), b1 = *(const LAS bf16x8*)(wlr + (aB ^ ((k2 & 3) << 6)) + 256 * (k2 >> 2) + 32768);
                    a0 = __builtin_amdgcn_mfma_f32_16x16x32_bf16(b0, af[kk], a0, 0, 0, 0); a1 = __builtin_amdgcn_mfma_f32_16x16x32_bf16(b1, af[kk], a1, 0, 0, 0);
                    if ((kk & 3) == 3) __builtin_amdgcn_sched_barrier(0); }
            }
            { u32x2 w0, w1; w0.x = pk2(a0[0], a0[1]); w0.y = pk2(a0[2], a0[3]); w1.x = pk2(a1[0], a1[1]); w1.y = pk2(a1[2], a1[3]);
              bf16* o = LRp + (size_t)(16 * g + fr) * 32 + 4 * fq; *(u32x2*)o = w0; *(u32x2*)(o + 16) = w1; }
        }
    }
    float* ROPEp = F.ROPE();
    for (int idx = (F.vcu * NWAVES + F.wave) * 64 + F.lane; idx < SEQ * 64; idx += NGW * 64) {
        const int i = idx & 63, pos = idx >> 6; double f = 1.0;
        for (int k = 0; k < i; ++k) f *= 0.8659643233600653;
        float c, s; sincos_d((double)pos * f, c, s);
        ROPEp[2 * idx] = c; ROPEp[2 * idx + 1] = s;
    }
}
__device__ __forceinline__ void p1_lr(Frame& F) {
    const int gw = F.vcu * NWAVES + F.wave, NGW = F.G * NWAVES, fr = F.lane & 15, fq = F.lane >> 4;
    const bf16* XNp = F.XN(); const bf16* WLRp = F.WLR(); bf16* LRp = (bf16*)F.LR();
    for (int g = gw; g < M / 16; g += NGW) {
        const bf16* ap = XNp + (size_t)(16 * g + fr) * DM + 8 * fq; const bf16* b0p = WLRp + (size_t)fr * DM + 8 * fq; const bf16* b1p = b0p + 16 * DM;
        f32x4 a0 = {0.f, 0.f, 0.f, 0.f}, a1 = {0.f, 0.f, 0.f, 0.f};
#pragma unroll 4
        for (int kk = 0; kk < 32; ++kk) { const bf16x8 a = *(const bf16x8*)(ap + 32 * kk), b0 = *(const bf16x8*)(b0p + 32 * kk), b1 = *(const bf16x8*)(b1p + 32 * kk);
            a0 = __builtin_amdgcn_mfma_f32_16x16x32_bf16(a, b0, a0, 0, 0, 0); a1 = __builtin_amdgcn_mfma_f32_16x16x32_bf16(a, b1, a1, 0, 0, 0); }
#pragma unroll
        for (int i = 0; i < 4; ++i) { bf16* o = LRp + (size_t)(16 * g + 4 * fq + i) * 32 + fr; o[0] = (bf16)f2bf(a0[i]); o[16] = (bf16)f2bf(a1[i]); }
    }
}
__device__ __forceinline__ void p1b_qknorm_rope(Frame& F, int dummy = 0) {
    const int gw = F.vcu * NWAVES + F.wave, NGW = F.G * NWAVES, lane = F.lane, slot = lane >> 3, c = lane & 7;
    constexpr int NGRP = M * 10 / 8;
    bf16* SQp = F.SQ(); bf16* SKp = F.SK(); const float* ROPEp = F.ROPE(); const float* gqp = inp(I_GQ); const float* gkp = inp(I_GK);
    for (int g0 = gw; g0 < NGRP; g0 += 4 * NGW) {
        v4u a1[4], a2[4]; f32x4 cs[4][4];
#pragma unroll
        for (int u = 0; u < 4; ++u) { const int g = g0 + u * NGW, idx = (g < NGRP ? g : g0) * 8 + slot, row = idx / 10, hh = idx - row * 10, pos = row & (SEQ - 1);
            const bf16* p = (hh < 8) ? SQp + (size_t)row * 1024 + hh * 128 : SKp + (size_t)row * 256 + (hh - 8) * 128;
            a1[u] = *(const v4u*)(p + 8 * c); a2[u] = *(const v4u*)(p + 64 + 8 * c);
            const f32x4* rp = (const f32x4*)(ROPEp + 2 * (pos * 64 + 8 * c));
#pragma unroll
            for (int j = 0; j < 4; ++j) cs[u][j] = rp[j]; }
#pragma unroll
        for (int u = 0; u < 4; ++u) { const int g = g0 + u * NGW, idx = (g < NGRP ? g : g0) * 8 + slot, row = idx / 10, hh = idx - row * 10;
            bf16* p = (hh < 8) ? SQp + (size_t)row * 1024 + hh * 128 : SKp + (size_t)row * 256 + (hh - 8) * 128;
            const float* gn = (hh < 8) ? gqp : gkp; const float sc = (hh < 8) ? (SWA_MFMA ? 0.08838834764831845f * 1.4426950408889634f : 0.08838834764831845f) : 1.f;
            float x1[8], x2[8];
            x1[0] = bflo(a1[u].x); x1[1] = bfhi(a1[u].x); x1[2] = bflo(a1[u].y); x1[3] = bfhi(a1[u].y); x1[4] = bflo(a1[u].z); x1[5] = bfhi(a1[u].z); x1[6] = bflo(a1[u].w); x1[7] = bfhi(a1[u].w);
            x2[0] = bflo(a2[u].x); x2[1] = bfhi(a2[u].x); x2[2] = bflo(a2[u].y); x2[3] = bfhi(a2[u].y); x2[4] = bflo(a2[u].z); x2[5] = bfhi(a2[u].z); x2[6] = bflo(a2[u].w); x2[7] = bfhi(a2[u].w);
            float ss = 0.f;
#pragma unroll
            for (int e = 0; e < 8; ++e) ss += x1[e] * x1[e] + x2[e] * x2[e];
            ss += __shfl_xor(ss, 1); ss += __shfl_xor(ss, 2); ss += __shfl_xor(ss, 4);
            const float rstd = sc / sqrtf(ss * (1.f / 128.f) + EPS);
            const f32x4 g10 = *(const f32x4*)(gn + 8 * c), g11 = *(const f32x4*)(gn + 8 * c + 4), g20 = *(const f32x4*)(gn + 64 + 8 * c), g21 = *(const f32x4*)(gn + 64 + 8 * c + 4);
            float o1[8], o2[8];
#pragma unroll
            for (int e = 0; e < 8; ++e) { const float y1 = x1[e] * rstd * (e < 4 ? g10[e & 3] : g11[e & 3]), y2 = x2[e] * rstd * (e < 4 ? g20[e & 3] : g21[e & 3]);
                const float cc = cs[u][e >> 1][2 * (e & 1)], sn = cs[u][e >> 1][2 * (e & 1) + 1]; o1[e] = y1 * cc - y2 * sn; o2[e] = y2 * cc + y1 * sn; }
            if (g < NGRP) { v4u w1, w2; w1.x = pk2(o1[0], o1[1]); w1.y = pk2(o1[2], o1[3]); w1.z = pk2(o1[4], o1[5]); w1.w = pk2(o1[6], o1[7]); w2.x = pk2(o2[0], o2[1]); w2.y = pk2(o2[2], o2[3]); w2.z = pk2(o2[4], o2[5]); w2.w = pk2(o2[6], o2[7]);
                bf16* po = dummy ? (bf16*)(F.ws + WS_DUMMY) + (size_t)(idx & 8191) * 128 : p; *(v4u*)(po + 8 * c) = w1; *(v4u*)(po + 64 + 8 * c) = w2; } }
    }
}
#if 0
__device__ __forceinline__ float logsig(float z) { return fminf(z, 0.f) - log1pf(expf(-fabsf(z))); }
__device__ __forceinline__ void gla_naive(Frame& F) {
    if (F.vcu >= 64) return;
    const int b = F.vcu >> 3, h = (F.vcu >> 1) & 3, dir = F.vcu & 1;
    LAS float* Gs = (LAS float*)(F.lds + RING_OFF); LAS float* Qs = Gs + 2048; LAS float* Ks = Qs + 2048;
    const float* up = dir ? F.up_b : F.up_f; const float* bias = dir ? F.bias_b : F.bias_f;
    const int tt = F.tid >> 5, d0 = (F.tid & 31) * 4;
    const int col = 32 * F.wave + (F.lane & 31), hf = F.lane >> 5;
    bf16* O = dir ? F.OB : F.OF;
    float S[64];
#pragma unroll
    for (int i = 0; i < 64; ++i) S[i] = 0.f;
    for (int tile = 0; tile < SEQ / 16; ++tile) {
        {
            const int i = tile * 16 + tt, t = dir ? (SEQ - 1 - i) : i; const size_t row = (size_t)b * SEQ + t;
            const f32x4* lrp = (const f32x4*)(F.LR + row * 32 + dir * 16);
            f32x4 z = *(const f32x4*)(bias + h * 128 + d0);
#pragma unroll
            for (int r4 = 0; r4 < 4; ++r4) { const f32x4 l = lrp[r4];
#pragma unroll
                for (int e = 0; e < 4; ++e) { const f32x4 u = *(const f32x4*)(up + (size_t)(4 * r4 + e) * 512 + h * 128 + d0); z += u * l[e]; } }
            f32x4 g;
#pragma unroll
            for (int e = 0; e < 4; ++e) g[e] = expf(fmaxf(logsig(z[e]) * (1.f / 16.f), -0.5f));
            const u32x2 qw = *(const u32x2*)(F.QG + row * 512 + h * 128 + d0), kw = *(const u32x2*)(F.KG + row * 512 + h * 128 + d0);
            *(LAS f32x4*)(Gs + tt * 128 + d0) = g;
            *(LAS f32x4*)(Qs + tt * 128 + d0) = (f32x4){bflo(qw.x), bfhi(qw.x), bflo(qw.y), bfhi(qw.y)};
            *(LAS f32x4*)(Ks + tt * 128 + d0) = (f32x4){bflo(kw.x), bfhi(kw.x), bflo(kw.y), bfhi(kw.y)};
        }
        __syncthreads();
        for (int t2 = 0; t2 < 16; ++t2) {
            const int i = tile * 16 + t2, t = dir ? (SEQ - 1 - i) : i; const size_t row = (size_t)b * SEQ + t;
            const float v = bf1(F.VG[row * 1024 + h * 256 + col]);
            float o = 0.f;
#pragma unroll
            for (int dd = 0; dd < 64; dd += 4) {
                const f32x4 g4 = *(const LAS f32x4*)(Gs + t2 * 128 + 64 * hf + dd), q4 = *(const LAS f32x4*)(Qs + t2 * 128 + 64 * hf + dd), k4 = *(const LAS f32x4*)(Ks + t2 * 128 + 64 * hf + dd);
#pragma unroll
                for (int e = 0; e < 4; ++e) { float s = S[dd + e] * g4[e];
                    if (dir == 0) { s = fmaf(k4[e], v, s); o = fmaf(q4[e], s, o); } else { o = fmaf(q4[e], s, o); s = fmaf(k4[e], v, s); }
                    S[dd + e] = s; }
            }
            o += __shfl_xor(o, 32);
            if (hf == 0) O[row * 1024 + h * 256 + col] = (bf16)f2bf(o);
        }
        __syncthreads();
    }
}
__device__ __forceinline__ void swa_naive(Frame& F) {
    LAS float* qs = (LAS float*)(F.lds + RING_OFF + 32768) + F.wave * 512; LAS float* ps = qs + 128;
    const int gw = F.vcu * NWAVES + F.wave, NGW = F.G * NWAVES, lane = F.lane;
    const int per = (BATCH * 8 * SEQ) / NGW;
    for (int j = 0; j < per; ++j) {
        const int it = gw * per + j, bh = it >> 12, i = it & (SEQ - 1), b = bh >> 3, hd = bh & 7, kvh = hd >> 2;
        const size_t rowb = (size_t)b * SEQ;
        bf16* qp = F.SQ + (rowb + i) * 1024 + hd * 128;
        { const unsigned w = *(const unsigned*)(qp + 2 * lane); qs[2 * lane] = bflo(w); qs[2 * lane + 1] = bfhi(w); }
        LDS_WAIT(); asm volatile("" ::: "memory");
        const int jlo = (i - 128 > 0) ? i - 128 : 0, jhi = (i + 128 < SEQ - 1) ? i + 128 : SEQ - 1;
        float s[5];
#pragma unroll
        for (int c = 0; c < 5; ++c) { const int jj = jlo + lane + 64 * c; const bool valid = jj <= jhi;
            const bf16* kp = F.SK + (rowb + (valid ? jj : jhi)) * 256 + kvh * 128; float a = 0.f;
#pragma unroll 4
            for (int ch = 0; ch < 16; ++ch) { const v4u w = *(const v4u*)(kp + 8 * ch); const f32x4 qa = *(const LAS f32x4*)(qs + 8 * ch), qb = *(const LAS f32x4*)(qs + 8 * ch + 4);
                a += (bflo(w.x) * qa[0] + bfhi(w.x) * qa[1]) + (bflo(w.y) * qa[2] + bfhi(w.y) * qa[3]) + (bflo(w.z) * qb[0] + bfhi(w.z) * qb[1]) + (bflo(w.w) * qb[2] + bfhi(w.w) * qb[3]); }
            s[c] = valid ? a : -INFINITY; }
        const float sink = F.sinks[hd];
        float mx = fmaxf(fmaxf(fmaxf(s[0], s[1]), fmaxf(s[2], s[3])), s[4]); mx = fmaxf(wave_max(mx), sink);
        float sum = 0.f;
#pragma unroll
        for (int c = 0; c < 5; ++c) { const float p = expf(s[c] - mx); ps[lane + 64 * c] = p; sum += p; }
        sum = wave_sum(sum) + expf(sink - mx);
        LDS_WAIT(); asm volatile("" ::: "memory");
        const int n = jhi - jlo + 1; float o0 = 0.f, o1 = 0.f;
        const bf16* vp = F.SV + (rowb + jlo) * 256 + kvh * 128 + 2 * lane;
        for (int jj = 0; jj < n; ++jj) { const float p = ps[jj]; const unsigned w = *(const unsigned*)(vp + (size_t)jj * 256); o0 = fmaf(p, bflo(w), o0); o1 = fmaf(p, bfhi(w), o1); }
        const float inv = 1.0f / sum;
        *(unsigned*)(qp + 2 * lane) = pk2(o0 * inv, o1 * inv);
        asm volatile("" ::: "memory");
    }
}
#endif
__device__ __forceinline__ void p2c_combine(Frame& F, int dummy = 0) {
    const int gw = F.vcu * NWAVES + F.wave, NGW = F.G * NWAVES, lane = F.lane, l32 = lane & 31;
    const float* ggla = inp(I_GGLA); bf16* Rp = F.R();
    const bf16* OFp = F.OF(); const bf16* OBp = F.OB();
    const f32x4 ga = *((const f32x4*)ggla + 2 * l32), gb = *((const f32x4*)ggla + 2 * l32 + 1);
    constexpr int NGRP = M * 4 / 2;
    for (int g0 = gw; g0 < NGRP; g0 += 4 * NGW) {
        v4u a[4], b2[4], r4[4];
#pragma unroll
        for (int u = 0; u < 4; ++u) { const int g = g0 + u * NGW, idx = (g < NGRP ? g : g0) * 2 + (lane >> 5); const size_t so = (size_t)idx * 256 + 8 * l32;
            a[u] = *(const v4u*)(OFp + so); b2[u] = *(const v4u*)(OBp + so); r4[u] = *(const v4u*)(Rp + so); }
#pragma unroll
        for (int u = 0; u < 4; ++u) { const int g = g0 + u * NGW; const size_t off = (size_t)((g < NGRP ? g : g0) * 2 + (lane >> 5)) * 256 + 8 * l32;
            float o[8], r[8];
            o[0] = bflo(a[u].x) + bflo(b2[u].x); o[1] = bfhi(a[u].x) + bfhi(b2[u].x); o[2] = bflo(a[u].y) + bflo(b2[u].y); o[3] = bfhi(a[u].y) + bfhi(b2[u].y);
            o[4] = bflo(a[u].z) + bflo(b2[u].z); o[5] = bfhi(a[u].z) + bfhi(b2[u].z); o[6] = bflo(a[u].w) + bflo(b2[u].w); o[7] = bfhi(a[u].w) + bfhi(b2[u].w);
            r[0] = bflo(r4[u].x); r[1] = bfhi(r4[u].x); r[2] = bflo(r4[u].y); r[3] = bfhi(r4[u].y); r[4] = bflo(r4[u].z); r[5] = bfhi(r4[u].z); r[6] = bflo(r4[u].w); r[7] = bfhi(r4[u].w);
            float ss = 0.f;
#pragma unroll
            for (int e = 0; e < 8; ++e) ss += o[e] * o[e];
            ss += __shfl_xor(ss, 1); ss += __shfl_xor(ss, 2); ss += __shfl_xor(ss, 4); ss += __shfl_xor(ss, 8); ss += __shfl_xor(ss, 16);
            const float rstd = 1.0f / sqrtf(ss * (1.f / 256.f) + EPS);
            float y[8];
#pragma unroll
            for (int e = 0; e < 8; ++e) y[e] = o[e] * rstd * (e < 4 ? ga[e & 3] : gb[e & 3]) * r[e] / (1.f + __expf(-r[e]));
            if (g < NGRP) { v4u w; w.x = pk2(y[0], y[1]); w.y = pk2(y[2], y[3]); w.z = pk2(y[4], y[5]); w.w = pk2(y[6], y[7]); *(v4u*)((dummy ? (bf16*)(F.ws + WS_DUMMY) + (off & 0xfffff) : Rp + off)) = w; } }
    }
}

typedef float f32x16 __attribute__((ext_vector_type(16)));
typedef short s16x4 __attribute__((ext_vector_type(4)));
typedef float f32x2_t __attribute__((ext_vector_type(2))); typedef __bf16 bf16x2_t __attribute__((ext_vector_type(2)));
__device__ __forceinline__ unsigned cvtpk(float lo, float hi) { f32x2_t v = {lo, hi}; bf16x2_t b = __builtin_convertvector(v, bf16x2_t); return __builtin_bit_cast(unsigned, b); }
__device__ __forceinline__ bf16x8 pack_step(const f32x16& x, int s) { v4u p; p.x = cvtpk(x[8 * s], x[8 * s + 1]); p.y = cvtpk(x[8 * s + 2], x[8 * s + 3]); p.z = cvtpk(x[8 * s + 4], x[8 * s + 5]); p.w = cvtpk(x[8 * s + 6], x[8 * s + 7]); return __builtin_bit_cast(bf16x8, p); }
__device__ __forceinline__ int qk_off(int row, int ch) { return 256 * row + 16 * (ch ^ (((row & 3) << 2) | ((row >> 2) & 3))); }
__device__ __forceinline__ int v_off(int tok, int ch) { return 512 * tok + 16 * (ch ^ ((tok & 3) << 2)); }
__device__ __forceinline__ int p_off(int row, int ch) { return 128 * row + 16 * (ch ^ ((row >> 1) & 7)); }
typedef short v4i16_t __attribute__((ext_vector_type(4)));
__device__ __forceinline__ s16x4 tr_rd(LAS const unsigned char* p) { return __builtin_bit_cast(s16x4, __builtin_amdgcn_ds_read_tr16_b64_v4i16((LAS v4i16_t*)p)); }
#define MFMA32(a, b, c) __builtin_amdgcn_mfma_f32_32x32x16_bf16((a), (b), (c), 0, 0, 0)
#define MFMA16(a, b, c) __builtin_amdgcn_mfma_f32_16x16x32_bf16((a), (b), (c), 0, 0, 0)
constexpr int GL_QKSZ = 32768, GL_KI = 16384, GL_V0 = 65536, GL_VSZ = 32768, GL_P = 131072, GL_DEC = 139264;
constexpr int GL_OST = 140800, GL_OSTW = 2560;
constexpr int GLA_LDS_END = GL_OST + 8 * GL_OSTW;
constexpr int GL_DSEG = GLA_LDS_END;
constexpr int GL_NSEG = 4, GL_SEGC = 64 / GL_NSEG;
__device__ __forceinline__ void glds16(const void* gsrc, unsigned lds_dst) { unsigned keep;
    asm volatile("s_mov_b32 %0, m0\n\ts_mov_b32 m0, %2\n\ts_nop 0\n\tglobal_load_lds_dwordx4 %1, off\n\ts_mov_b32 m0, %0" : "=&s"(keep) : "v"(gsrc), "s"(lds_dst) : "memory"); }

__device__ __forceinline__ void ldg8_nc(u32x2& d, const void* p) { asm volatile("global_load_dwordx2 %0, %1, off" : "=v"(d) : "v"(p) : "memory"); }
__device__ __forceinline__ void ldg16_nc(v4u& d, const void* p) { asm volatile("global_load_dwordx4 %0, %1, off" : "=v"(d) : "v"(p) : "memory"); }
__device__ __forceinline__ float* gl_sloc(Frame& F) { return (float*)(F.ws + WS_END); }
__device__ __forceinline__ float* gl_dseg(Frame& F) { return (float*)(F.ws + WS_END + 32 * MiB); }
template <int MODE> __device__ __forceinline__ void gla_mfma(Frame& F, int item, bool dump = (MODE == 0)) {
    const int b = item >> 5, h = (item >> 3) & 3, dir = (item >> 2) & 1, seg = item & 3, n0 = seg * GL_SEGC, n1e = n0 + GL_SEGC;
    if (MODE == 0 && seg == GL_NSEG - 1) return;
    const int w = F.wave;
    LAS unsigned char* L = F.lds + RING_OFF; const unsigned lds0 = (unsigned)(size_t)L;
    bf16* O = dir ? F.OB() : F.OF(); const bf16* VGp = F.VG(); const bf16* QGp = F.QG(); const bf16* KGp = F.KG(); const bf16* LRp = (const bf16*)F.LR();
    const size_t rowb = (size_t)b * SEQ;
    bf16x8 upf; float biasv;
    { const float* up = inp(dir ? I_UPB : I_UPF); const float* bias = inp(dir ? I_BIASB : I_BIASF); const int fr = F.lane & 15, fq = F.lane >> 4;
      v4u t = {0u, 0u, 0u, 0u};
      if (fq < 2) { const float* p = up + (size_t)(8 * fq) * 512 + h * 128 + 16 * w + fr; t.x = cvtpk(p[0], p[512]); t.y = cvtpk(p[1024], p[1536]); t.z = cvtpk(p[2048], p[2560]); t.w = cvtpk(p[3072], p[3584]); }
      upf = __builtin_bit_cast(bf16x8, t); biasv = bias[h * 128 + 16 * w + fr]; }
    f32x16 S[4];
#pragma unroll
    for (int j = 0; j < 4; ++j)
#pragma unroll
        for (int r = 0; r < 16; ++r) S[j][r] = 0.f;
    if (MODE == 1 && seg > 0) {
        if (F.tid < 128 * seg) *(LAS float*)(L + GL_DSEG + 4 * F.tid) = gl_dseg(F)[(size_t)(item - seg + (F.tid >> 7)) * 128 + (F.tid & 127)];
        __syncthreads();
        const int hi_ = F.lane >> 5;
        for (int sp = 0; sp < seg; ++sp) { const float* sl = gl_sloc(F) + ((size_t)((item - seg + sp) * 8 + w) * 64) * 64 + F.lane;
#pragma unroll
            for (int j = 0; j < 4; ++j)
#pragma unroll
                for (int g = 0; g < 4; ++g) { const f32x4 d4 = *(const LAS f32x4*)(L + GL_DSEG + 512 * sp + 4 * (32 * j + 8 * g + 4 * hi_));
#pragma unroll
                    for (int e = 0; e < 4; ++e) S[j][4 * g + e] = S[j][4 * g + e] * d4[e] + sl[(size_t)(j * 16 + 4 * g + e) * 64]; } }
    }
    float dprod = 1.f;

#define GL_ROW(n_, i_) (rowb + (size_t)(dir ? (SEQ - 1 - (64 * (n_) + (i_))) : (64 * (n_) + (i_))))
#define GL_OPAQUE(x) asm volatile("" : "+v"(x))
#define GL_LANE() int ln_ = F.lane; GL_OPAQUE(ln_); const int fr = ln_ & 15, fq = ln_ >> 4, r32 = ln_ & 31, hi = ln_ >> 5; (void)fr; (void)fq; (void)r32; (void)hi
#define GL_LOAD(n1) do { GL_LANE(); \
        _Pragma("unroll") for (int tt = 0; tt < 4; ++tt) { const size_t row_ = GL_ROW(n1, 16 * tt + fr); \
            if (MODE == 1) ldg8_nc(pq[tt], QGp + row_ * 512 + h * 128 + 16 * w + 4 * fq); ldg8_nc(pk[tt], KGp + row_ * 512 + h * 128 + 16 * w + 4 * fq); } \
    } while (0)
#define GL_LOAD_LR(n1) do { GL_LANE(); _Pragma("unroll") for (int tt = 0; tt < 4; ++tt) ldg16_nc(plr[tt], LRp + GL_ROW(n1, 16 * tt + fr) * 32 + dir * 16 + 8 * (fq & 1)); } while (0)
#define GL_WAIT(cnt) asm volatile("s_waitcnt vmcnt(" #cnt ")" : "+v"(plr[0]), "+v"(plr[1]), "+v"(plr[2]), "+v"(plr[3]), "+v"(pk[0]), "+v"(pk[1]), "+v"(pk[2]), "+v"(pk[3]), "+v"(pq[0]), "+v"(pq[1]), "+v"(pq[2]), "+v"(pq[3]) :: "memory")
#define GL_DMA_V(n1, bsel) do { GL_LANE(); _Pragma("unroll") for (int i_ = 0; i_ < 4; ++i_) { const int tok_ = 8 * w + 2 * i_ + hi, ch_ = r32 ^ (((2 * i_ + hi) & 3) << 2); \
        glds16(VGp + GL_ROW(n1, tok_) * 1024 + h * 256 + 8 * ch_, (unsigned)__builtin_amdgcn_readfirstlane((int)(lds0 + GL_V0 + (bsel) * GL_VSZ + 4096 * w + 1024 * i_))); } } while (0)
#define GL_STAGE_A(bsel) do { GL_LANE(); \
        const int fF_ = ((fr & 3) << 2) | ((fr >> 2) & 3); \
        const unsigned aW_ = (unsigned)((fr << 8) | (((2 * w + (fq >> 1)) ^ fF_) << 4) | ((fq & 1) << 3)) + (bsel) * GL_QKSZ; \
        bf16x8 tri0, tri1, ones; \
        _Pragma("unroll") for (int j = 0; j < 8; ++j) { const int tk = 16 * (j >> 2) + 4 * fq + (j & 3); tri0[j] = (tk <= fr) ? (short)0x3F80 : (short)0; tri1[j] = (tk <= 16 + fr) ? (short)0x3F80 : (short)0; ones[j] = (short)0x3F80; } \
        f32x4 zt_[4]; \
        _Pragma("unroll") for (int tt = 0; tt < 4; ++tt) { v4u a_ = plr[tt]; if (fq >= 2) a_ = (v4u){0u, 0u, 0u, 0u}; \
            zt_[tt] = MFMA16(__builtin_bit_cast(bf16x8, a_), upf, ((f32x4){biasv, biasv, biasv, biasv})); } \
        v4u ahi_[2], alo_[2]; \
        _Pragma("unroll") for (int tt = 0; tt < 4; ++tt) { float lg_[4], lo_[4]; unsigned hw_[2]; \
            _Pragma("unroll") for (int r = 0; r < 4; ++r) { const float z_ = zt_[tt][r]; \
                const float ls_ = fminf(z_, 0.f) - 0.6931471805599453f * __builtin_amdgcn_logf(1.0f + __builtin_amdgcn_exp2f(-1.4426950408889634f * fabsf(z_))); \
                lg_[r] = fmaxf(ls_ * 0.0625f, -0.5f); } \
            hw_[0] = cvtpk(lg_[0], lg_[1]); hw_[1] = cvtpk(lg_[2], lg_[3]); \
            lo_[0] = lg_[0] - bflo(hw_[0]); lo_[1] = lg_[1] - bfhi(hw_[0]); lo_[2] = lg_[2] - bflo(hw_[1]); lo_[3] = lg_[3] - bfhi(hw_[1]); \
            const unsigned lw0_ = cvtpk(lo_[0], lo_[1]), lw1_ = cvtpk(lo_[2], lo_[3]); \
            if (tt & 1) { ahi_[tt >> 1].z = hw_[0]; ahi_[tt >> 1].w = hw_[1]; alo_[tt >> 1].z = lw0_; alo_[tt >> 1].w = lw1_; } else { ahi_[tt >> 1].x = hw_[0]; ahi_[tt >> 1].y = hw_[1]; alo_[tt >> 1].x = lw0_; alo_[tt >> 1].y = lw1_; } } \
        const bf16x8 AH0_ = __builtin_bit_cast(bf16x8, ahi_[0]), AL0_ = __builtin_bit_cast(bf16x8, alo_[0]), AH1_ = __builtin_bit_cast(bf16x8, ahi_[1]), AL1_ = __builtin_bit_cast(bf16x8, alo_[1]); \
        const f32x4 z4_ = {0.f, 0.f, 0.f, 0.f}; f32x4 bq_[4]; \
        bq_[0] = MFMA16(AH0_, tri0, z4_); bq_[0] = MFMA16(AL0_, tri0, bq_[0]); \
        bq_[1] = MFMA16(AH0_, tri1, z4_); bq_[1] = MFMA16(AL0_, tri1, bq_[1]); \
        f32x4 tot_ = MFMA16(AH0_, ones, z4_); tot_ = MFMA16(AL0_, ones, tot_); \
        bq_[2] = MFMA16(AH1_, tri0, tot_); bq_[2] = MFMA16(AL1_, tri0, bq_[2]); \
        bq_[3] = MFMA16(AH1_, tri1, tot_); bq_[3] = MFMA16(AL1_, tri1, bq_[3]); \
        if (fr == 15) { f32x4 d_; _Pragma("unroll") for (int r = 0; r < 4; ++r) d_[r] = __builtin_amdgcn_exp2f(1.4426950408889634f * bq_[3][r]); \
            *(LAS f32x4*)(L + GL_DEC + (bsel) * 512 + 4 * (16 * w + 4 * fq)) = d_; } \
        _Pragma("unroll") for (int tq = 0; tq < 4; ++tq) { const u32x2 qw_ = pq[tq], kw_ = pk[tq]; \
            float e_[4], ei_[4]; \
            _Pragma("unroll") for (int r = 0; r < 4; ++r) { const float bl_ = 1.4426950408889634f * bq_[tq][r]; if (MODE == 1) e_[r] = __builtin_amdgcn_exp2f(bl_); ei_[r] = __builtin_amdgcn_exp2f(-bl_); } \
            u32x2 qo_, ko_; if (MODE == 1) { qo_.x = cvtpk(bflo(qw_.x) * e_[0], bfhi(qw_.x) * e_[1]); qo_.y = cvtpk(bflo(qw_.y) * e_[2], bfhi(qw_.y) * e_[3]); } \
            ko_.x = cvtpk(bflo(kw_.x) * ei_[0], bfhi(kw_.x) * ei_[1]); ko_.y = cvtpk(bflo(kw_.y) * ei_[2], bfhi(kw_.y) * ei_[3]); \
            if (MODE == 1) *(LAS u32x2*)(L + aW_ + tq * 4096) = qo_; *(LAS u32x2*)(L + aW_ + GL_KI + tq * 4096) = ko_; } \
    } while (0)

    v4u plr[4]; u32x2 pq[4] = {}, pk[4];
    GL_DMA_V(n0, n0 & 1);
    GL_LOAD(n0); GL_LOAD_LR(n0);
    GL_WAIT(0);
    GL_STAGE_A(n0 & 1);
    GL_LOAD(n0 + 1); GL_LOAD_LR(n0 + 1);
    GL_WAIT(0);
    __syncthreads();
    for (int n = n0; n < n1e; ++n) {
        const int bs = n & 1;
        if (MODE == 1) {
            GL_LANE();
            const int fF = ((fr & 3) << 2) | ((fr >> 2) & 3);
            const unsigned aB = (unsigned)((fr << 8) | ((fq ^ fF) << 4)) + bs * GL_QKSZ;
            const unsigned aPw = (unsigned)((fr << 7) | (((fq >> 1) ^ ((fr >> 1) & 7)) << 4) | ((fq & 1) << 3)) + GL_P;
            const int tq = w & 3;
#pragma unroll
            for (int tkk = 0; tkk < 2; ++tkk) { const int tk = 2 * (w >> 2) + tkk; f32x4 acc = {0.f, 0.f, 0.f, 0.f};
                if (tk <= tq) {
#pragma unroll
                    for (int kk = 0; kk < 4; ++kk) { const bf16x8 a = *(const LAS bf16x8*)(L + (aB ^ (kk << 6)) + GL_KI + tk * 4096), bb = *(const LAS bf16x8*)(L + (aB ^ (kk << 6)) + tq * 4096); acc = MFMA16(a, bb, acc); }
#pragma unroll
                    for (int r = 0; r < 4; ++r) { const int tokk = 16 * tk + 4 * fq + r, tokq = 16 * tq + fr; const bool keep = dir ? (tokk < tokq) : (tokk <= tokq); acc[r] = keep ? acc[r] : 0.f; }
                }
                u32x2 pw; pw.x = cvtpk(acc[0], acc[1]); pw.y = cvtpk(acc[2], acc[3]);
                *(LAS u32x2*)(L + (aPw ^ (tk << 5)) + tq * 2048) = pw; }
        }
        __builtin_amdgcn_sched_barrier(0);
        if (n + 1 < n1e) { if (MODE == 1) GL_WAIT(4); else GL_WAIT(0); GL_STAGE_A(bs ^ 1); }
        __builtin_amdgcn_sched_barrier(0);
        if (MODE == 1) { asm volatile("s_waitcnt vmcnt(4)" ::: "memory"); __syncthreads(); }
        if (n + 1 < n1e) { GL_DMA_V(n + 1, bs ^ 1); }
        if (n + 2 < n1e) { GL_LOAD(n + 2); GL_LOAD_LR(n + 2); }
        if (dump && F.tid < 128) dprod *= *(const LAS float*)(L + GL_DEC + bs * 512 + 4 * F.tid);
        {
            GL_LANE();
            const int i16 = ln_ & 15, q4 = i16 >> 2, p4 = i16 & 3, h16 = (ln_ >> 4) & 1;
            const int fR = ((r32 & 3) << 2) | ((r32 >> 2) & 3);
            const unsigned aV = (unsigned)(((8 * hi + q4) << 9) | (((4 * w + 2 * h16 + (p4 >> 1)) ^ (q4 << 2)) << 4) | ((p4 & 1) << 3)) + GL_V0 + bs * GL_VSZ;
            const unsigned aC = (unsigned)((r32 << 8) | (fR << 4) | (hi << 3)) + bs * GL_QKSZ;
            const unsigned aPr = (unsigned)((r32 << 7) | ((hi ^ ((r32 >> 1) & 7)) << 4)) + GL_P;
            const unsigned aK0 = (unsigned)(((8 * hi + q4) << 8) | ((((2 * h16 + (p4 >> 1)) ^ ((q4 << 2) | ((2 * hi) & 3))) & 15) << 4) | ((p4 & 1) << 3)) + bs * GL_QKSZ + GL_KI;
            const unsigned aK1 = (unsigned)(((8 * hi + q4 + 4) << 8) | ((((2 * h16 + (p4 >> 1)) ^ ((q4 << 2) | ((2 * hi + 1) & 3))) & 15) << 4) | ((p4 & 1) << 3)) + bs * GL_QKSZ + GL_KI;
            const unsigned aD = GL_DEC + bs * 512 + 16 * hi;
            bf16x8 vf[4];
#pragma unroll
            for (int s = 0; s < 4; ++s) { const s16x4 lo = tr_rd(L + aV + s * 8192), hh = tr_rd(L + aV + s * 8192 + 2048);
                vf[s] = (bf16x8){lo[0], lo[1], lo[2], lo[3], hh[0], hh[1], hh[2], hh[3]}; }
#define GL_QDF(f, a) ({ const u32x2 q0_ = *(const LAS u32x2*)(L + (aC ^ ((2 * (f)) << 4)) + (a) * 8192), q1_ = *(const LAS u32x2*)(L + (aC ^ ((2 * (f) + 1) << 4)) + (a) * 8192); (v4u){q0_.x, q0_.y, q1_.x, q1_.y}; })
#define GL_KIF(f) ({ const s16x4 lo_ = tr_rd(L + (aK0 ^ (((f) >> 2) << 6)) + ((f) & 3) * 4096), hh_ = tr_rd(L + (aK1 ^ (((f) >> 2) << 6)) + ((f) & 3) * 4096); (bf16x8){lo_[0], lo_[1], lo_[2], lo_[3], hh_[0], hh_[1], hh_[2], hh_[3]}; })
            if (MODE == 1) {
#pragma unroll
            for (int a = 0; a < 2; ++a) {
                f32x16 oT;
#pragma unroll
                for (int r = 0; r < 16; ++r) oT[r] = 0.f;
                v4u qf[4]; bf16x8 pf[4];
                qf[0] = GL_QDF(0, a); qf[1] = GL_QDF(1, a); qf[2] = GL_QDF(2, a);
                __builtin_amdgcn_sched_barrier(0);
#pragma unroll
                for (int f = 0; f < 8; ++f) {
                    if (f + 3 < 8) qf[(f + 3) & 3] = GL_QDF(f + 3, a);
                    if (f == 6) { pf[0] = *(const LAS bf16x8*)(L + (aPr ^ (0 << 5)) + a * 4096); pf[1] = *(const LAS bf16x8*)(L + (aPr ^ (1 << 5)) + a * 4096); }
                    if (f == 7) { pf[2] = *(const LAS bf16x8*)(L + (aPr ^ (2 << 5)) + a * 4096); pf[3] = *(const LAS bf16x8*)(L + (aPr ^ (3 << 5)) + a * 4096); }
                    oT = MFMA32(pack_step(S[f >> 1], f & 1), __builtin_bit_cast(bf16x8, qf[f & 3]), oT);
                    __builtin_amdgcn_sched_barrier(0); }
#pragma unroll
                for (int s = 0; s < 4; ++s) oT = MFMA32(vf[s], pf[s], oT);
                { const unsigned ost = GL_OST + w * GL_OSTW;
#pragma unroll
                  for (int g = 0; g < 4; ++g) { u32x2 ow; ow.x = cvtpk(oT[4 * g], oT[4 * g + 1]); ow.y = cvtpk(oT[4 * g + 2], oT[4 * g + 3]); *(LAS u32x2*)(L + ost + r32 * 80 + 16 * g + 8 * hi) = ow; }
                  asm volatile("s_waitcnt lgkmcnt(0)" ::: "memory");
#pragma unroll
                  for (int i = 0; i < 2; ++i) { const int tk = (ln_ >> 2) + 16 * i; const v4u ov = *(const LAS v4u*)(L + ost + tk * 80 + 16 * (ln_ & 3));
                      *(v4u*)(O + GL_ROW(n, 32 * a + tk) * 1024 + h * 256 + 32 * w + 8 * (ln_ & 3)) = ov; }
                  asm volatile("s_waitcnt lgkmcnt(0)" ::: "memory"); }
            }
            }
            {
                bf16x8 kf[4]; kf[0] = GL_KIF(0); kf[1] = GL_KIF(1); kf[2] = GL_KIF(2);
                f32x4 d4[4];
                __builtin_amdgcn_sched_barrier(0);
#pragma unroll
                for (int f = 0; f < 16; ++f) {
                    if (f + 3 < 16) kf[(f + 3) & 3] = GL_KIF(f + 3);
                    if ((f & 3) == 1) {
#pragma unroll
                        for (int g = 0; g < 4; ++g) d4[g] = *(const LAS f32x4*)(L + aD + 128 * (f >> 2) + 32 * g); }
                    S[f >> 2] = MFMA32(kf[f & 3], vf[f & 3], S[f >> 2]);
                    if ((f & 3) == 3) { const int j = f >> 2;
#pragma unroll
                        for (int g = 0; g < 4; ++g)
#pragma unroll
                            for (int e = 0; e < 4; ++e) S[j][4 * g + e] *= d4[g][e]; }
                    __builtin_amdgcn_sched_barrier(0);
                }
            }
#undef GL_QDF
#undef GL_KIF
        }
        if (MODE == 0) { if (n + 2 < n1e) asm volatile("s_waitcnt vmcnt(8)" ::: "memory"); else asm volatile("s_waitcnt vmcnt(0)" ::: "memory"); }
        __syncthreads();
    }
    if (dump) {
        float* sl = gl_sloc(F) + ((size_t)(item * 8 + w) * 64) * 64 + F.lane;
#pragma unroll
        for (int j = 0; j < 4; ++j)
#pragma unroll
            for (int r = 0; r < 16; ++r) sl[(size_t)(j * 16 + r) * 64] = S[j][r];
        if (F.tid < 128) gl_dseg(F)[(size_t)item * 128 + F.tid] = dprod; }
#undef GL_STAGE_A
#undef GL_LOAD
#undef GL_LOAD_LR
#undef GL_WAIT
#undef GL_DMA_V
#undef GL_LANE
#undef GL_ROW
#undef GL_OPAQUE
}

constexpr int CW_SWAQ = 64;
constexpr int SWA_ITEMS = BATCH * 2 * 32 * 2;
__device__ __forceinline__ void swa_mfma(Frame& F, int dummy_o = 0, int abl = 0, int max_items = 1 << 30, int limit = 1 << 30) {
    const int lane = F.lane, w = F.wave, r32 = lane & 31, hi = lane >> 5, tid = F.tid;
    const int g16 = lane >> 4, i16 = lane & 15, q4 = i16 >> 2, p4 = i16 & 3, h16 = g16 & 1;
    LAS unsigned char* L = F.lds + RING_OFF;
    volatile LAS unsigned* qword = F.MISC + 16;
    unsigned step = 0;
    bf16* SQp = F.SQ(); const bf16* SKp = F.SK(); const bf16* SVp = F.SV(); const float* sinksp = inp(I_SINKS);
    bool fastsm;
    { const float* gq = inp(I_GQ); const float* gk = inp(I_GK);
      const float a = wave_max(fmaxf(fabsf(gq[lane]), fabsf(gq[lane + 64]))), b2 = wave_max(fmaxf(fabsf(gk[lane]), fabsf(gk[lane + 64]))), sk = wave_max(lane < 8 ? fabsf(sinksp[lane]) : 0.f);
      fastsm = __builtin_amdgcn_readfirstlane((16.4f * a * b2 + 1.4426950408889634f * sk < 60.f) ? 1 : 0) != 0; }
    if (tid == 0 && qword[1] == 0u) { qword[0] = __hip_atomic_fetch_add(F.ctl + CW_SWAQ, 1u, __ATOMIC_RELAXED, __HIP_MEMORY_SCOPE_AGENT); qword[1] = 1u; }
    __syncthreads();
    int item = (int)qword[0], done = 0;
    while (item < SWA_ITEMS && done < max_items) {
        ++done;
        unsigned nxt = 0xffffffffu;
        if (tid == 0 && item < limit) nxt = __hip_atomic_fetch_add(F.ctl + CW_SWAQ, 1u, __ATOMIC_RELAXED, __HIP_MEMORY_SCOPE_AGENT);
        const int hp = item & 1, n = (item >> 1) & 31, kvh = (item >> 6) & 1, b = item >> 7;
        const int head = 4 * kvh + 2 * hp + (w >> 2), qt = w & 3, qi = 128 * n + 32 * qt + r32;
        const size_t rowb = (size_t)b * SEQ;
        bf16* qp = SQp + (rowb + qi) * 1024 + head * 128;
        bf16x8 qf[8];
        { LAS unsigned char* qst = L + 65536 + w * 8704; const bf16* qb = SQp + (rowb + 128 * n + 32 * qt) * 1024 + head * 128;
          v4u qv[8];
#pragma unroll
          for (int i = 0; i < 8; ++i) qv[i] = (abl & 64) ? (v4u){0u, 0u, 0u, 0u} : *(const v4u*)(qb + (size_t)(4 * i + (lane >> 4)) * 1024 + 8 * (lane & 15));
#pragma unroll
          for (int i = 0; i < 8; ++i) *(LAS v4u*)(qst + (4 * i + (lane >> 4)) * 272 + 16 * (lane & 15)) = qv[i];
          asm volatile("s_waitcnt lgkmcnt(0)" ::: "memory");
#pragma unroll
          for (int s = 0; s < 8; ++s) qf[s] = *(const LAS bf16x8*)(qst + r32 * 272 + 16 * (2 * s + hi));
          asm volatile("s_waitcnt lgkmcnt(0)" ::: "memory"); }
        float m = sinksp[head] * 1.4426950408889634f, l = hi ? 0.f : 1.f;
        f32x16 O[4];
#pragma unroll
        for (int dt = 0; dt < 4; ++dt)
#pragma unroll
            for (int r = 0; r < 16; ++r) O[dt][r] = 0.f;
        const int t_lo = (n == 0) ? 2 : 0, t_hi = (n == 31) ? 4 : 6;
        const bf16* kg = SKp + rowb * 256 + kvh * 128; const bf16* vg = SVp + rowb * 256 + kvh * 128;
        v4u kr[2], vr[2];
#define SW_LOAD(t_) do { const int k0_ = 128 * (n - 1) + 64 * (t_); _Pragma("unroll") for (int i_ = 0; i_ < 2; ++i_) { const int c_ = tid + 512 * i_, key_ = c_ >> 4, ch_ = c_ & 15; \
            kr[i_] = *(const v4u*)(kg + (size_t)(k0_ + key_) * 256 + 8 * ch_); vr[i_] = *(const v4u*)(vg + (size_t)(k0_ + key_) * 256 + 8 * ch_); } } while (0)
#define SW_STORE(bsel) do { _Pragma("unroll") for (int i_ = 0; i_ < 2; ++i_) { const int c_ = tid + 512 * i_, key_ = c_ >> 4, ch_ = c_ & 15; \
            *(LAS v4u*)(L + (bsel) * 32768 + qk_off(key_, ch_)) = kr[i_]; *(LAS v4u*)(L + (bsel) * 32768 + 16384 + qk_off(key_, ch_)) = vr[i_]; } } while (0)
        if (!(abl & 8)) SW_LOAD(t_lo); else { kr[0] = kr[1] = vr[0] = vr[1] = (v4u){0u, 0u, 0u, 0u}; }
        for (int t = t_lo; t < t_hi; ++t) {
            const int bs = step & 1; ++step;
            if (!(abl & 16)) SW_STORE(bs);
            __syncthreads();
            if (t + 1 < t_hi && !(abl & 8)) SW_LOAD(t + 1);
            const int k0 = 128 * (n - 1) + 64 * t, qlo = 128 * n + 32 * qt;
            if (k0 + 63 >= qlo - 128 && k0 <= qlo + 31 + 128 && !(abl & 32)) {
                LAS unsigned char* K = L + bs * 32768; LAS unsigned char* V = K + 16384;
                f32x16 p0, p1;
#pragma unroll
                for (int r = 0; r < 16; ++r) { p0[r] = 0.f; p1[r] = 0.f; }
                unsigned aKr = (unsigned)(bs * 32768) + (unsigned)((r32 << 8) | ((hi ^ (((r32 & 3) << 2) | ((r32 >> 2) & 3))) << 4)); asm volatile("" : "+v"(aKr));
#define SW_KF(s_, half) (*(const LAS bf16x8*)(L + (aKr ^ ((2 * (s_)) << 4)) + (half) * 8192))
                bf16x8 ka[4], kb[4];
                ka[0] = SW_KF(0, 0); kb[0] = SW_KF(0, 1); ka[1] = SW_KF(1, 0); kb[1] = SW_KF(1, 1); ka[2] = SW_KF(2, 0); kb[2] = SW_KF(2, 1);
                __builtin_amdgcn_sched_barrier(0);
#pragma unroll
                for (int s = 0; s < 8; ++s) {
                    if (s + 3 < 8) { ka[(s + 3) & 3] = SW_KF(s + 3, 0); kb[(s + 3) & 3] = SW_KF(s + 3, 1); }
                    if (!(abl & 1)) { p0 = MFMA32(ka[s & 3], qf[s], p0); p1 = MFMA32(kb[s & 3], qf[s], p1); }
                    __builtin_amdgcn_sched_barrier(0); }
#undef SW_KF
                if (!(abl & 2)) {
                const bool needmask = !(k0 + 63 - qlo <= 128 && qlo + 31 - k0 <= 128);
                if (needmask) {
#pragma unroll
                    for (int r = 0; r < 16; ++r) { const int kj = k0 + (r & 3) + 8 * (r >> 2) + 4 * hi;
                        p0[r] = ((unsigned)(qi - kj + 128) <= 256u) ? p0[r] : -INFINITY; p1[r] = ((unsigned)(qi - kj - 32 + 128) <= 256u) ? p1[r] : -INFINITY; } }
                float mn = m, alpha = 1.f;
                if (!fastsm) { float mloc = -INFINITY;
#pragma unroll
                    for (int r = 0; r < 16; ++r) mloc = fmaxf(mloc, fmaxf(p0[r], p1[r]));
                    mloc = fmaxf(mloc, __shfl_xor(mloc, 32));
                    mn = fmaxf(m, mloc); alpha = __builtin_amdgcn_exp2f(m - mn); m = mn; }
                float ls = 0.f;
#pragma unroll
                for (int r = 0; r < 16; ++r) { p0[r] = __builtin_amdgcn_exp2f(p0[r] - mn); p1[r] = __builtin_amdgcn_exp2f(p1[r] - mn); ls += p0[r] + p1[r]; }
                l = l * alpha + ls;
                if (!fastsm) {
#pragma unroll
                    for (int dt = 0; dt < 4; ++dt)
#pragma unroll
                        for (int r = 0; r < 16; ++r) O[dt][r] *= alpha; }
                }
                bf16x8 pb[4]; pb[0] = pack_step(p0, 0); pb[1] = pack_step(p0, 1); pb[2] = pack_step(p1, 0); pb[3] = pack_step(p1, 1);
                unsigned aVr0 = (unsigned)(bs * 32768 + 16384) + (unsigned)(((4 * hi + q4) << 8) | ((((2 * h16 + (p4 >> 1)) ^ ((q4 << 2) | hi)) & 15) << 4) | ((p4 & 1) << 3));
                unsigned aVr1 = (unsigned)(bs * 32768 + 16384) + (unsigned)(((4 * hi + q4 + 8) << 8) | ((((2 * h16 + (p4 >> 1)) ^ ((q4 << 2) | (2 + hi))) & 15) << 4) | ((p4 & 1) << 3));
                asm volatile("" : "+v"(aVr0), "+v"(aVr1));
#define SW_VF(f_) ({ const s16x4 lo_ = tr_rd(L + (aVr0 ^ (((f_) >> 2) << 6)) + ((f_) & 3) * 4096), hh_ = tr_rd(L + (aVr1 ^ (((f_) >> 2) << 6)) + ((f_) & 3) * 4096); (bf16x8){lo_[0], lo_[1], lo_[2], lo_[3], hh_[0], hh_[1], hh_[2], hh_[3]}; })
                bf16x8 vf[4]; vf[0] = SW_VF(0); vf[1] = SW_VF(1); vf[2] = SW_VF(2);
                __builtin_amdgcn_sched_barrier(0);
#pragma unroll
                for (int f = 0; f < 16; ++f) {
                    if (f + 3 < 16) vf[(f + 3) & 3] = SW_VF(f + 3);
                    if (!(abl & 4)) O[f >> 2] = MFMA32(vf[f & 3], pb[f & 3], O[f >> 2]);
                    __builtin_amdgcn_sched_barrier(0); }
#undef SW_VF
            }
        }
#undef SW_LOAD
#undef SW_STORE
        l += __shfl_xor(l, 32);
        const float inv = 1.0f / l;
        if (!(abl & 64)) {
            LAS unsigned char* ost = L + 65536 + w * 8704;
#pragma unroll
            for (int dt = 0; dt < 4; ++dt)
#pragma unroll
                for (int g = 0; g < 4; ++g) { u32x2 ow; ow.x = cvtpk(O[dt][4 * g] * inv, O[dt][4 * g + 1] * inv); ow.y = cvtpk(O[dt][4 * g + 2] * inv, O[dt][4 * g + 3] * inv);
                    *(LAS u32x2*)(ost + r32 * 272 + 2 * (32 * dt + 8 * g + 4 * hi)) = ow; }
            asm volatile("s_waitcnt lgkmcnt(0)" ::: "memory");
            bf16* ob = dummy_o ? (bf16*)(F.ws + WS_DUMMY) + (size_t)((128 * n + 32 * qt) & 1023) * 1024 + head * 128 : SQp + (rowb + 128 * n + 32 * qt) * 1024 + head * 128;
#pragma unroll
            for (int i = 0; i < 8; ++i) { const int row = 4 * i + (lane >> 4), ch = lane & 15; const v4u ov = *(const LAS v4u*)(ost + row * 272 + 16 * ch); *(v4u*)(ob + (size_t)row * 1024 + 8 * ch) = ov; }
            asm volatile("s_waitcnt lgkmcnt(0)" ::: "memory");
        }
        if (tid == 0) { qword[0] = nxt; qword[1] = (nxt != 0xffffffffu) ? 1u : 0u; }
        __syncthreads();
        const bool have = qword[1] != 0u; item = have ? (int)qword[0] : SWA_ITEMS;
        __syncthreads();
    }
}

constexpr int N_PHASES = 10;
constexpr int SWA_PHASE3_LIMIT = 600;
#ifndef STAGGER_US
#define STAGGER_US 0
#endif
__device__ __forceinline__ void stagger_wait(int us) { if (us > 0 && (blockIdx.x & 8)) { const unsigned long long t0 = __builtin_amdgcn_s_memrealtime(); while (__builtin_amdgcn_s_memrealtime() - t0 < (unsigned long long)us * 100ull) __builtin_amdgcn_s_sleep(8); } }
#ifndef PROBE_REP
#define PROBE_REP -1
#endif
#ifndef PROBE_N
#define PROBE_N 3
#endif
#ifndef PROBE_ABL
#define PROBE_ABL 0
#endif
static_assert(GLA_LDS_END <= LDSCTL_OFF, "GLA LDS map");
struct Args { const float* in[17]; float* out; unsigned char* ws; int ph_lo, ph_hi, use_bar, pad; };
__global__ void __launch_bounds__(NWAVES * 64, 2) mk_fwd(Args args) {
    extern __shared__ __attribute__((aligned(16))) unsigned char lds[];
    Frame F;
    F.lds = (LAS unsigned char*)lds;
    F.MISC = (volatile LAS unsigned*)(F.lds + MISC_OFF);
    F.tid = threadIdx.x; F.lane = F.tid & 63; F.wave = __builtin_amdgcn_readfirstlane(F.tid >> 6);
    F.G = gridDim.x; { const int bx = blockIdx.x; F.vcu = (F.G % 8 == 0) ? (bx % 8) * (F.G / 8) + bx / 8 : bx; }
    F.ws = args.ws; F.out = args.out;
    F.ctl = (gu32*)(args.ws + WS_CTL);
    for (int u = F.tid; u < (LDS_BYTES - LDSCTL_OFF) / 4; u += NWAVES * 64) ((LAS unsigned*)(F.lds + LDSCTL_OFF))[u] = 0u;
    __syncthreads();
    XcdBarrier bar; bar.bar = (unsigned*)(F.ctl + CW_BAR); bar.x = 0; bar.st = nullptr;
    if (args.use_bar) bar = xcd_barrier_post((unsigned*)(F.ctl + CW_BAR), F.MISC + 8);
    const int lo = args.ph_lo, hi = args.ph_hi;
#define IN(k) (lo <= (k) && (k) < hi)
#define SEAM(k) do { if (IN(k) && IN((k) + 1)) xcd_barrier(bar); } while (0)

    if (IN(0)) { p0_prologue(F); } SEAM(0);
    if (IN(1)) {
#if PROBE_REP == 11
        p1_lr(F);
#endif
        stagger_wait(STAGGER_US);
        pg8::Gemm g{F.XN(), F.WIN(), M, NPROJ, DM}; pg8::StaticOrder S; S.init(M, NPROJ, F.G, (int)blockIdx.x);
        static_assert(pg8::EpiProj::O_QG == WS_QG && pg8::EpiProj::O_KG == WS_KG && pg8::EpiProj::O_VG == WS_VG && pg8::EpiProj::O_R == WS_R && pg8::EpiProj::O_SQ == WS_SQ && pg8::EpiProj::O_SK == WS_SK && pg8::EpiProj::O_SV == WS_SV && pg8::EpiProj::O_GA == WS_GA && pg8::EpiProj::O_GB == WS_GB, "EpiProj offsets");
        pg8::EpiProj E{F.ws, args.pad & 128};
        pg8::gemm_phase<pg8::EpiProj, pg8::StaticOrder, true, true>(F.lds + RING_OFF, g, S, E);
    } SEAM(1);
    if (IN(2)) { p1b_qknorm_rope(F, args.pad & 8); } SEAM(2);
    if (IN(3)) { if ((args.pad & 3) != 2) gla_mfma<0>(F, F.vcu); __syncthreads(); if ((args.pad & 3) != 1) swa_mfma(F, args.pad & 8, args.pad >> 8); } SEAM(3);
    if (IN(4)) { gla_mfma<1>(F, F.vcu); } SEAM(4);
    if (IN(5)) { p2c_combine(F, args.pad & 8); } SEAM(5);
    if (IN(6)) {
        pg8::Gemm g{F.R(), F.WG(), M, DM, DM, F.SQ(), F.WS_()}; pg8::StaticOrder S; S.init(M, DM, F.G, (int)blockIdx.x);
        pg8::EpiMerge2 E{F.GA(), F.GB(), F.MERGED()};
        pg8::gemm_phase<pg8::EpiMerge2, pg8::StaticOrder, true, true, true>(F.lds + RING_OFF, g, S, E);
    } SEAM(6);
    if (IN(7)) {
        pg8::Gemm g{F.MERGED(), F.WOUT(), M, DM, DM}; pg8::StaticOrder S; S.init(M, DM, F.G, (int)blockIdx.x);
        pg8::EpiX1 E{inp(I_X), F.X1B(), F.SSQ()};
        pg8::gemm_phase<pg8::EpiX1, pg8::StaticOrder, true, true>(F.lds + RING_OFF, g, S, E);
    } SEAM(7);
    if (IN(8)) {
        stagger_wait(STAGGER_US);
        pg8::Gemm g{F.X1B(), F.WFI(), M, 2 * DFF, DM}; pg8::StaticOrder S; S.init(M, 2 * DFF, F.G, (int)blockIdx.x);
        pg8::EpiSwiGLU E{F.SSQ(), F.H()};
        pg8::gemm_phase<pg8::EpiSwiGLU, pg8::StaticOrder, true, true>(F.lds + RING_OFF, g, S, E);
    } SEAM(8);
    if (IN(9)) {
        pg8::Gemm g{F.H(), F.WFO(), M, DM, DFF}; pg8::StaticOrder S; S.init(M, DM, F.G, (int)blockIdx.x);
        pg8::EpiResid E{F.X1B(), F.out};
        pg8::gemm_phase<pg8::EpiResid, pg8::StaticOrder, true, true>(F.lds + RING_OFF, g, S, E);
    }
#undef IN
#undef SEAM
}

#ifndef MK_ONE_LAUNCH
#define MK_ONE_LAUNCH 1
#endif
extern "C" void kernel_launch(void* const* d_in, const int* in_sizes, int n_in, void* d_out, int out_size, void* d_ws, size_t ws_size, hipStream_t stream) {
    static int grid = 0;
    if (grid == 0) {
        if (n_in != 17 || in_sizes[0] != M * DM || out_size != M * DM || ws_size < WS_END + 33 * MiB) { fprintf(stderr, "kernel_launch: shape/workspace mismatch (n_in %d, in0 %d, out %d, ws %zu); nothing launched\n", n_in, n_in > 0 ? in_sizes[0] : -1, out_size, ws_size); grid = -1; return; }
        int dev = 0, cus = 0;
        if (hipGetDevice(&dev) != hipSuccess || hipDeviceGetAttribute(&cus, hipDeviceAttributeMultiprocessorCount, dev) != hipSuccess) { grid = -1; return; }
        if (hipFuncSetAttribute((const void*)mk_fwd, hipFuncAttributeMaxDynamicSharedMemorySize, LDS_BYTES) != hipSuccess) { fprintf(stderr, "kernel_launch: hipFuncSetAttribute failed\n"); grid = -1; return; }
        (void)hipGetLastError();
        grid = cus;
        if (grid != 256) fprintf(stderr, "kernel_launch: %d CUs; built for 256\n", grid);
    }
    if (grid < 0) return;
    (void)hipMemsetAsync((char*)d_ws + WS_CTL, 0, CTL_ZERO_BYTES, stream);
    Args a{};
    for (int i = 0; i < 17; ++i) a.in[i] = (const float*)d_in[i];
    a.out = (float*)d_out; a.ws = (unsigned char*)d_ws;
#if PROBE_REP == -1
    a.ph_lo = 0; a.ph_hi = N_PHASES; a.use_bar = 1;
    hipLaunchKernelGGL(mk_fwd, dim3(grid), dim3(NWAVES * 64), LDS_BYTES, stream, a);
#else
    for (int p = 0; p < N_PHASES; ++p) { const int nrep = (p == PROBE_REP) ? PROBE_N : 1;
        if (p == 2 && PROBE_REP == 21) {
            a.ph_lo = 2; a.ph_hi = 3; a.use_bar = 0;
            for (int r = 0; r + 1 < PROBE_N; ++r) { a.pad = 2 | 8; hipLaunchKernelGGL(mk_fwd, dim3(grid), dim3(NWAVES * 64), LDS_BYTES, stream, a); }
            a.pad = 0; hipLaunchKernelGGL(mk_fwd, dim3(grid), dim3(NWAVES * 64), LDS_BYTES, stream, a); continue; }
        if (p == 4 && PROBE_REP == 40) {
            a.ph_lo = 4; a.ph_hi = 5; a.use_bar = 0;
            for (int r = 0; r + 1 < PROBE_N; ++r) { a.pad = 8; hipLaunchKernelGGL(mk_fwd, dim3(grid), dim3(NWAVES * 64), LDS_BYTES, stream, a); }
            a.pad = 0; hipLaunchKernelGGL(mk_fwd, dim3(grid), dim3(NWAVES * 64), LDS_BYTES, stream, a); continue; }
        if (p == 2 && PROBE_REP == 20) {
            a.ph_lo = 2; a.ph_hi = 3; a.use_bar = 0;
            for (int r = 0; r + 1 < PROBE_N; ++r) { a.pad = 5; hipLaunchKernelGGL(mk_fwd, dim3(grid), dim3(NWAVES * 64), LDS_BYTES, stream, a); }
            a.pad = 0; hipLaunchKernelGGL(mk_fwd, dim3(grid), dim3(NWAVES * 64), LDS_BYTES, stream, a); continue; }
        if (p == 1 && PROBE_REP == 11) {
            a.ph_lo = 1; a.ph_hi = 2; a.use_bar = 0; a.pad = 16; hipLaunchKernelGGL(mk_fwd, dim3(grid), dim3(NWAVES * 64), LDS_BYTES, stream, a); a.pad = 0; continue; }
        if (p == 1 && PROBE_REP == 12) {
            a.ph_lo = 1; a.ph_hi = 2; a.use_bar = 0;
            for (int r = 0; r + 1 < PROBE_N; ++r) { a.pad = 128; hipLaunchKernelGGL(mk_fwd, dim3(grid), dim3(NWAVES * 64), LDS_BYTES, stream, a); }
            a.pad = 0; hipLaunchKernelGGL(mk_fwd, dim3(grid), dim3(NWAVES * 64), LDS_BYTES, stream, a); continue; }
        if (p == 4 && PROBE_REP == 41) {
            a.ph_lo = 4; a.ph_hi = 5; a.use_bar = 0;
            for (int r = 0; r + 1 < PROBE_N; ++r) { a.pad = 4 | (PROBE_ABL << 8); hipLaunchKernelGGL(mk_fwd, dim3(grid), dim3(NWAVES * 64), LDS_BYTES, stream, a); }
            a.pad = 0; hipLaunchKernelGGL(mk_fwd, dim3(grid), dim3(NWAVES * 64), LDS_BYTES, stream, a); continue; }
        if (p == 3 && PROBE_REP == 36) {
            a.ph_lo = 3; a.ph_hi = 4; a.use_bar = 0;
            for (int r = 0; r + 1 < PROBE_N; ++r) { a.pad = 1; hipLaunchKernelGGL(mk_fwd, dim3(grid), dim3(NWAVES * 64), LDS_BYTES, stream, a); }
            a.pad = 0; hipLaunchKernelGGL(mk_fwd, dim3(grid), dim3(NWAVES * 64), LDS_BYTES, stream, a); continue; }
        if (p == 3 && PROBE_REP == 37) {
            a.ph_lo = 3; a.ph_hi = 4; a.use_bar = 0;
            for (int r = 0; r + 1 < PROBE_N; ++r) { a.pad = 8; hipLaunchKernelGGL(mk_fwd, dim3(grid), dim3(NWAVES * 64), LDS_BYTES, stream, a); (void)hipMemsetAsync((char*)d_ws + WS_CTL, 0, 4096, stream); }
            a.pad = 0; hipLaunchKernelGGL(mk_fwd, dim3(grid), dim3(NWAVES * 64), LDS_BYTES, stream, a); continue; }
        if (p == 3 && PROBE_REP == 35) {
            a.ph_lo = 3; a.ph_hi = 4; a.use_bar = 0;
            for (int r = 0; r + 1 < PROBE_N; ++r) { a.pad = 2 | 8 | (PROBE_ABL << 8); hipLaunchKernelGGL(mk_fwd, dim3(grid), dim3(NWAVES * 64), LDS_BYTES, stream, a); (void)hipMemsetAsync((char*)d_ws + WS_CTL, 0, 4096, stream); }
            a.pad = 0; hipLaunchKernelGGL(mk_fwd, dim3(grid), dim3(NWAVES * 64), LDS_BYTES, stream, a); continue; }
        if (p == 3 && PROBE_REP >= 30 && PROBE_REP < 40) {
            a.ph_lo = 3; a.ph_hi = 4; a.use_bar = 0;
            for (int r = 0; r < (PROBE_REP == 30 ? 1 : PROBE_N); ++r) { a.pad = (r + 1 < (PROBE_REP == 30 ? 1 : PROBE_N)) ? 5 : 1; hipLaunchKernelGGL(mk_fwd, dim3(grid), dim3(NWAVES * 64), LDS_BYTES, stream, a); }
            a.pad = 2; hipLaunchKernelGGL(mk_fwd, dim3(grid), dim3(NWAVES * 64), LDS_BYTES, stream, a); a.pad = 0; continue; }
        for (int r = 0; r < nrep; ++r) { a.ph_lo = p; a.ph_hi = p + 1; a.use_bar = 0; hipLaunchKernelGGL(mk_fwd, dim3(grid), dim3(NWAVES * 64), LDS_BYTES, stream, a); } }
#endif
}
```

```cpp
#include <hip/hip_runtime.h>
#include <cstdio>
#include <cstdint>
#include <cmath>
namespace pg8 {
#define PG8_LAS __attribute__((address_space(3)))
typedef unsigned short bf16_t;
typedef short bf16x8 __attribute__((ext_vector_type(8)));
typedef float f32x4 __attribute__((ext_vector_type(4)));
typedef unsigned u32x4 __attribute__((ext_vector_type(4)));
constexpr int BM = 256, BK = 64, HALF = 128, HTB = HALF * BK * 2  , STAGE_BYTES = 8 * HTB, NXCD = 8, WGM = 8;

__host__ __device__ __forceinline__ int lds_byte(int r, int c) { const int st = (r >> 4) * 2 + (c >> 5), rr = r & 15, cc = c & 31, ob = rr * 64 + cc * 2; return st * 1024 + (ob ^ (((ob >> 9) & 1) << 5)); }
__host__ __device__ __forceinline__ void stage_rc(int b, int& R, int& C) { const int st = b / 1024, sb = b % 1024, swz = sb ^ (((sb >> 9) & 1) << 5); R = (st >> 1) * 16 + swz / 64; C = (st & 1) * 32 + (swz % 64) / 2; }
__host__ __device__ __forceinline__ int perm32(int rho) { const int n = rho >> 4, i = rho & 15; return 8 * (i >> 2) + 4 * n + (i & 3); }

template <class E> struct epi_has_post { static constexpr bool v = false; };
struct Unit { int pm, pn; };
struct Gemm { const bf16_t* A; const bf16_t* Bt; int M, N, K; const bf16_t* A2 = nullptr; const bf16_t* Bt2 = nullptr; };

struct StaticOrder {
    int nM, nN, nwg, G, c;
    __host__ __device__ void init(int M, int N, int G_, int c_) { nM = M / BM; nN = N / BM; nwg = nM * nN; G = G_; c = c_; }
    __host__ __device__ bool next(int i, Unit& u) const {
        const long L = (long)i * G + c; if (L >= nwg) return false;
        int wgid = (int)L; { const int q = nwg / NXCD, r = nwg % NXCD, xcd = wgid % NXCD, off = wgid / NXCD; wgid = (xcd < r ? xcd * (q + 1) : r * (q + 1) + (xcd - r) * q) + off; }
        const int nig = WGM * nN, gid = wgid / nig, fm = gid * WGM, gsz = (nM - fm) < WGM ? (nM - fm) : WGM;
        u.pm = fm + ((wgid % nig) % gsz); u.pn = (wgid % nig) / gsz; return true;
    }
    __device__ __forceinline__ void a_ready(const Unit&) const {}
    __device__ __forceinline__ void done(const Unit&) const {}
};

__device__ __forceinline__ unsigned cvt_pk_bf16(float lo, float hi) { unsigned r; asm volatile("v_cvt_pk_bf16_f32 %0, %1, %2" : "=v"(r) : "v"(lo), "v"(hi)); return r; }
typedef float f32x2 __attribute__((ext_vector_type(2)));
typedef unsigned u32x2 __attribute__((ext_vector_type(2)));
__device__ __forceinline__ float bflo(unsigned w) { return __uint_as_float(w << 16); }
__device__ __forceinline__ float bfhi(unsigned w) { return __uint_as_float(w & 0xffff0000u); }
__device__ __forceinline__ float sigm(float x) { return __builtin_amdgcn_rcpf(1.0f + __builtin_amdgcn_exp2f(-1.4426950408889634f * x)); }

struct EpiProj {
    static constexpr bool PERM = true, AFTER_DRAIN = false;
    static constexpr size_t MB = 1u << 20, O_QG = 48 * MB, O_KG = 80 * MB, O_VG = 112 * MB, O_R = 176 * MB, O_SQ = 240 * MB, O_SK = 304 * MB, O_SV = 320 * MB, O_GA = 336 * MB, O_GB = 400 * MB;
    unsigned char* ws; int skip;
    __device__ __forceinline__ void operator()(const f32x4 (&acc)[2][2][4][2], const Unit& u, int wr, int wc, int fr, int fq) const { part(acc, u, wr, wc, fr, fq, 0); part(acc, u, wr, wc, fr, fq, 1); }
    __device__ __forceinline__ void part(const f32x4 (&acc)[2][2][4][2], const Unit& u, int wr, int wc, int fr, int fq, const int ai) const {
        if (skip) { asm volatile("" :: "v"(acc[0][0][0][0]), "v"(acc[1][1][3][1])); return; }
        const int pn = u.pn; size_t off; int ldc, ct; float sc = 1.f;
        if (pn < 2) { off = O_QG; ldc = 512; ct = pn * 256; sc = 0.08838834764831845f; }
        else if (pn < 4) { off = O_KG; ldc = 512; ct = (pn - 2) * 256; }
        else if (pn < 8) { off = O_VG; ldc = 1024; ct = (pn - 4) * 256; }
        else if (pn < 12) { off = O_R; ldc = 1024; ct = (pn - 8) * 256; }
        else if (pn < 16) { off = O_SQ; ldc = 1024; ct = (pn - 12) * 256; }
        else if (pn == 16) { off = O_SK; ldc = 256; ct = 0; }
        else if (pn == 17) { off = O_SV; ldc = 256; ct = 0; }
        else if (pn < 22) { off = O_GA; ldc = 1024; ct = (pn - 18) * 256; }
        else { off = O_GB; ldc = 1024; ct = (pn - 22) * 256; }
        bf16_t* base = (bf16_t*)(ws + off);
        const int row0 = u.pm * BM + wr * 64 + fr, col0 = ct + wc * 32 + 8 * fq;
#pragma unroll
            for (int m = 0; m < 4; ++m) { bf16_t* rowp = base + (size_t)(row0 + ai * HALF + m * 16) * ldc + col0;
#pragma unroll
                for (int bj = 0; bj < 2; ++bj) { const f32x4 v0 = acc[ai][bj][m][0] * sc, v1 = acc[ai][bj][m][1] * sc;
                    u32x4 w; w.x = cvt_pk_bf16(v0[0], v0[1]); w.y = cvt_pk_bf16(v0[2], v0[3]); w.z = cvt_pk_bf16(v1[0], v1[1]); w.w = cvt_pk_bf16(v1[2], v1[3]);
                    *(u32x4*)(rowp + bj * HALF) = w; } }
    }
};
struct QkPost {
    bf16_t *SQ, *SK; const float *rope, *g_q, *g_k; float qsc;
    __device__ __forceinline__ void post(const Unit& u, int tid) const {
        const int wave = tid >> 6, lane = tid & 63, slot = lane >> 3, c = lane & 7; const bool isq = u.pn < 16;
        bf16_t* base = isq ? SQ + (size_t)(u.pn - 12) * 256 : SK; const int ldc = isq ? 1024 : 256; const float* gn = isq ? g_q : g_k; const float sc = isq ? qsc : 1.f;
        const f32x4 g10 = *(const f32x4*)(gn + 8 * c), g11 = *(const f32x4*)(gn + 8 * c + 4), g20 = *(const f32x4*)(gn + 64 + 8 * c), g21 = *(const f32x4*)(gn + 64 + 8 * c + 4);
#pragma unroll 1
        for (int rd = 0; rd < 2; ++rd) {
            u32x4 a1[4], a2[4]; f32x4 cs[4][4]; bf16_t* pp[4];
#pragma unroll
            for (int q = 0; q < 4; ++q) { const int idx = ((rd * 4 + q) * 8 + wave) * 8 + slot, row = u.pm * BM + (idx >> 1), pos = row & 4095;
                pp[q] = base + (size_t)row * ldc + (idx & 1) * 128; a1[q] = *(const u32x4*)(pp[q] + 8 * c); a2[q] = *(const u32x4*)(pp[q] + 64 + 8 * c);
                const f32x4* rp = (const f32x4*)(rope + 2 * (pos * 64 + 8 * c));
#pragma unroll
                for (int j = 0; j < 4; ++j) cs[q][j] = rp[j]; }
#pragma unroll
            for (int q = 0; q < 4; ++q) { float x1[8], x2[8];
                x1[0] = bflo(a1[q].x); x1[1] = bfhi(a1[q].x); x1[2] = bflo(a1[q].y); x1[3] = bfhi(a1[q].y); x1[4] = bflo(a1[q].z); x1[5] = bfhi(a1[q].z); x1[6] = bflo(a1[q].w); x1[7] = bfhi(a1[q].w);
                x2[0] = bflo(a2[q].x); x2[1] = bfhi(a2[q].x); x2[2] = bflo(a2[q].y); x2[3] = bfhi(a2[q].y); x2[4] = bflo(a2[q].z); x2[5] = bfhi(a2[q].z); x2[6] = bflo(a2[q].w); x2[7] = bfhi(a2[q].w);
                float ss = 0.f;
#pragma unroll
                for (int e = 0; e < 8; ++e) ss += x1[e] * x1[e] + x2[e] * x2[e];
                ss += __shfl_xor(ss, 1); ss += __shfl_xor(ss, 2); ss += __shfl_xor(ss, 4);
                const float rstd = sc * __builtin_amdgcn_rsqf(ss * (1.f / 128.f) + 1e-6f);
                float o1[8], o2[8];
#pragma unroll
                for (int e = 0; e < 8; ++e) { const float y1 = x1[e] * rstd * (e < 4 ? g10[e & 3] : g11[e & 3]), y2 = x2[e] * rstd * (e < 4 ? g20[e & 3] : g21[e & 3]);
                    const float cc = cs[q][e >> 1][2 * (e & 1)], sn = cs[q][e >> 1][2 * (e & 1) + 1]; o1[e] = y1 * cc - y2 * sn; o2[e] = y2 * cc + y1 * sn; }
                u32x4 w1, w2; w1.x = cvt_pk_bf16(o1[0], o1[1]); w1.y = cvt_pk_bf16(o1[2], o1[3]); w1.z = cvt_pk_bf16(o1[4], o1[5]); w1.w = cvt_pk_bf16(o1[6], o1[7]);
                w2.x = cvt_pk_bf16(o2[0], o2[1]); w2.y = cvt_pk_bf16(o2[2], o2[3]); w2.z = cvt_pk_bf16(o2[4], o2[5]); w2.w = cvt_pk_bf16(o2[6], o2[7]);
                *(u32x4*)(pp[q] + 8 * c) = w1; *(u32x4*)(pp[q] + 64 + 8 * c) = w2; }
        }
    }
};
struct EpiMerge2 {
    static constexpr bool PERM = true, AFTER_DRAIN = false;
    const bf16_t* ga; const bf16_t* gb; bf16_t* out;
    __device__ __forceinline__ void mid(f32x4 (&acc)[2][2][4][2], const Unit& u, int wr, int wc, int fr, int fq) const {
        int row0 = u.pm * BM + wr * 64 + fr, col0 = u.pn * BM + wc * 32 + 8 * fq; asm volatile("" : "+v"(row0), "+v"(col0));
#pragma unroll
        for (int ai = 0; ai < 2; ++ai)
#pragma unroll
            for (int m = 0; m < 4; ++m) { const size_t off = (size_t)(row0 + ai * HALF + m * 16) * 1024 + col0;
#pragma unroll
                for (int bj = 0; bj < 2; ++bj) { const size_t o2 = off + bj * HALF; const u32x4 a = *(const u32x4*)(ga + o2), b = *(const u32x4*)(gb + o2);
#define PG8_RATIO(aw, bw) ((1.0f + __builtin_amdgcn_exp2f(-1.4426950408889634f * (bw))) * __builtin_amdgcn_rcpf(1.0f + __builtin_amdgcn_exp2f(-1.4426950408889634f * (aw))))
                    acc[ai][bj][m][0][0] *= PG8_RATIO(bflo(a.x), bflo(b.x)); acc[ai][bj][m][0][1] *= PG8_RATIO(bfhi(a.x), bfhi(b.x)); acc[ai][bj][m][0][2] *= PG8_RATIO(bflo(a.y), bflo(b.y)); acc[ai][bj][m][0][3] *= PG8_RATIO(bfhi(a.y), bfhi(b.y));
                    acc[ai][bj][m][1][0] *= PG8_RATIO(bflo(a.z), bflo(b.z)); acc[ai][bj][m][1][1] *= PG8_RATIO(bfhi(a.z), bfhi(b.z)); acc[ai][bj][m][1][2] *= PG8_RATIO(bflo(a.w), bflo(b.w)); acc[ai][bj][m][1][3] *= PG8_RATIO(bfhi(a.w), bfhi(b.w));
#undef PG8_RATIO
                }
                if (m & 1) asm volatile("" ::: "memory"); }
    }
    __device__ __forceinline__ void operator()(const f32x4 (&acc)[2][2][4][2], const Unit& u, int wr, int wc, int fr, int fq) const {
        int row0 = u.pm * BM + wr * 64 + fr, col0 = u.pn * BM + wc * 32 + 8 * fq; asm volatile("" : "+v"(row0), "+v"(col0));
#pragma unroll
        for (int ai = 0; ai < 2; ++ai)
#pragma unroll
            for (int m = 0; m < 4; ++m) { const size_t off = (size_t)(row0 + ai * HALF + m * 16) * 1024 + col0;
#pragma unroll
                for (int bj = 0; bj < 2; ++bj) { const size_t o2 = off + bj * HALF; const u32x4 g = *(const u32x4*)(gb + o2);
                    const f32x4 a0 = acc[ai][bj][m][0], a1 = acc[ai][bj][m][1];
                    u32x4 w; w.x = cvt_pk_bf16(a0[0] * sigm(bflo(g.x)), a0[1] * sigm(bfhi(g.x))); w.y = cvt_pk_bf16(a0[2] * sigm(bflo(g.y)), a0[3] * sigm(bfhi(g.y)));
                    w.z = cvt_pk_bf16(a1[0] * sigm(bflo(g.z)), a1[1] * sigm(bfhi(g.z))); w.w = cvt_pk_bf16(a1[2] * sigm(bflo(g.w)), a1[3] * sigm(bfhi(g.w)));
                    *(u32x4*)(out + o2) = w; } }
    }
};
struct EpiX1 {
    static constexpr bool PERM = true, AFTER_DRAIN = false;
    const float* x; bf16_t* xb; float* ssq;
    __device__ __forceinline__ void operator()(const f32x4 (&acc)[2][2][4][2], const Unit& u, int wr, int wc, int fr, int fq) const {
        const int row0 = u.pm * BM + wr * 64 + fr, col0 = u.pn * BM + wc * 32 + 8 * fq;
#pragma unroll
        for (int ai = 0; ai < 2; ++ai)
#pragma unroll
            for (int m = 0; m < 4; ++m) { const int row = row0 + ai * HALF + m * 16; const size_t off = (size_t)row * 1024 + col0; float s = 0.f;
#pragma unroll
                for (int bj = 0; bj < 2; ++bj) { const size_t o2 = off + bj * HALF;
                    const f32x4 v0 = *(const f32x4*)(x + o2) + acc[ai][bj][m][0], v1 = *(const f32x4*)(x + o2 + 4) + acc[ai][bj][m][1];
                    s += ((v0[0] * v0[0] + v0[1] * v0[1]) + (v0[2] * v0[2] + v0[3] * v0[3])) + ((v1[0] * v1[0] + v1[1] * v1[1]) + (v1[2] * v1[2] + v1[3] * v1[3]));
                    u32x4 w; w.x = cvt_pk_bf16(v0[0], v0[1]); w.y = cvt_pk_bf16(v0[2], v0[3]); w.z = cvt_pk_bf16(v1[0], v1[1]); w.w = cvt_pk_bf16(v1[2], v1[3]); *(u32x4*)(xb + o2) = w; }
                s += __shfl_xor(s, 16); s += __shfl_xor(s, 32);
                if (fq == 0) ssq[(size_t)row * 16 + u.pn * 4 + wc] = s; }
    }
};
struct EpiSwiGLU {
    static constexpr bool PERM = true, AFTER_DRAIN = false;
    const float* ssq; bf16_t* H;
    __device__ __forceinline__ void operator()(const f32x4 (&acc)[2][2][4][2], const Unit& u, int wr, int wc, int fr, int fq) const {
        const int row0 = u.pm * BM + wr * 64 + fr, col0 = u.pn * HALF + wc * 32 + 8 * fq;
#pragma unroll
        for (int ai = 0; ai < 2; ++ai)
#pragma unroll
            for (int m = 0; m < 4; ++m) { const int row = row0 + ai * HALF + m * 16; const f32x4* sp = (const f32x4*)(ssq + (size_t)row * 16);
                const f32x4 s0 = sp[0], s1 = sp[1], s2 = sp[2], s3 = sp[3]; const f32x4 st = (s0 + s1) + (s2 + s3);
                const float rstd = __builtin_amdgcn_rsqf(((st[0] + st[1]) + (st[2] + st[3])) * (1.0f / 1024.0f) + 1e-6f);
                float hv[8];
#pragma unroll
                for (int n = 0; n < 2; ++n)
#pragma unroll
                    for (int e = 0; e < 4; ++e) { const float g = acc[ai][0][m][n][e] * rstd, up = acc[ai][1][m][n][e] * rstd; hv[4 * n + e] = g * sigm(g) * up; }
                u32x4 w; w.x = cvt_pk_bf16(hv[0], hv[1]); w.y = cvt_pk_bf16(hv[2], hv[3]); w.z = cvt_pk_bf16(hv[4], hv[5]); w.w = cvt_pk_bf16(hv[6], hv[7]);
                *(u32x4*)(H + (size_t)row * 2816 + col0) = w; }
    }
};
struct EpiResid {
    static constexpr bool PERM = true, AFTER_DRAIN = false;
    const bf16_t* xb; float* out;
    __device__ __forceinline__ void operator()(const f32x4 (&acc)[2][2][4][2], const Unit& u, int wr, int wc, int fr, int fq) const {
        const int row0 = u.pm * BM + wr * 64 + fr, col0 = u.pn * BM + wc * 32 + 8 * fq;
#pragma unroll
        for (int ai = 0; ai < 2; ++ai)
#pragma unroll
            for (int m = 0; m < 4; ++m) { const size_t off = (size_t)(row0 + ai * HALF + m * 16) * 1024 + col0;
#pragma unroll
                for (int bj = 0; bj < 2; ++bj) { const size_t o2 = off + bj * HALF; const u32x4 xw = *(const u32x4*)(xb + o2);
                    *(f32x4*)(out + o2) = (f32x4){bflo(xw.x), bfhi(xw.x), bflo(xw.y), bfhi(xw.y)} + acc[ai][bj][m][0];
                    *(f32x4*)(out + o2 + 4) = (f32x4){bflo(xw.z), bfhi(xw.z), bflo(xw.w), bfhi(xw.w)} + acc[ai][bj][m][1]; } }
    }
};

template <class Epi, class Sched, bool ALIGN_EPI = false, bool SP2 = false, bool DUAL = false, bool SPLIT_EPI = false>
__device__ __forceinline__ void gemm_phase(PG8_LAS unsigned char* lds, const Gemm g, const Sched& S, const Epi& E) {
    const int tid = threadIdx.x, wid = __builtin_amdgcn_readfirstlane(tid >> 6), lane = tid & 63, wr = wid >> 2, wc = wid & 3, fr = lane & 15, fq = lane >> 4;
    const int K = g.K, TS = K / BK, nt = DUAL ? 2 * TS : TS;
    unsigned voffA[2], voffB[2];
#pragma unroll
    for (int i = 0; i < 2; ++i) { int R, C; stage_rc(tid * 16 + i * 8192, R, C); const int Rb = Epi::PERM ? ((R & ~31) + perm32(R & 31)) : R;
        voffA[i] = (unsigned)(R * K + C) * 2u; voffB[i] = (unsigned)(Rb * K + C) * 2u; }
    const size_t kstep = (size_t)(BK * 2);
    const size_t hstep = (size_t)HALF * K * 2;
    const size_t tstep = 2 * hstep;
    const unsigned ldsw = (unsigned)wid * 1024u;
    const int aoff = lds_byte(wr * 64 + fr, fq * 8), boff = lds_byte(wc * 32 + fr, fq * 8);
#define PG8_SA(b, h) (((b) * 2 + (h)) * HTB)
#define PG8_SB(b, h) ((4 + (b) * 2 + (h)) * HTB)
#define PG8_STAGE(bufoff, gbase, voff) do { _Pragma("unroll") for (int _i = 0; _i < 2; ++_i) \
        __builtin_amdgcn_global_load_lds((const unsigned*)((const char*)(gbase) + (voff)[_i]), (PG8_LAS unsigned*)(lds + (bufoff) + ldsw + _i * 8192), 16, 0, 0); } while (0)
#define PG8_LDA(dst, b, h) do { _Pragma("unroll") for (int m = 0; m < 4; ++m) _Pragma("unroll") for (int k = 0; k < 2; ++k) dst[m][k] = *(const PG8_LAS bf16x8*)(lds + PG8_SA(b, h) + aoff + m * 2048 + k * 1024); } while (0)
#define PG8_LDB(dst, b, h) do { _Pragma("unroll") for (int n = 0; n < 2; ++n) _Pragma("unroll") for (int k = 0; k < 2; ++k) dst[n][k] = *(const PG8_LAS bf16x8*)(lds + PG8_SB(b, h) + boff + n * 2048 + k * 1024); } while (0)
#define PG8_MMA(ai, bj, At, Bt) do { __builtin_amdgcn_s_setprio(1); _Pragma("unroll") for (int m = 0; m < 4; ++m) _Pragma("unroll") for (int n = 0; n < 2; ++n) _Pragma("unroll") for (int k = 0; k < 2; ++k) \
        acc[ai][bj][m][n] = __builtin_amdgcn_mfma_f32_16x16x32_bf16(Bt[n][k], At[m][k], acc[ai][bj][m][n], 0, 0, 0); __builtin_amdgcn_s_setprio(0); } while (0)
#define PG8_WAIT_V(n) asm volatile("s_waitcnt vmcnt(" #n ")" ::: "memory")
#define PG8_WAIT_L(n) asm volatile("s_waitcnt lgkmcnt(" #n ")" ::: "memory")
#define PG8_BAR __builtin_amdgcn_s_barrier()
#define PG8_SCHED __builtin_amdgcn_sched_barrier(0)
    Unit cur, nxt, prev; int ui = 0; bool have_prev = false; (void)prev; (void)have_prev;
    static_assert(!SPLIT_EPI || (SP2 && !ALIGN_EPI && !DUAL && !Epi::AFTER_DRAIN), "SPLIT_EPI geometry");
    if (!S.next(0, cur)) return;
    f32x4 acc[2][2][4][2];
#pragma unroll
    for (int a = 0; a < 2; ++a)
#pragma unroll
        for (int b = 0; b < 2; ++b)
#pragma unroll
            for (int m = 0; m < 4; ++m)
#pragma unroll
                for (int n = 0; n < 2; ++n) acc[a][b][m][n] = (f32x4){0.f, 0.f, 0.f, 0.f};
    bf16x8 At[4][2], B0[2][2], B1[2][2];
    const char* cA = (const char*)g.A + (size_t)cur.pm * tstep; const char* cB = (const char*)g.Bt + (size_t)cur.pn * tstep;
    const char* cA2 = DUAL ? (const char*)g.A2 + (size_t)cur.pm * tstep - (size_t)TS * kstep : cA; const char* cB2 = DUAL ? (const char*)g.Bt2 + (size_t)cur.pn * tstep - (size_t)TS * kstep : cB;
    S.a_ready(cur);
    if constexpr (SP2) {
        PG8_STAGE(PG8_SB(0, 0), cB, voffB); PG8_STAGE(PG8_SB(0, 1), cB + hstep, voffB); PG8_STAGE(PG8_SA(0, 0), cA, voffA); PG8_STAGE(PG8_SA(0, 1), cA + hstep, voffA);
        if (wr == 1) PG8_BAR;
        PG8_WAIT_V(2); PG8_BAR;
        PG8_STAGE(PG8_SB(1, 0), cB + kstep, voffB); PG8_STAGE(PG8_SA(1, 0), cA + kstep, voffA); PG8_STAGE(PG8_SB(1, 1), cB + hstep + kstep, voffB);
        PG8_WAIT_V(6); PG8_BAR;
    } else {
        PG8_STAGE(PG8_SB(0, 0), cB, voffB); PG8_STAGE(PG8_SA(0, 0), cA, voffA); PG8_STAGE(PG8_SB(0, 1), cB + hstep, voffB); PG8_STAGE(PG8_SA(0, 1), cA + hstep, voffA);
        if (wr == 1) PG8_BAR;
        PG8_WAIT_V(4); PG8_BAR;
        PG8_STAGE(PG8_SB(1, 0), cB + kstep, voffB); PG8_STAGE(PG8_SA(1, 0), cA + kstep, voffA); PG8_STAGE(PG8_SB(1, 1), cB + hstep + kstep, voffB);
        PG8_WAIT_V(6); PG8_BAR;
    }
    for (;;) {
        const bool has_next = S.next(ui + 1, nxt);
        const char* nA = has_next ? (const char*)g.A + (size_t)nxt.pm * tstep : cA; const char* nB = has_next ? (const char*)g.Bt + (size_t)nxt.pn * tstep : cB;
        const char* nA2 = (DUAL && has_next) ? (const char*)g.A2 + (size_t)nxt.pm * tstep - (size_t)TS * kstep : cA2; const char* nB2 = (DUAL && has_next) ? (const char*)g.Bt2 + (size_t)nxt.pn * tstep - (size_t)TS * kstep : cB2;
#pragma unroll
        for (int seg = 0; seg < (DUAL ? 2 : 1); ++seg) {
        if constexpr (DUAL) { if (seg == 1) E.mid(acc, cur, wr, wc, fr, fq); }
        for (int t = (seg ? TS : 0); t < ((DUAL && seg == 0) ? TS : nt); t += 2) {
            const bool last = (t == nt - 2);
            const char* a1 = ((DUAL && t + 1 >= TS) ? cA2 : cA) + (size_t)(t + 1) * kstep;
            const char* a2 = last ? nA : ((DUAL && t + 2 >= TS) ? cA2 : cA) + (size_t)(t + 2) * kstep; const char* b2 = last ? nB : ((DUAL && t + 2 >= TS) ? cB2 : cB) + (size_t)(t + 2) * kstep;
            const char* a3 = a2 + kstep; const char* b3 = b2 + kstep;
            if (last && has_next) S.a_ready(nxt);
            if constexpr (SP2) {
            PG8_LDB(B0, 0, 0); PG8_LDB(B1, 0, 1); PG8_SCHED; PG8_LDA(At, 0, 0); PG8_STAGE(PG8_SA(1, 1), a1 + hstep, voffA);
            PG8_WAIT_V(8); PG8_WAIT_L(0); PG8_BAR;
            if constexpr (SPLIT_EPI) { if (t == 0 && have_prev) { E.part(acc, prev, wr, wc, fr, fq, 1);
                _Pragma("unroll") for (int b_ = 0; b_ < 2; ++b_) _Pragma("unroll") for (int m_ = 0; m_ < 4; ++m_) _Pragma("unroll") for (int n_ = 0; n_ < 2; ++n_) acc[1][b_][m_][n_] = (f32x4){0.f, 0.f, 0.f, 0.f}; } }
            PG8_MMA(0, 0, At, B0); PG8_MMA(0, 1, At, B1); PG8_BAR; PG8_SCHED;
            PG8_LDA(At, 0, 1); PG8_STAGE(PG8_SB(0, 0), b2, voffB); PG8_STAGE(PG8_SB(0, 1), b2 + hstep, voffB); PG8_STAGE(PG8_SA(0, 0), a2, voffA);
            PG8_WAIT_V(8); PG8_WAIT_L(0); PG8_BAR; PG8_MMA(1, 0, At, B0); PG8_MMA(1, 1, At, B1); PG8_BAR; PG8_SCHED;
            PG8_LDB(B0, 1, 0); PG8_LDB(B1, 1, 1); PG8_SCHED; PG8_LDA(At, 1, 0); PG8_STAGE(PG8_SA(0, 1), a2 + hstep, voffA);
            PG8_WAIT_V(8); PG8_WAIT_L(0); PG8_BAR; PG8_MMA(0, 0, At, B0); PG8_MMA(0, 1, At, B1); PG8_BAR; PG8_SCHED;
            PG8_LDA(At, 1, 1); PG8_STAGE(PG8_SB(1, 0), b3, voffB); PG8_STAGE(PG8_SB(1, 1), b3 + hstep, voffB); PG8_STAGE(PG8_SA(1, 0), a3, voffA);
            PG8_WAIT_V(8); PG8_WAIT_L(0); PG8_BAR;
            if constexpr (SPLIT_EPI) { if (last) { E.part(acc, cur, wr, wc, fr, fq, 0);
                _Pragma("unroll") for (int b_ = 0; b_ < 2; ++b_) _Pragma("unroll") for (int m_ = 0; m_ < 4; ++m_) _Pragma("unroll") for (int n_ = 0; n_ < 2; ++n_) acc[0][b_][m_][n_] = (f32x4){0.f, 0.f, 0.f, 0.f}; } }
            PG8_MMA(1, 0, At, B0); PG8_MMA(1, 1, At, B1); PG8_BAR; PG8_SCHED;
            } else {
            PG8_LDB(B0, 0, 0); PG8_SCHED; PG8_LDA(At, 0, 0); PG8_STAGE(PG8_SA(1, 1), a1 + hstep, voffA);
            PG8_WAIT_L(8); PG8_BAR; PG8_WAIT_L(0); PG8_MMA(0, 0, At, B0); PG8_BAR; PG8_SCHED;
            PG8_LDB(B1, 0, 1); PG8_STAGE(PG8_SB(0, 0), b2, voffB);
            PG8_BAR; PG8_WAIT_L(0); PG8_MMA(0, 1, At, B1); PG8_BAR;
            PG8_LDA(At, 0, 1); PG8_STAGE(PG8_SA(0, 0), a2, voffA);
            PG8_BAR; PG8_WAIT_L(0); PG8_MMA(1, 0, At, B0); PG8_BAR; PG8_SCHED;
            PG8_STAGE(PG8_SB(0, 1), b2 + hstep, voffB);
            PG8_WAIT_V(6); PG8_BAR; PG8_MMA(1, 1, At, B1); PG8_BAR;
            PG8_LDB(B0, 1, 0); PG8_SCHED; PG8_LDA(At, 1, 0); PG8_STAGE(PG8_SA(0, 1), a2 + hstep, voffA);
            PG8_WAIT_L(8); PG8_BAR; PG8_WAIT_L(0); PG8_MMA(0, 0, At, B0); PG8_BAR; PG8_SCHED;
            PG8_LDB(B1, 1, 1); PG8_STAGE(PG8_SB(1, 0), b3, voffB);
            PG8_BAR; PG8_WAIT_L(0); PG8_MMA(0, 1, At, B1); PG8_BAR;
            PG8_LDA(At, 1, 1); PG8_STAGE(PG8_SA(1, 0), a3, voffA);
            PG8_BAR; PG8_WAIT_L(0); PG8_MMA(1, 0, At, B0); PG8_BAR; PG8_SCHED;
            PG8_STAGE(PG8_SB(1, 1), b3 + hstep, voffB);
            PG8_WAIT_V(6); PG8_BAR; PG8_MMA(1, 1, At, B1); PG8_BAR;
            }
        }
        }
        if constexpr (SPLIT_EPI) { prev = cur; have_prev = true; if (!has_next) break; cur = nxt; cA = nA; cB = nB; cA2 = nA2; cB2 = nB2; ++ui; continue; }
        if constexpr (ALIGN_EPI) { if (wr == 0) PG8_BAR; }
        if constexpr (!Epi::AFTER_DRAIN) { E(acc, cur, wr, wc, fr, fq); S.done(cur); }
        if constexpr (ALIGN_EPI && epi_has_post<Epi>::v) {
            if (E.need_post(cur)) { PG8_WAIT_V(0); PG8_WAIT_L(0); PG8_BAR; asm volatile("" ::: "memory"); E.post(cur, tid); } }
        if (!has_next) break;
#pragma unroll
        for (int a = 0; a < 2; ++a)
#pragma unroll
            for (int b = 0; b < 2; ++b)
#pragma unroll
                for (int m = 0; m < 4; ++m)
#pragma unroll
                    for (int n = 0; n < 2; ++n) acc[a][b][m][n] = (f32x4){0.f, 0.f, 0.f, 0.f};
        cur = nxt; cA = nA; cB = nB; cA2 = nA2; cB2 = nB2; ++ui;
        if constexpr (ALIGN_EPI) { if (wr == 1) PG8_BAR; }
    }
    PG8_WAIT_V(0);
    if constexpr (!ALIGN_EPI) { if (wr == 0) PG8_BAR; }
    PG8_BAR;
    if constexpr (Epi::AFTER_DRAIN) { E.fused(acc, cur, wr, wc, fr, fq, lds, wid, lane); S.done(cur); }
    if constexpr (SPLIT_EPI) { if (have_prev) E.part(acc, prev, wr, wc, fr, fq, 1); }
#undef PG8_SA
#undef PG8_SB
#undef PG8_STAGE
#undef PG8_LDA
#undef PG8_LDB
#undef PG8_MMA
#undef PG8_WAIT_V
#undef PG8_WAIT_L
#undef PG8_BAR
#undef PG8_SCHED
}
}
#define GAS __attribute__((address_space(1)))
#define LAS __attribute__((address_space(3)))
typedef unsigned short bf16;
typedef unsigned v4u __attribute__((ext_vector_type(4)));
typedef float f32x4 __attribute__((ext_vector_type(4)));
typedef short bf16x8 __attribute__((ext_vector_type(8)));
typedef GAS unsigned gu32;
typedef GAS unsigned long long gu64;
#define RLX_AGENT __ATOMIC_RELAXED, __HIP_MEMORY_SCOPE_AGENT
#define LDS_WAIT() asm volatile("s_waitcnt lgkmcnt(0)" ::: "memory")
#define VM_WAIT() asm volatile("s_waitcnt vmcnt(0)" ::: "memory")
__device__ __forceinline__ unsigned long long rt() { return __builtin_amdgcn_s_memrealtime(); }
__device__ __forceinline__ unsigned f2bf(float f) { unsigned u = __builtin_bit_cast(unsigned, f); return (u + 0x7fffu + ((u >> 16) & 1u)) >> 16; }
__device__ __forceinline__ unsigned pk2(float lo, float hi) { return f2bf(lo) | (f2bf(hi) << 16); }
constexpr int NWAVES = 8;
#ifndef GLA_MFMA
#define GLA_MFMA 1
#endif
#ifndef SWA_MFMA
#define SWA_MFMA 1
#endif
constexpr int BATCH = 8, SEQ = 4096, DM = 1024, M = BATCH * SEQ;
constexpr int NPROJ = 6656;
constexpr int DFF = 2816;
constexpr float EPS = 1e-6f;
constexpr size_t MiB = 1u << 20;
constexpr size_t WS_CTL = 0, CTL_ZERO_BYTES = 1 * MiB;
constexpr size_t WS_WIN = 1 * MiB;
constexpr size_t WS_WLR = 14 * MiB;
constexpr size_t WS_WG = 15 * MiB, WS_WS = 17 * MiB, WS_WOUT = 19 * MiB;
constexpr size_t WS_WFI = 21 * MiB;
constexpr size_t WS_WFO = 32 * MiB;
constexpr size_t WS_ROPE = 38 * MiB;
constexpr size_t WS_LR = 40 * MiB;
constexpr size_t WS_SSQ = 44 * MiB;
constexpr size_t WS_QG = 48 * MiB, WS_KG = 80 * MiB;
constexpr size_t WS_VG = 112 * MiB, WS_R = 176 * MiB, WS_SQ = 240 * MiB;
constexpr size_t WS_SK = 304 * MiB, WS_SV = 320 * MiB;
constexpr size_t WS_GA = 336 * MiB, WS_GB = 400 * MiB;
constexpr size_t WS_END = 464 * MiB;
constexpr size_t WS_DUMMY = 500 * MiB;
constexpr size_t WS_MERGED = WS_VG;
constexpr size_t WS_X1B = WS_QG;
constexpr size_t WS_H = WS_SQ;
static_assert(WS_H + (size_t)M * DFF * 2 <= WS_END, "h overlay");
constexpr int CW_TMO = 0, CW_CODE = 1;
constexpr int CW_BAR = 4096;
constexpr int RING_OFF = 0, RING_BYTES = 131072;
constexpr int LDS_BYTES = 163840;
constexpr int LDSCTL_OFF = LDS_BYTES - 1024, MISC_OFF = LDSCTL_OFF + 320;
static_assert(MISC_OFF + 128 <= LDS_BYTES, "LDS map");

#define XB_TMO      128
#define XB_XCNT(j)  (256  + 64 * (j))
#define XB_XSUB(j)  (1280 + 64 * (j))
#define XB_XGEN(j)  (2304 + 64 * (j))
#define XB_TOP      3328
#define XB_TOPGEN   3392
#define XCD_BAR_WORDS 3456
#define XB_SPIN_CAP (1u << 18)

__device__ __forceinline__ unsigned xb_ld(unsigned* p)              { return __hip_atomic_load(p, __ATOMIC_RELAXED, __HIP_MEMORY_SCOPE_AGENT); }
__device__ __forceinline__ unsigned xb_add(unsigned* p, unsigned v) { return __hip_atomic_fetch_add(p, v, __ATOMIC_RELAXED, __HIP_MEMORY_SCOPE_AGENT); }
__device__ __forceinline__ unsigned xb_xcc_id() { return (unsigned)__builtin_amdgcn_s_getreg((3 << 11) | 20) & 0xFu; }
#define XB_SPIN(cond, bar) do { unsigned _sp = 0; while (cond) { __builtin_amdgcn_s_sleep(1); \
    if ((++_sp & 255u) == 0u) { if (xb_ld(&(bar)[XB_TMO])) break; if (_sp > XB_SPIN_CAP) { atomicAdd(&(bar)[XB_TMO], 1u); break; } } } } while (0)

struct XcdBarrier {
    unsigned* bar; unsigned x;
    volatile LAS unsigned* st;
};

__device__ __forceinline__ XcdBarrier xcd_barrier_post(unsigned* bar, volatile LAS unsigned* st) {
    XcdBarrier b; b.bar = bar; b.x = xb_xcc_id(); b.st = st;
    if (threadIdx.x == 0) (void)xb_add(&bar[XB_XCNT(b.x)], 1u);
    return b;
}
__device__ __forceinline__ void xcd_barrier_complete(unsigned* bar, unsigned x, unsigned& nloc, unsigned& nx) {
    const unsigned G = gridDim.x * gridDim.y * gridDim.z;
    unsigned sum, cnt, mine, sp = 0u;
    for (;;) {
        sum = 0u; cnt = 0u; mine = 0u;
#pragma unroll
        for (unsigned j = 0; j < 16; ++j) { const unsigned c = xb_ld(&bar[XB_XCNT(j)]); sum += c; cnt += (c > 0u) ? 1u : 0u; mine = (j == x) ? c : mine; }
        if (sum == G) break;
        __builtin_amdgcn_s_sleep(1);
        if ((++sp & 255u) == 0u) { if (xb_ld(&bar[XB_TMO])) break; if (sp > XB_SPIN_CAP) { atomicAdd(&bar[XB_TMO], 1u); break; } }
    }
    nloc = mine > 0u ? mine : 1u; nx = cnt > 0u ? cnt : 1u;
}

__device__ __forceinline__ void xcd_barrier(const XcdBarrier& b) {
    asm volatile("s_waitcnt vmcnt(0)" ::: "memory");
    __syncthreads();
    if (threadIdx.x == 0) {
        unsigned* bar = b.bar;
        __builtin_amdgcn_s_waitcnt(0);
        unsigned nloc = b.st[0], nx = b.st[1];
        if (nloc == 0u) { xcd_barrier_complete(bar, b.x, nloc, nx); b.st[0] = nloc; b.st[1] = nx; }
        const unsigned old = xb_add(&bar[XB_XSUB(b.x)], 1u);
        const unsigned gen = old / nloc;
        if (old + 1u == (gen + 1u) * nloc) {
            __builtin_amdgcn_fence(__ATOMIC_RELEASE, "agent");
            asm volatile("s_waitcnt vmcnt(0)" ::: "memory");
            const unsigned og = xb_add(&bar[XB_TOP], 1u);
            const unsigned tg = og / nx;
            if (og + 1u == (tg + 1u) * nx) xb_add(&bar[XB_TOPGEN], 1u);
            else XB_SPIN(xb_ld(&bar[XB_TOPGEN]) == tg, bar);
            __builtin_amdgcn_fence(__ATOMIC_ACQUIRE, "agent");
            xb_add(&bar[XB_XGEN(b.x)], 1u);
            asm volatile("s_waitcnt vmcnt(0)" ::: "memory");
        } else {
            XB_SPIN(xb_ld(&bar[XB_XGEN(b.x)]) == gen, bar);
            __builtin_amdgcn_fence(__ATOMIC_ACQUIRE, "agent");
            asm volatile("s_waitcnt vmcnt(0)" ::: "memory");
        }
    }
    __syncthreads();
}

typedef unsigned u32x2 __attribute__((ext_vector_type(2)));
__device__ __forceinline__ const float* inp(int i) { const float* const* ka = (const float* const*)__builtin_amdgcn_kernarg_segment_ptr(); asm volatile("" : "+s"(ka)); return ka[i]; }
enum { I_X = 0, I_GMIX, I_WIN, I_UPF, I_BIASF, I_UPB, I_BIASB, I_GGLA, I_WOG, I_GQ, I_GK, I_SINKS, I_WOS, I_WOUT, I_GFFN, I_WFI, I_WFO };
struct Frame {
    LAS unsigned char* lds;
    volatile LAS unsigned* MISC;
    gu32* ctl;
    unsigned char* ws; float* out;
    int tid, lane, wave;
    int vcu, G;
#define WSPTR(name, T, off) __device__ __forceinline__ T* name() const { return (T*)(ws + (off)); }
    WSPTR(WIN, bf16, WS_WIN) WSPTR(WLR, bf16, WS_WLR) WSPTR(WG, bf16, WS_WG) WSPTR(WS_, bf16, WS_WS) WSPTR(WOUT, bf16, WS_WOUT) WSPTR(WFI, bf16, WS_WFI) WSPTR(WFO, bf16, WS_WFO)
    WSPTR(ROPE, float, WS_ROPE) WSPTR(LR, float, WS_LR) WSPTR(SSQ, float, WS_SSQ)
    WSPTR(QG, bf16, WS_QG) WSPTR(KG, bf16, WS_KG) WSPTR(VG, bf16, WS_VG) WSPTR(R, bf16, WS_R) WSPTR(SQ, bf16, WS_SQ) WSPTR(SK, bf16, WS_SK) WSPTR(SV, bf16, WS_SV)
    WSPTR(GA, bf16, WS_GA) WSPTR(GB, bf16, WS_GB) WSPTR(MERGED, bf16, WS_MERGED) WSPTR(X1B, bf16, WS_X1B) WSPTR(H, bf16, WS_H)
#undef WSPTR
    __device__ __forceinline__ bf16* XN() const { return (bf16*)out; }
    __device__ __forceinline__ bf16* OF() const { return (bf16*)out; }
    __device__ __forceinline__ bf16* OB() const { return (bf16*)out + (size_t)M * DM; }
};
__device__ __forceinline__ float wave_sum(float v) {
#pragma unroll
    for (int o = 1; o < 64; o <<= 1) v += __shfl_xor(v, o);
    return v;
}
__device__ __forceinline__ float wave_max(float v) {
#pragma unroll
    for (int o = 1; o < 64; o <<= 1) v = fmaxf(v, __shfl_xor(v, o));
    return v;
}
__device__ __forceinline__ float bflo(unsigned w) { return __uint_as_float(w << 16); }
__device__ __forceinline__ float bfhi(unsigned w) { return __uint_as_float(w & 0xffff0000u); }
__device__ __forceinline__ float bf1(bf16 b) { return __uint_as_float((unsigned)b << 16); }

__device__ __forceinline__ void p0_item(const float* W, int ldw, int K, int scol0, bf16* WT, int drow0, int k0, const float* gain, LAS float* scr, int lane) {
    float wv[32];
#pragma unroll
    for (int i = 0; i < 32; ++i) wv[i] = W[(size_t)(k0 + 2 * i + (lane >> 5)) * ldw + scol0 + (lane & 31)];
#pragma unroll
    for (int i = 0; i < 32; ++i) { const int kk = 2 * i + (lane >> 5); float v = wv[i]; if (gain) v *= gain[k0 + kk]; scr[kk * 33 + (lane & 31)] = v; }
    LDS_WAIT(); asm volatile("" ::: "memory");
    const int c = lane & 7;
#pragma unroll
    for (int j = 0; j < 4; ++j) { const int n = (lane >> 3) + 8 * j; const LAS float* s = scr + (8 * c) * 33 + n;
        v4u o; o.x = pk2(s[0 * 33], s[1 * 33]); o.y = pk2(s[2 * 33], s[3 * 33]); o.z = pk2(s[4 * 33], s[5 * 33]); o.w = pk2(s[6 * 33], s[7 * 33]);
        *(GAS v4u*)(WT + (size_t)(drow0 + n) * K + k0 + 8 * c) = o; }
    LDS_WAIT(); asm volatile("" ::: "memory");
}
__device__ __forceinline__ void sincos_d(double a, float& c, float& s) {
    const double n = __builtin_rint(a * 0.6366197723675814);
    double r = __builtin_fma(-n, 1.5707963267948966, a); r = __builtin_fma(-n, 6.123233995736766e-17, r);
    const double r2 = r * r;
    double sp = -1.0 / 1307674368000.0;
    sp = sp * r2 + 1.0 / 6227020800.0; sp = sp * r2 - 1.0 / 39916800.0; sp = sp * r2 + 1.0 / 362880.0; sp = sp * r2 - 1.0 / 5040.0; sp = sp * r2 + 1.0 / 120.0; sp = sp * r2 - 1.0 / 6.0; sp = sp * r2 * r + r;
    double cp = 1.0 / 20922789888000.0;
    cp = cp * r2 - 1.0 / 87178291200.0; cp = cp * r2 + 1.0 / 479001600.0; cp = cp * r2 - 1.0 / 3628800.0; cp = cp * r2 + 1.0 / 40320.0; cp = cp * r2 - 1.0 / 720.0; cp = cp * r2 + 1.0 / 24.0; cp = cp * r2 - 0.5; cp = cp * r2 + 1.0;
    const int q = (int)n & 3;
    const double sv = (q == 0) ? sp : (q == 1) ? cp : (q == 2) ? -sp : -cp;
    const double cv = (q == 0) ? cp : (q == 1) ? -sp : (q == 2) ? -cp : sp;
    c = (float)cv; s = (float)sv;
}
__device__ __forceinline__ void p0_prologue(Frame& F) {
    LAS float* scr = (LAS float*)(F.lds + RING_OFF + F.wave * 8448);
    LAS unsigned char* wlr = F.lds + RING_OFF + 8 * 8448;
    const int gw = F.vcu * NWAVES + F.wave, NGW = F.G * NWAVES;
    {
        const float* wsrc = inp(I_WIN) + (size_t)(2 * F.tid) * 6688 + 3072;
        f32x4 w0[8], w1[8];
#pragma unroll
        for (int j = 0; j < 8; ++j) { w0[j] = *(const f32x4*)(wsrc + 4 * j); w1[j] = *(const f32x4*)(wsrc + 6688 + 4 * j); }
#pragma unroll
        for (int n = 0; n < 32; ++n) { const int fF = ((n & 3) << 2) | ((n >> 2) & 3);
            *(LAS unsigned*)(wlr + 2048 * n + 16 * ((F.tid >> 2) ^ fF) + 4 * (F.tid & 3)) = pk2(w0[n >> 2][n & 3], w1[n >> 2][n & 3]); }
        __syncthreads();
    }
    constexpr int I_IN = 16 * 208, I_LR = 16, I_SQ = 16 * 32, I_FI = 16 * 176, I_FO = 44 * 32;
    constexpr int NITEMS = I_IN + I_LR + 3 * I_SQ + I_FI + I_FO;
    for (int it = gw; it < NITEMS; it += NGW) {
        int r = it;
        if (r < I_IN) { const int kb = r / 208, nb = r % 208, dn0 = 32 * nb, sc0 = dn0 + (dn0 >= 3072 ? 32 : 0); p0_item(inp(I_WIN), 6688, 1024, sc0, F.WIN(), dn0, 64 * kb, nullptr, scr, F.lane); continue; } r -= I_IN;
        if (r < I_LR) { p0_item(inp(I_WIN), 6688, 1024, 3072, F.WLR(), 0, 64 * r, nullptr, scr, F.lane); continue; } r -= I_LR;
        if (r < I_SQ) { p0_item(inp(I_WOG), 1024, 1024, 32 * (r % 32), F.WG(), 32 * (r % 32), 64 * (r / 32), nullptr, scr, F.lane); continue; } r -= I_SQ;
        if (r < I_SQ) { p0_item(inp(I_WOS), 1024, 1024, 32 * (r % 32), F.WS_(), 32 * (r % 32), 64 * (r / 32), nullptr, scr, F.lane); continue; } r -= I_SQ;
        if (r < I_SQ) { p0_item(inp(I_WOUT), 1024, 1024, 32 * (r % 32), F.WOUT(), 32 * (r % 32), 64 * (r / 32), nullptr, scr, F.lane); continue; } r -= I_SQ;
        if (r < I_FI) { const int kb = r / 176, nb = r % 176, dn0 = 32 * nb, tj = dn0 >> 8, wi = dn0 & 255, sc0 = (wi < 128) ? (128 * tj + wi) : (DFF + 128 * tj + (wi - 128));
            p0_item(inp(I_WFI), 2 * DFF, 1024, sc0, F.WFI(), dn0, 64 * kb, inp(I_GFFN), scr, F.lane); continue; } r -= I_FI;
        p0_item(inp(I_WFO), 1024, DFF, 32 * (r % 32), F.WFO(), 32 * (r % 32), 64 * (r / 32), nullptr, scr, F.lane);
    }
    {
        const float* xin = inp(I_X); const float* gmix = inp(I_GMIX); bf16* XNp = F.XN(); bf16* LRp = (bf16*)F.LR();
        f32x4 gm[4];
#pragma unroll
        for (int j = 0; j < 4; ++j) gm[j] = *((const f32x4*)gmix + F.lane + 64 * j);
        for (int g = gw; g < M / 16; g += NGW) {
            for (int it = 0; it < 4; ++it) {
                const int m0 = 16 * g + 4 * it;
                f32x4 v[4][4];
#pragma unroll
                for (int u = 0; u < 4; ++u) { const GAS f32x4* xr = (const GAS f32x4*)(xin + (size_t)(m0 + u) * DM) + F.lane;
#pragma unroll
                    for (int j = 0; j < 4; ++j) v[u][j] = xr[64 * j]; }
#pragma unroll
                for (int u = 0; u < 4; ++u) { float s = 0.f;
#pragma unroll
                    for (int j = 0; j < 4; ++j) s += (v[u][j].x * v[u][j].x + v[u][j].y * v[u][j].y) + (v[u][j].z * v[u][j].z + v[u][j].w * v[u][j].w);
                    const float rstd = 1.0f / sqrtf(wave_sum(s) * (1.f / DM) + EPS);
                    GAS unsigned long long* o8 = (GAS unsigned long long*)(XNp + (size_t)(m0 + u) * DM) + F.lane;
#pragma unroll
                    for (int j = 0; j < 4; ++j) o8[64 * j] = (unsigned long long)pk2(v[u][j].x * rstd * gm[j].x, v[u][j].y * rstd * gm[j].y) | ((unsigned long long)pk2(v[u][j].z * rstd * gm[j].z, v[u][j].w * rstd * gm[j].w) << 32); }
            }
            asm volatile("s_waitcnt vmcnt(0)" ::: "memory");
            int ln = F.lane; asm volatile("" : "+v"(ln));
            const int fr = ln & 15, fq = ln >> 4, fF = ((fr & 3) << 2) | ((fr >> 2) & 3);
            const bf16* ap = XNp + (size_t)(16 * g + fr) * DM + 8 * fq;
            const unsigned aB = (unsigned)(2048 * fr + 16 * (fq ^ fF));
            f32x4 a0 = {0.f, 0.f, 0.f, 0.f}, a1 = {0.f, 0.f, 0.f, 0.f};
#pragma unroll
            for (int hb = 0; hb < 2; ++hb) {
                bf16x8 af[16];
#pragma unroll
                for (int kk = 0; kk < 16; ++kk) af[kk] = *(const bf16x8*)(ap + 32 * (16 * hb + kk));
#pragma unroll
                for (int kk = 0; kk < 16; ++kk) { const int k2 = 16 * hb + kk;
                    const bf16x8 b0 = *(const LAS bf16x8*)(wlr + (aB ^ ((k2 & 3) << 6)) + 256 * (k2 >> 2)), b1 = *(const LAS bf16x8*)(wlr + (aB ^ ((k2 & 3) << 6)) + 256 * (k2 >> 2) + 32768);
                    a0 = __builtin_amdgcn_mfma_f32_16x16x32_bf16(b0, af[kk], a0, 0, 0, 0); a1 = __builtin_amdgcn_mfma_f32_16x16x32_bf16(b1, af[kk], a1, 0, 0, 0);
                    if ((kk & 3) == 3) __builtin_amdgcn_sched_barrier(0); }
            }
            { u32x2 w0, w1; w0.x = pk2(a0[0], a0[1]); w0.y = pk2(a0[2], a0[3]); w1.x = pk2(a1[0], a1[1]); w1.y = pk2(a1[2], a1[3]);
              bf16* o = LRp + (size_t)(16 * g + fr) * 32 + 4 * fq; *(u32x2*)o = w0; *(u32x2*)(o + 16) = w1; }
        }
    }
    float* ROPEp = F.ROPE();
    for (int idx = (F.vcu * NWAVES + F.wave) * 64 + F.lane; idx < SEQ * 64; idx += NGW * 64) {
        const int i = idx & 63, pos = idx >> 6; double f = 1.0;
        for (int k = 0; k < i; ++k) f *= 0.8659643233600653;
        float c, s; sincos_d((double)pos * f, c, s);
        ROPEp[2 * idx] = c; ROPEp[2 * idx + 1] = s;
    }
}
__device__ __forceinline__ void p1_lr(Frame& F) {
    const int gw = F.vcu * NWAVES + F.wave, NGW = F.G * NWAVES, fr = F.lane & 15, fq = F.lane >> 4;
    const bf16* XNp = F.XN(); const bf16* WLRp = F.WLR(); bf16* LRp = (bf16*)F.LR();
    for (int g = gw; g < M / 16; g += NGW) {
        const bf16* ap = XNp + (size_t)(16 * g + fr) * DM + 8 * fq; const bf16* b0p = WLRp + (size_t)fr * DM + 8 * fq; const bf16* b1p = b0p + 16 * DM;
        f32x4 a0 = {0.f, 0.f, 0.f, 0.f}, a1 = {0.f, 0.f, 0.f, 0.f};
#pragma unroll 4
        for (int kk = 0; kk < 32; ++kk) { const bf16x8 a = *(const bf16x8*)(ap + 32 * kk), b0 = *(const bf16x8*)(b0p + 32 * kk), b1 = *(const bf16x8*)(b1p + 32 * kk);
            a0 = __builtin_amdgcn_mfma_f32_16x16x32_bf16(a, b0, a0, 0, 0, 0); a1 = __builtin_amdgcn_mfma_f32_16x16x32_bf16(a, b1, a1, 0, 0, 0); }
#pragma unroll
        for (int i = 0; i < 4; ++i) { bf16* o = LRp + (size_t)(16 * g + 4 * fq + i) * 32 + fr; o[0] = (bf16)f2bf(a0[i]); o[16] = (bf16)f2bf(a1[i]); }
    }
}
__device__ __forceinline__ void p1b_qknorm_rope(Frame& F, int dummy = 0) {
    const int gw = F.vcu * NWAVES + F.wave, NGW = F.G * NWAVES, lane = F.lane, slot = lane >> 3, c = lane & 7;
    constexpr int NGRP = M * 10 / 8;
    bf16* SQp = F.SQ(); bf16* SKp = F.SK(); const float* ROPEp = F.ROPE(); const float* gqp = inp(I_GQ); const float* gkp = inp(I_GK);
    for (int g0 = gw; g0 < NGRP; g0 += 4 * NGW) {
        v4u a1[4], a2[4]; f32x4 cs[4][4];
#pragma unroll
        for (int u = 0; u < 4; ++u) { const int g = g0 + u * NGW, idx = (g < NGRP ? g : g0) * 8 + slot, row = idx / 10, hh = idx - row * 10, pos = row & (SEQ - 1);
            const bf16* p = (hh < 8) ? SQp + (size_t)row * 1024 + hh * 128 : SKp + (size_t)row * 256 + (hh - 8) * 128;
            a1[u] = *(const v4u*)(p + 8 * c); a2[u] = *(const v4u*)(p + 64 + 8 * c);
            const f32x4* rp = (const f32x4*)(ROPEp + 2 * (pos * 64 + 8 * c));
#pragma unroll
            for (int j = 0; j < 4; ++j) cs[u][j] = rp[j]; }
#pragma unroll
        for (int u = 0; u < 4; ++u) { const int g = g0 + u * NGW, idx = (g < NGRP ? g : g0) * 8 + slot, row = idx / 10, hh = idx - row * 10;
            bf16* p = (hh < 8) ? SQp + (size_t)row * 1024 + hh * 128 : SKp + (size_t)row * 256 + (hh - 8) * 128;
            const float* gn = (hh < 8) ? gqp : gkp; const float sc = (hh < 8) ? (SWA_MFMA ? 0.08838834764831845f * 1.4426950408889634f : 0.08838834764831845f) : 1.f;
            float x1[8], x2[8];
            x1[0] = bflo(a1[u].x); x1[1] = bfhi(a1[u].x); x1[2] = bflo(a1[u].y); x1[3] = bfhi(a1[u].y); x1[4] = bflo(a1[u].z); x1[5] = bfhi(a1[u].z); x1[6] = bflo(a1[u].w); x1[7] = bfhi(a1[u].w);
            x2[0] = bflo(a2[u].x); x2[1] = bfhi(a2[u].x); x2[2] = bflo(a2[u].y); x2[3] = bfhi(a2[u].y); x2[4] = bflo(a2[u].z); x2[5] = bfhi(a2[u].z); x2[6] = bflo(a2[u].w); x2[7] = bfhi(a2[u].w);
            float ss = 0.f;
#pragma unroll
            for (int e = 0; e < 8; ++e) ss += x1[e] * x1[e] + x2[e] * x2[e];
            ss += __shfl_xor(ss, 1); ss += __shfl_xor(ss, 2); ss += __shfl_xor(ss, 4);
            const float rstd = sc / sqrtf(ss * (1.f / 128.f) + EPS);
            const f32x4 g10 = *(const f32x4*)(gn + 8 * c), g11 = *(const f32x4*)(gn + 8 * c + 4), g20 = *(const f32x4*)(gn + 64 + 8 * c), g21 = *(const f32x4*)(gn + 64 + 8 * c + 4);
            float o1[8], o2[8];
#pragma unroll
            for (int e = 0; e < 8; ++e) { const float y1 = x1[e] * rstd * (e < 4 ? g10[e & 3] : g11[e & 3]), y2 = x2[e] * rstd * (e < 4 ? g20[e & 3] : g21[e & 3]);
                const float cc = cs[u][e >> 1][2 * (e & 1)], sn = cs[u][e >> 1][2 * (e & 1) + 1]; o1[e] = y1 * cc - y2 * sn; o2[e] = y2 * cc + y1 * sn; }
            if (g < NGRP) { v4u w1, w2; w1.x = pk2(o1[0], o1[1]); w1.y = pk2(o1[2], o1[3]); w1.z = pk2(o1[4], o1[5]); w1.w = pk2(o1[6], o1[7]); w2.x = pk2(o2[0], o2[1]); w2.y = pk2(o2[2], o2[3]); w2.z = pk2(o2[4], o2[5]); w2.w = pk2(o2[6], o2[7]);
                bf16* po = dummy ? (bf16*)(F.ws + WS_DUMMY) + (size_t)(idx & 8191) * 128 : p; *(v4u*)(po + 8 * c) = w1; *(v4u*)(po + 64 + 8 * c) = w2; } }
    }
}
#if 0
__device__ __forceinline__ float logsig(float z) { return fminf(z, 0.f) - log1pf(expf(-fabsf(z))); }
__device__ __forceinline__ void gla_naive(Frame& F) {
    if (F.vcu >= 64) return;
    const int b = F.vcu >> 3, h = (F.vcu >> 1) & 3, dir = F.vcu & 1;
    LAS float* Gs = (LAS float*)(F.lds + RING_OFF); LAS float* Qs = Gs + 2048; LAS float* Ks = Qs + 2048;
    const float* up = dir ? F.up_b : F.up_f; const float* bias = dir ? F.bias_b : F.bias_f;
    const int tt = F.tid >> 5, d0 = (F.tid & 31) * 4;
    const int col = 32 * F.wave + (F.lane & 31), hf = F.lane >> 5;
    bf16* O = dir ? F.OB : F.OF;
    float S[64];
#pragma unroll
    for (int i = 0; i < 64; ++i) S[i] = 0.f;
    for (int tile = 0; tile < SEQ / 16; ++tile) {
        {
            const int i = tile * 16 + tt, t = dir ? (SEQ - 1 - i) : i; const size_t row = (size_t)b * SEQ + t;
            const f32x4* lrp = (const f32x4*)(F.LR + row * 32 + dir * 16);
            f32x4 z = *(const f32x4*)(bias + h * 128 + d0);
#pragma unroll
            for (int r4 = 0; r4 < 4; ++r4) { const f32x4 l = lrp[r4];
#pragma unroll
                for (int e = 0; e < 4; ++e) { const f32x4 u = *(const f32x4*)(up + (size_t)(4 * r4 + e) * 512 + h * 128 + d0); z += u * l[e]; } }
            f32x4 g;
#pragma unroll
            for (int e = 0; e < 4; ++e) g[e] = expf(fmaxf(logsig(z[e]) * (1.f / 16.f), -0.5f));
            const u32x2 qw = *(const u32x2*)(F.QG + row * 512 + h * 128 + d0), kw = *(const u32x2*)(F.KG + row * 512 + h * 128 + d0);
            *(LAS f32x4*)(Gs + tt * 128 + d0) = g;
            *(LAS f32x4*)(Qs + tt * 128 + d0) = (f32x4){bflo(qw.x), bfhi(qw.x), bflo(qw.y), bfhi(qw.y)};
            *(LAS f32x4*)(Ks + tt * 128 + d0) = (f32x4){bflo(kw.x), bfhi(kw.x), bflo(kw.y), bfhi(kw.y)};
        }
        __syncthreads();
        for (int t2 = 0; t2 < 16; ++t2) {
            const int i = tile * 16 + t2, t = dir ? (SEQ - 1 - i) : i; const size_t row = (size_t)b * SEQ + t;
            const float v = bf1(F.VG[row * 1024 + h * 256 + col]);
            float o = 0.f;
#pragma unroll
            for (int dd = 0; dd < 64; dd += 4) {
                const f32x4 g4 = *(const LAS f32x4*)(Gs + t2 * 128 + 64 * hf + dd), q4 = *(const LAS f32x4*)(Qs + t2 * 128 + 64 * hf + dd), k4 = *(const LAS f32x4*)(Ks + t2 * 128 + 64 * hf + dd);
#pragma unroll
                for (int e = 0; e < 4; ++e) { float s = S[dd + e] * g4[e];
                    if (dir == 0) { s = fmaf(k4[e], v, s); o = fmaf(q4[e], s, o); } else { o = fmaf(q4[e], s, o); s = fmaf(k4[e], v, s); }
                    S[dd + e] = s; }
            }
            o += __shfl_xor(o, 32);
            if (hf == 0) O[row * 1024 + h * 256 + col] = (bf16)f2bf(o);
        }
        __syncthreads();
    }
}
__device__ __forceinline__ void swa_naive(Frame& F) {
    LAS float* qs = (LAS float*)(F.lds + RING_OFF + 32768) + F.wave * 512; LAS float* ps = qs + 128;
    const int gw = F.vcu * NWAVES + F.wave, NGW = F.G * NWAVES, lane = F.lane;
    const int per = (BATCH * 8 * SEQ) / NGW;
    for (int j = 0; j < per; ++j) {
        const int it = gw * per + j, bh = it >> 12, i = it & (SEQ - 1), b = bh >> 3, hd = bh & 7, kvh = hd >> 2;
        const size_t rowb = (size_t)b * SEQ;
        bf16* qp = F.SQ + (rowb + i) * 1024 + hd * 128;
        { const unsigned w = *(const unsigned*)(qp + 2 * lane); qs[2 * lane] = bflo(w); qs[2 * lane + 1] = bfhi(w); }
        LDS_WAIT(); asm volatile("" ::: "memory");
        const int jlo = (i - 128 > 0) ? i - 128 : 0, jhi = (i + 128 < SEQ - 1) ? i + 128 : SEQ - 1;
        float s[5];
#pragma unroll
        for (int c = 0; c < 5; ++c) { const int jj = jlo + lane + 64 * c; const bool valid = jj <= jhi;
            const bf16* kp = F.SK + (rowb + (valid ? jj : jhi)) * 256 + kvh * 128; float a = 0.f;
#pragma unroll 4
            for (int ch = 0; ch < 16; ++ch) { const v4u w = *(const v4u*)(kp + 8 * ch); const f32x4 qa = *(const LAS f32x4*)(qs + 8 * ch), qb = *(const LAS f32x4*)(qs + 8 * ch + 4);
                a += (bflo(w.x) * qa[0] + bfhi(w.x) * qa[1]) + (bflo(w.y) * qa[2] + bfhi(w.y) * qa[3]) + (bflo(w.z) * qb[0] + bfhi(w.z) * qb[1]) + (bflo(w.w) * qb[2] + bfhi(w.w) * qb[3]); }
            s[c] = valid ? a : -INFINITY; }
        const float sink = F.sinks[hd];
        float mx = fmaxf(fmaxf(fmaxf(s[0], s[1]), fmaxf(s[2], s[3])), s[4]); mx = fmaxf(wave_max(mx), sink);
        float sum = 0.f;
#pragma unroll
        for (int c = 0; c < 5; ++c) { const float p = expf(s[c] - mx); ps[lane + 64 * c] = p; sum += p; }
        sum = wave_sum(sum) + expf(sink - mx);
        LDS_WAIT(); asm volatile("" ::: "memory");
        const int n = jhi - jlo + 1; float o0 = 0.f, o1 = 0.f;
        const bf16* vp = F.SV + (rowb + jlo) * 256 + kvh * 128 + 2 * lane;
        for (int jj = 0; jj < n; ++jj) { const float p = ps[jj]; const unsigned w = *(const unsigned*)(vp + (size_t)jj * 256); o0 = fmaf(p, bflo(w), o0); o1 = fmaf(p, bfhi(w), o1); }
        const float inv = 1.0f / sum;
        *(unsigned*)(qp + 2 * lane) = pk2(o0 * inv, o1 * inv);
        asm volatile("" ::: "memory");
    }
}
#endif
__device__ __forceinline__ void p2c_combine(Frame& F, int dummy = 0) {
    const int gw = F.vcu * NWAVES + F.wave, NGW = F.G * NWAVES, lane = F.lane, l32 = lane & 31;
    const float* ggla = inp(I_GGLA); bf16* Rp = F.R();
    const bf16* OFp = F.OF(); const bf16* OBp = F.OB();
    const f32x4 ga = *((const f32x4*)ggla + 2 * l32), gb = *((const f32x4*)ggla + 2 * l32 + 1);
    constexpr int NGRP = M * 4 / 2;
    for (int g0 = gw; g0 < NGRP; g0 += 4 * NGW) {
        v4u a[4], b2[4], r4[4];
#pragma unroll
        for (int u = 0; u < 4; ++u) { const int g = g0 + u * NGW, idx = (g < NGRP ? g : g0) * 2 + (lane >> 5); const size_t so = (size_t)idx * 256 + 8 * l32;
            a[u] = *(const v4u*)(OFp + so); b2[u] = *(const v4u*)(OBp + so); r4[u] = *(const v4u*)(Rp + so); }
#pragma unroll
        for (int u = 0; u < 4; ++u) { const int g = g0 + u * NGW; const size_t off = (size_t)((g < NGRP ? g : g0) * 2 + (lane >> 5)) * 256 + 8 * l32;
            float o[8], r[8];
            o[0] = bflo(a[u].x) + bflo(b2[u].x); o[1] = bfhi(a[u].x) + bfhi(b2[u].x); o[2] = bflo(a[u].y) + bflo(b2[u].y); o[3] = bfhi(a[u].y) + bfhi(b2[u].y);
            o[4] = bflo(a[u].z) + bflo(b2[u].z); o[5] = bfhi(a[u].z) + bfhi(b2[u].z); o[6] = bflo(a[u].w) + bflo(b2[u].w); o[7] = bfhi(a[u].w) + bfhi(b2[u].w);
            r[0] = bflo(r4[u].x); r[1] = bfhi(r4[u].x); r[2] = bflo(r4[u].y); r[3] = bfhi(r4[u].y); r[4] = bflo(r4[u].z); r[5] = bfhi(r4[u].z); r[6] = bflo(r4[u].w); r[7] = bfhi(r4[u].w);
            float ss = 0.f;
#pragma unroll
            for (int e = 0; e < 8; ++e) ss += o[e] * o[e];
            ss += __shfl_xor(ss, 1); ss += __shfl_xor(ss, 2); ss += __shfl_xor(ss, 4); ss += __shfl_xor(ss, 8); ss += __shfl_xor(ss, 16);
            const float rstd = 1.0f / sqrtf(ss * (1.f / 256.f) + EPS);
            float y[8];
#pragma unroll
            for (int e = 0; e < 8; ++e) y[e] = o[e] * rstd * (e < 4 ? ga[e & 3] : gb[e & 3]) * r[e] / (1.f + __expf(-r[e]));
            if (g < NGRP) { v4u w; w.x = pk2(y[0], y[1]); w.y = pk2(y[2], y[3]); w.z = pk2(y[4], y[5]); w.w = pk2(y[6], y[7]); *(v4u*)((dummy ? (bf16*)(F.ws + WS_DUMMY) + (off & 0xfffff) : Rp + off)) = w; } }
    }
}

typedef float f32x16 __attribute__((ext_vector_type(16)));
typedef short s16x4 __attribute__((ext_vector_type(4)));
typedef float f32x2_t __attribute__((ext_vector_type(2))); typedef __bf16 bf16x2_t __attribute__((ext_vector_type(2)));
__device__ __forceinline__ unsigned cvtpk(float lo, float hi) { f32x2_t v = {lo, hi}; bf16x2_t b = __builtin_convertvector(v, bf16x2_t); return __builtin_bit_cast(unsigned, b); }
__device__ __forceinline__ bf16x8 pack_step(const f32x16& x, int s) { v4u p; p.x = cvtpk(x[8 * s], x[8 * s + 1]); p.y = cvtpk(x[8 * s + 2], x[8 * s + 3]); p.z = cvtpk(x[8 * s + 4], x[8 * s + 5]); p.w = cvtpk(x[8 * s + 6], x[8 * s + 7]); return __builtin_bit_cast(bf16x8, p); }
__device__ __forceinline__ int qk_off(int row, int ch) { return 256 * row + 16 * (ch ^ (((row & 3) << 2) | ((row >> 2) & 3))); }
__device__ __forceinline__ int v_off(int tok, int ch) { return 512 * tok + 16 * (ch ^ ((tok & 3) << 2)); }
__device__ __forceinline__ int p_off(int row, int ch) { return 128 * row + 16 * (ch ^ ((row >> 1) & 7)); }
typedef short v4i16_t __attribute__((ext_vector_type(4)));
__device__ __forceinline__ s16x4 tr_rd(LAS const unsigned char* p) { return __builtin_bit_cast(s16x4, __builtin_amdgcn_ds_read_tr16_b64_v4i16((LAS v4i16_t*)p)); }
#define MFMA32(a, b, c) __builtin_amdgcn_mfma_f32_32x32x16_bf16((a), (b), (c), 0, 0, 0)
#define MFMA16(a, b, c) __builtin_amdgcn_mfma_f32_16x16x32_bf16((a), (b), (c), 0, 0, 0)
constexpr int GL_QKSZ = 32768, GL_KI = 16384, GL_V0 = 65536, GL_VSZ = 32768, GL_P = 131072, GL_DEC = 139264;
constexpr int GL_OST = 140800, GL_OSTW = 2560;
constexpr int GLA_LDS_END = GL_OST + 8 * GL_OSTW;
constexpr int GL_DSEG = GLA_LDS_END;
constexpr int GL_NSEG = 4, GL_SEGC = 64 / GL_NSEG;
__device__ __forceinline__ void glds16(const void* gsrc, unsigned lds_dst) { unsigned keep;
    asm volatile("s_mov_b32 %0, m0\n\ts_mov_b32 m0, %2\n\ts_nop 0\n\tglobal_load_lds_dwordx4 %1, off\n\ts_mov_b32 m0, %0" : "=&s"(keep) : "v"(gsrc), "s"(lds_dst) : "memory"); }

__device__ __forceinline__ void ldg8_nc(u32x2& d, const void* p) { asm volatile("global_load_dwordx2 %0, %1, off" : "=v"(d) : "v"(p) : "memory"); }
__device__ __forceinline__ void ldg16_nc(v4u& d, const void* p) { asm volatile("global_load_dwordx4 %0, %1, off" : "=v"(d) : "v"(p) : "memory"); }
__device__ __forceinline__ float* gl_sloc(Frame& F) { return (float*)(F.ws + WS_END); }
__device__ __forceinline__ float* gl_dseg(Frame& F) { return (float*)(F.ws + WS_END + 32 * MiB); }
template <int MODE> __device__ __forceinline__ void gla_mfma(Frame& F, int item, bool dump = (MODE == 0)) {
    const int b = item >> 5, h = (item >> 3) & 3, dir = (item >> 2) & 1, seg = item & 3, n0 = seg * GL_SEGC, n1e = n0 + GL_SEGC;
    if (MODE == 0 && seg == GL_NSEG - 1) return;
    const int w = F.wave;
    LAS unsigned char* L = F.lds + RING_OFF; const unsigned lds0 = (unsigned)(size_t)L;
    bf16* O = dir ? F.OB() : F.OF(); const bf16* VGp = F.VG(); const bf16* QGp = F.QG(); const bf16* KGp = F.KG(); const bf16* LRp = (const bf16*)F.LR();
    const size_t rowb = (size_t)b * SEQ;
    bf16x8 upf; float biasv;
    { const float* up = inp(dir ? I_UPB : I_UPF); const float* bias = inp(dir ? I_BIASB : I_BIASF); const int fr = F.lane & 15, fq = F.lane >> 4;
      v4u t = {0u, 0u, 0u, 0u};
      if (fq < 2) { const float* p = up + (size_t)(8 * fq) * 512 + h * 128 + 16 * w + fr; t.x = cvtpk(p[0], p[512]); t.y = cvtpk(p[1024], p[1536]); t.z = cvtpk(p[2048], p[2560]); t.w = cvtpk(p[3072], p[3584]); }
      upf = __builtin_bit_cast(bf16x8, t); biasv = bias[h * 128 + 16 * w + fr]; }
    f32x16 S[4];
#pragma unroll
    for (int j = 0; j < 4; ++j)
#pragma unroll
        for (int r = 0; r < 16; ++r) S[j][r] = 0.f;
    if (MODE == 1 && seg > 0) {
        if (F.tid < 128 * seg) *(LAS float*)(L + GL_DSEG + 4 * F.tid) = gl_dseg(F)[(size_t)(item - seg + (F.tid >> 7)) * 128 + (F.tid & 127)];
        __syncthreads();
        const int hi_ = F.lane >> 5;
        for (int sp = 0; sp < seg; ++sp) { const float* sl = gl_sloc(F) + ((size_t)((item - seg + sp) * 8 + w) * 64) * 64 + F.lane;
#pragma unroll
            for (int j = 0; j < 4; ++j)
#pragma unroll
                for (int g = 0; g < 4; ++g) { const f32x4 d4 = *(const LAS f32x4*)(L + GL_DSEG + 512 * sp + 4 * (32 * j + 8 * g + 4 * hi_));
#pragma unroll
                    for (int e = 0; e < 4; ++e) S[j][4 * g + e] = S[j][4 * g + e] * d4[e] + sl[(size_t)(j * 16 + 4 * g + e) * 64]; } }
    }
    float dprod = 1.f;

#define GL_ROW(n_, i_) (rowb + (size_t)(dir ? (SEQ - 1 - (64 * (n_) + (i_))) : (64 * (n_) + (i_))))
#define GL_OPAQUE(x) asm volatile("" : "+v"(x))
#define GL_LANE() int ln_ = F.lane; GL_OPAQUE(ln_); const int fr = ln_ & 15, fq = ln_ >> 4, r32 = ln_ & 31, hi = ln_ >> 5; (void)fr; (void)fq; (void)r32; (void)hi
#define GL_LOAD(n1) do { GL_LANE(); \
        _Pragma("unroll") for (int tt = 0; tt < 4; ++tt) { const size_t row_ = GL_ROW(n1, 16 * tt + fr); \
            if (MODE == 1) ldg8_nc(pq[tt], QGp + row_ * 512 + h * 128 + 16 * w + 4 * fq); ldg8_nc(pk[tt], KGp + row_ * 512 + h * 128 + 16 * w + 4 * fq); } \
    } while (0)
#define GL_LOAD_LR(n1) do { GL_LANE(); _Pragma("unroll") for (int tt = 0; tt < 4; ++tt) ldg16_nc(plr[tt], LRp + GL_ROW(n1, 16 * tt + fr) * 32 + dir * 16 + 8 * (fq & 1)); } while (0)
#define GL_WAIT(cnt) asm volatile("s_waitcnt vmcnt(" #cnt ")" : "+v"(plr[0]), "+v"(plr[1]), "+v"(plr[2]), "+v"(plr[3]), "+v"(pk[0]), "+v"(pk[1]), "+v"(pk[2]), "+v"(pk[3]), "+v"(pq[0]), "+v"(pq[1]), "+v"(pq[2]), "+v"(pq[3]) :: "memory")
#define GL_DMA_V(n1, bsel) do { GL_LANE(); _Pragma("unroll") for (int i_ = 0; i_ < 4; ++i_) { const int tok_ = 8 * w + 2 * i_ + hi, ch_ = r32 ^ (((2 * i_ + hi) & 3) << 2); \
        glds16(VGp + GL_ROW(n1, tok_) * 1024 + h * 256 + 8 * ch_, (unsigned)__builtin_amdgcn_readfirstlane((int)(lds0 + GL_V0 + (bsel) * GL_VSZ + 4096 * w + 1024 * i_))); } } while (0)
#define GL_STAGE_A(bsel) do { GL_LANE(); \
        const int fF_ = ((fr & 3) << 2) | ((fr >> 2) & 3); \
        const unsigned aW_ = (unsigned)((fr << 8) | (((2 * w + (fq >> 1)) ^ fF_) << 4) | ((fq & 1) << 3)) + (bsel) * GL_QKSZ; \
        bf16x8 tri0, tri1, ones; \
        _Pragma("unroll") for (int j = 0; j < 8; ++j) { const int tk = 16 * (j >> 2) + 4 * fq + (j & 3); tri0[j] = (tk <= fr) ? (short)0x3F80 : (short)0; tri1[j] = (tk <= 16 + fr) ? (short)0x3F80 : (short)0; ones[j] = (short)0x3F80; } \
        f32x4 zt_[4]; \
        _Pragma("unroll") for (int tt = 0; tt < 4; ++tt) { v4u a_ = plr[tt]; if (fq >= 2) a_ = (v4u){0u, 0u, 0u, 0u}; \
            zt_[tt] = MFMA16(__builtin_bit_cast(bf16x8, a_), upf, ((f32x4){biasv, biasv, biasv, biasv})); } \
        v4u ahi_[2], alo_[2]; \
        _Pragma("unroll") for (int tt = 0; tt < 4; ++tt) { float lg_[4], lo_[4]; unsigned hw_[2]; \
            _Pragma("unroll") for (int r = 0; r < 4; ++r) { const float z_ = zt_[tt][r]; \
                const float ls_ = fminf(z_, 0.f) - 0.6931471805599453f * __builtin_amdgcn_logf(1.0f + __builtin_amdgcn_exp2f(-1.4426950408889634f * fabsf(z_))); \
                lg_[r] = fmaxf(ls_ * 0.0625f, -0.5f); } \
            hw_[0] = cvtpk(lg_[0], lg_[1]); hw_[1] = cvtpk(lg_[2], lg_[3]); \
            lo_[0] = lg_[0] - bflo(hw_[0]); lo_[1] = lg_[1] - bfhi(hw_[0]); lo_[2] = lg_[2] - bflo(hw_[1]); lo_[3] = lg_[3] - bfhi(hw_[1]); \
            const unsigned lw0_ = cvtpk(lo_[0], lo_[1]), lw1_ = cvtpk(lo_[2], lo_[3]); \
            if (tt & 1) { ahi_[tt >> 1].z = hw_[0]; ahi_[tt >> 1].w = hw_[1]; alo_[tt >> 1].z = lw0_; alo_[tt >> 1].w = lw1_; } else { ahi_[tt >> 1].x = hw_[0]; ahi_[tt >> 1].y = hw_[1]; alo_[tt >> 1].x = lw0_; alo_[tt >> 1].y = lw1_; } } \
        const bf16x8 AH0_ = __builtin_bit_cast(bf16x8, ahi_[0]), AL0_ = __builtin_bit_cast(bf16x8, alo_[0]), AH1_ = __builtin_bit_cast(bf16x8, ahi_[1]), AL1_ = __builtin_bit_cast(bf16x8, alo_[1]); \
        const f32x4 z4_ = {0.f, 0.f, 0.f, 0.f}; f32x4 bq_[4]; \
        bq_[0] = MFMA16(AH0_, tri0, z4_); bq_[0] = MFMA16(AL0_, tri0, bq_[0]); \
        bq_[1] = MFMA16(AH0_, tri1, z4_); bq_[1] = MFMA16(AL0_, tri1, bq_[1]); \
        f32x4 tot_ = MFMA16(AH0_, ones, z4_); tot_ = MFMA16(AL0_, ones, tot_); \
        bq_[2] = MFMA16(AH1_, tri0, tot_); bq_[2] = MFMA16(AL1_, tri0, bq_[2]); \
        bq_[3] = MFMA16(AH1_, tri1, tot_); bq_[3] = MFMA16(AL1_, tri1, bq_[3]); \
        if (fr == 15) { f32x4 d_; _Pragma("unroll") for (int r = 0; r < 4; ++r) d_[r] = __builtin_amdgcn_exp2f(1.4426950408889634f * bq_[3][r]); \
            *(LAS f32x4*)(L + GL_DEC + (bsel) * 512 + 4 * (16 * w + 4 * fq)) = d_; } \
        _Pragma("unroll") for (int tq = 0; tq < 4; ++tq) { const u32x2 qw_ = pq[tq], kw_ = pk[tq]; \
            float e_[4], ei_[4]; \
            _Pragma("unroll") for (int r = 0; r < 4; ++r) { const float bl_ = 1.4426950408889634f * bq_[tq][r]; if (MODE == 1) e_[r] = __builtin_amdgcn_exp2f(bl_); ei_[r] = __builtin_amdgcn_exp2f(-bl_); } \
            u32x2 qo_, ko_; if (MODE == 1) { qo_.x = cvtpk(bflo(qw_.x) * e_[0], bfhi(qw_.x) * e_[1]); qo_.y = cvtpk(bflo(qw_.y) * e_[2], bfhi(qw_.y) * e_[3]); } \
            ko_.x = cvtpk(bflo(kw_.x) * ei_[0], bfhi(kw_.x) * ei_[1]); ko_.y = cvtpk(bflo(kw_.y) * ei_[2], bfhi(kw_.y) * ei_[3]); \
            if (MODE == 1) *(LAS u32x2*)(L + aW_ + tq * 4096) = qo_; *(LAS u32x2*)(L + aW_ + GL_KI + tq * 4096) = ko_; } \
    } while (0)

    v4u plr[4]; u32x2 pq[4] = {}, pk[4];
    GL_DMA_V(n0, n0 & 1);
    GL_LOAD(n0); GL_LOAD_LR(n0);
    GL_WAIT(0);
    GL_STAGE_A(n0 & 1);
    GL_LOAD(n0 + 1); GL_LOAD_LR(n0 + 1);
    GL_WAIT(0);
    __syncthreads();
    for (int n = n0; n < n1e; ++n) {
        const int bs = n & 1;
        if (MODE == 1) {
            GL_LANE();
            const int fF = ((fr & 3) << 2) | ((fr >> 2) & 3);
            const unsigned aB = (unsigned)((fr << 8) | ((fq ^ fF) << 4)) + bs * GL_QKSZ;
            const unsigned aPw = (unsigned)((fr << 7) | (((fq >> 1) ^ ((fr >> 1) & 7)) << 4) | ((fq & 1) << 3)) + GL_P;
            const int tq = w & 3;
#pragma unroll
            for (int tkk = 0; tkk < 2; ++tkk) { const int tk = 2 * (w >> 2) + tkk; f32x4 acc = {0.f, 0.f, 0.f, 0.f};
                if (tk <= tq) {
#pragma unroll
                    for (int kk = 0; kk < 4; ++kk) { const bf16x8 a = *(const LAS bf16x8*)(L + (aB ^ (kk << 6)) + GL_KI + tk * 4096), bb = *(const LAS bf16x8*)(L + (aB ^ (kk << 6)) + tq * 4096); acc = MFMA16(a, bb, acc); }
#pragma unroll
                    for (int r = 0; r < 4; ++r) { const int tokk = 16 * tk + 4 * fq + r, tokq = 16 * tq + fr; const bool keep = dir ? (tokk < tokq) : (tokk <= tokq); acc[r] = keep ? acc[r] : 0.f; }
                }
                u32x2 pw; pw.x = cvtpk(acc[0], acc[1]); pw.y = cvtpk(acc[2], acc[3]);
                *(LAS u32x2*)(L + (aPw ^ (tk << 5)) + tq * 2048) = pw; }
        }
        __builtin_amdgcn_sched_barrier(0);
        if (n + 1 < n1e) { if (MODE == 1) GL_WAIT(4); else GL_WAIT(0); GL_STAGE_A(bs ^ 1); }
        __builtin_amdgcn_sched_barrier(0);
        if (MODE == 1) { asm volatile("s_waitcnt vmcnt(4)" ::: "memory"); __syncthreads(); }
        if (n + 1 < n1e) { GL_DMA_V(n + 1, bs ^ 1); }
        if (n + 2 < n1e) { GL_LOAD(n + 2); GL_LOAD_LR(n + 2); }
        if (dump && F.tid < 128) dprod *= *(const LAS float*)(L + GL_DEC + bs * 512 + 4 * F.tid);
        {
            GL_LANE();
            const int i16 = ln_ & 15, q4 = i16 >> 2, p4 = i16 & 3, h16 = (ln_ >> 4) & 1;
            const int fR = ((r32 & 3) << 2) | ((r32 >> 2) & 3);
            const unsigned aV = (unsigned)(((8 * hi + q4) << 9) | (((4 * w + 2 * h16 + (p4 >> 1)) ^ (q4 << 2)) << 4) | ((p4 & 1) << 3)) + GL_V0 + bs * GL_VSZ;
            const unsigned aC = (unsigned)((r32 << 8) | (fR << 4) | (hi << 3)) + bs * GL_QKSZ;
            const unsigned aPr = (unsigned)((r32 << 7) | ((hi ^ ((r32 >> 1) & 7)) << 4)) + GL_P;
            const unsigned aK0 = (unsigned)(((8 * hi + q4) << 8) | ((((2 * h16 + (p4 >> 1)) ^ ((q4 << 2) | ((2 * hi) & 3))) & 15) << 4) | ((p4 & 1) << 3)) + bs * GL_QKSZ + GL_KI;
            const unsigned aK1 = (unsigned)(((8 * hi + q4 + 4) << 8) | ((((2 * h16 + (p4 >> 1)) ^ ((q4 << 2) | ((2 * hi + 1) & 3))) & 15) << 4) | ((p4 & 1) << 3)) + bs * GL_QKSZ + GL_KI;
            const unsigned aD = GL_DEC + bs * 512 + 16 * hi;
            bf16x8 vf[4];
#pragma unroll
            for (int s = 0; s < 4; ++s) { const s16x4 lo = tr_rd(L + aV + s * 8192), hh = tr_rd(L + aV + s * 8192 + 2048);
                vf[s] = (bf16x8){lo[0], lo[1], lo[2], lo[3], hh[0], hh[1], hh[2], hh[3]}; }
#define GL_QDF(f, a) ({ const u32x2 q0_ = *(const LAS u32x2*)(L + (aC ^ ((2 * (f)) << 4)) + (a) * 8192), q1_ = *(const LAS u32x2*)(L + (aC ^ ((2 * (f) + 1) << 4)) + (a) * 8192); (v4u){q0_.x, q0_.y, q1_.x, q1_.y}; })
#define GL_KIF(f) ({ const s16x4 lo_ = tr_rd(L + (aK0 ^ (((f) >> 2) << 6)) + ((f) & 3) * 4096), hh_ = tr_rd(L + (aK1 ^ (((f) >> 2) << 6)) + ((f) & 3) * 4096); (bf16x8){lo_[0], lo_[1], lo_[2], lo_[3], hh_[0], hh_[1], hh_[2], hh_[3]}; })
            if (MODE == 1) {
#pragma unroll
            for (int a = 0; a < 2; ++a) {
                f32x16 oT;
#pragma unroll
                for (int r = 0; r < 16; ++r) oT[r] = 0.f;
                v4u qf[4]; bf16x8 pf[4];
                qf[0] = GL_QDF(0, a); qf[1] = GL_QDF(1, a); qf[2] = GL_QDF(2, a);
                __builtin_amdgcn_sched_barrier(0);
#pragma unroll
                for (int f = 0; f < 8; ++f) {
                    if (f + 3 < 8) qf[(f + 3) & 3] = GL_QDF(f + 3, a);
                    if (f == 6) { pf[0] = *(const LAS bf16x8*)(L + (aPr ^ (0 << 5)) + a * 4096); pf[1] = *(const LAS bf16x8*)(L + (aPr ^ (1 << 5)) + a * 4096); }
                    if (f == 7) { pf[2] = *(const LAS bf16x8*)(L + (aPr ^ (2 << 5)) + a * 4096); pf[3] = *(const LAS bf16x8*)(L + (aPr ^ (3 << 5)) + a * 4096); }
                    oT = MFMA32(pack_step(S[f >> 1], f & 1), __builtin_bit_cast(bf16x8, qf[f & 3]), oT);
                    __builtin_amdgcn_sched_barrier(0); }
#pragma unroll
                for (int s = 0; s < 4; ++s) oT = MFMA32(vf[s], pf[s], oT);
                { const unsigned ost = GL_OST + w * GL_OSTW;
#pragma unroll
                  for (int g = 0; g < 4; ++g) { u32x2 ow; ow.x = cvtpk(oT[4 * g], oT[4 * g + 1]); ow.y = cvtpk(oT[4 * g + 2], oT[4 * g + 3]); *(LAS u32x2*)(L + ost + r32 * 80 + 16 * g + 8 * hi) = ow; }
                  asm volatile("s_waitcnt lgkmcnt(0)" ::: "memory");
#pragma unroll
                  for (int i = 0; i < 2; ++i) { const int tk = (ln_ >> 2) + 16 * i; const v4u ov = *(const LAS v4u*)(L + ost + tk * 80 + 16 * (ln_ & 3));
                      *(v4u*)(O + GL_ROW(n, 32 * a + tk) * 1024 + h * 256 + 32 * w + 8 * (ln_ & 3)) = ov; }
                  asm volatile("s_waitcnt lgkmcnt(0)" ::: "memory"); }
            }
            }
            {
                bf16x8 kf[4]; kf[0] = GL_KIF(0); kf[1] = GL_KIF(1); kf[2] = GL_KIF(2);
                f32x4 d4[4];
                __builtin_amdgcn_sched_barrier(0);
#pragma unroll
                for (int f = 0; f < 16; ++f) {
                    if (f + 3 < 16) kf[(f + 3) & 3] = GL_KIF(f + 3);
                    if ((f & 3) == 1) {
#pragma unroll
                        for (int g = 0; g < 4; ++g) d4[g] = *(const LAS f32x4*)(L + aD + 128 * (f >> 2) + 32 * g); }
                    S[f >> 2] = MFMA32(kf[f & 3], vf[f & 3], S[f >> 2]);
                    if ((f & 3) == 3) { const int j = f >> 2;
#pragma unroll
                        for (int g = 0; g < 4; ++g)
#pragma unroll
                            for (int e = 0; e < 4; ++e) S[j][4 * g + e] *= d4[g][e]; }
                    __builtin_amdgcn_sched_barrier(0);
                }
            }
#undef GL_QDF
#undef GL_KIF
        }
        if (MODE == 0) { if (n + 2 < n1e) asm volatile("s_waitcnt vmcnt(8)" ::: "memory"); else asm volatile("s_waitcnt vmcnt(0)" ::: "memory"); }
        __syncthreads();
    }
    if (dump) {
        float* sl = gl_sloc(F) + ((size_t)(item * 8 + w) * 64) * 64 + F.lane;
#pragma unroll
        for (int j = 0; j < 4; ++j)
#pragma unroll
            for (int r = 0; r < 16; ++r) sl[(size_t)(j * 16 + r) * 64] = S[j][r];
        if (F.tid < 128) gl_dseg(F)[(size_t)item * 128 + F.tid] = dprod; }
#undef GL_STAGE_A
#undef GL_LOAD
#undef GL_LOAD_LR
#undef GL_WAIT
#undef GL_DMA_V
#undef GL_LANE
#undef GL_ROW
#undef GL_OPAQUE
}

constexpr int CW_SWAQ = 64;
constexpr int SWA_ITEMS = BATCH * 2 * 32 * 2;
__device__ __forceinline__ void swa_mfma(Frame& F, int dummy_o = 0, int abl = 0) {
    const int lane = F.lane, w = F.wave, r32 = lane & 31, hi = lane >> 5, tid = F.tid;
    const int g16 = lane >> 4, i16 = lane & 15, q4 = i16 >> 2, p4 = i16 & 3, h16 = g16 & 1;
    LAS unsigned char* L = F.lds + RING_OFF;
    volatile LAS unsigned* qword = F.MISC + 16;
    unsigned step = 0;
    bf16* SQp = F.SQ(); const bf16* SKp = F.SK(); const bf16* SVp = F.SV(); const float* sinksp = inp(I_SINKS);
    bool fastsm;
    { const float* gq = inp(I_GQ); const float* gk = inp(I_GK);
      const float a = wave_max(fmaxf(fabsf(gq[lane]), fabsf(gq[lane + 64]))), b2 = wave_max(fmaxf(fabsf(gk[lane]), fabsf(gk[lane + 64]))), sk = wave_max(lane < 8 ? fabsf(sinksp[lane]) : 0.f);
      fastsm = __builtin_amdgcn_readfirstlane((16.4f * a * b2 + 1.4426950408889634f * sk < 60.f) ? 1 : 0) != 0; }
    if (tid == 0) qword[0] = __hip_atomic_fetch_add(F.ctl + CW_SWAQ, 1u, __ATOMIC_RELAXED, __HIP_MEMORY_SCOPE_AGENT);
    __syncthreads();
    int item = (int)qword[0]; if (item > SWA_ITEMS) item = SWA_ITEMS;
    const int qt = w & 3;
    v4u qv[8], kr[2], vr[2];
#define SW_DECODE(it_, hp_, n_, kvh_, b_) const int hp_ = (it_) & 1, n_ = ((it_) >> 1) & 31, kvh_ = ((it_) >> 6) & 1, b_ = (it_) >> 7
#define SW_LOAD(b_, kvh_, n_, t_) do { const bf16* kg_ = SKp + (size_t)(b_) * SEQ * 256 + (kvh_) * 128; const bf16* vg_ = SVp + (size_t)(b_) * SEQ * 256 + (kvh_) * 128; const int k0_ = 128 * ((n_) - 1) + 64 * (t_); \
        _Pragma("unroll") for (int i_ = 0; i_ < 2; ++i_) { const int c_ = tid + 512 * i_, key_ = c_ >> 4, ch_ = c_ & 15; \
            kr[i_] = *(const v4u*)(kg_ + (size_t)(k0_ + key_) * 256 + 8 * ch_); vr[i_] = *(const v4u*)(vg_ + (size_t)(k0_ + key_) * 256 + 8 * ch_); } } while (0)
#define SW_STORE(bsel) do { _Pragma("unroll") for (int i_ = 0; i_ < 2; ++i_) { const int c_ = tid + 512 * i_, key_ = c_ >> 4, ch_ = c_ & 15; \
            *(LAS v4u*)(L + (bsel) * 32768 + qk_off(key_, ch_)) = kr[i_]; *(LAS v4u*)(L + (bsel) * 32768 + 16384 + qk_off(key_, ch_)) = vr[i_]; } } while (0)
#define SW_PREFETCH(it_) do { SW_DECODE(it_, hp_, n_, kvh_, b_); const bf16* qb_ = SQp + ((size_t)b_ * SEQ + 128 * n_ + 32 * qt) * 1024 + (4 * kvh_ + 2 * hp_ + (w >> 2)) * 128; \
        int ln_ = lane; asm volatile("" : "+v"(ln_));        \
        const unsigned qo_ = (unsigned)((ln_ >> 4) * 2048 + 16 * (ln_ & 15)); \
        _Pragma("unroll") for (int i_ = 0; i_ < 8; ++i_) qv[i_] = (abl & 64) ? (v4u){0u, 0u, 0u, 0u} : *(const v4u*)((const unsigned char*)qb_ + (qo_ + 8192u * i_)); \
        if (!(abl & 8)) SW_LOAD(b_, kvh_, n_, (n_ == 0) ? 2 : 0); else { kr[0] = kr[1] = vr[0] = vr[1] = (v4u){0u, 0u, 0u, 0u}; } } while (0)
    if (item < SWA_ITEMS) SW_PREFETCH(item);
    while (item < SWA_ITEMS) {
        if (tid == 0) qword[2] = __hip_atomic_fetch_add(F.ctl + CW_SWAQ, 1u, __ATOMIC_RELAXED, __HIP_MEMORY_SCOPE_AGENT);
        SW_DECODE(item, hp, n, kvh, b);
        const int head = 4 * kvh + 2 * hp + (w >> 2), qi = 128 * n + 32 * qt + r32;
        const size_t rowb = (size_t)b * SEQ;
        bf16x8 qf[8];
        { LAS unsigned char* qst = L + 65536 + w * 8704;
#pragma unroll
          for (int i = 0; i < 8; ++i) *(LAS v4u*)(qst + (4 * i + (lane >> 4)) * 272 + 16 * (lane & 15)) = qv[i];
          asm volatile("s_waitcnt lgkmcnt(0)" ::: "memory");
#pragma unroll
          for (int s = 0; s < 8; ++s) qf[s] = *(const LAS bf16x8*)(qst + r32 * 272 + 16 * (2 * s + hi));
          asm volatile("s_waitcnt lgkmcnt(0)" ::: "memory"); }
        float m = sinksp[head] * 1.4426950408889634f, l = hi ? 0.f : 1.f;
        f32x16 O[4];
#pragma unroll
        for (int dt = 0; dt < 4; ++dt)
#pragma unroll
            for (int r = 0; r < 16; ++r) O[dt][r] = 0.f;
        const int t_lo = (n == 0) ? 2 : 0, t_hi = (n == 31) ? 4 : 6;
        for (int t = t_lo; t < t_hi; ++t) {
            const int bs = step & 1; ++step;
            if (!(abl & 16)) SW_STORE(bs);
            __syncthreads();
            if (t + 1 < t_hi && !(abl & 8)) SW_LOAD(b, kvh, n, t + 1);
            const int k0 = 128 * (n - 1) + 64 * t, qlo = 128 * n + 32 * qt;
            if (k0 + 63 >= qlo - 128 && k0 <= qlo + 31 + 128 && !(abl & 32)) {
                LAS unsigned char* K = L + bs * 32768; LAS unsigned char* V = K + 16384;
                f32x16 p0, p1;
#pragma unroll
                for (int r = 0; r < 16; ++r) { p0[r] = 0.f; p1[r] = 0.f; }
                unsigned aKr = (unsigned)(bs * 32768) + (unsigned)((r32 << 8) | ((hi ^ (((r32 & 3) << 2) | ((r32 >> 2) & 3))) << 4)); asm volatile("" : "+v"(aKr));
#define SW_KF(s_, half) (*(const LAS bf16x8*)(L + (aKr ^ ((2 * (s_)) << 4)) + (half) * 8192))
                bf16x8 ka[4], kb[4];
                ka[0] = SW_KF(0, 0); kb[0] = SW_KF(0, 1); ka[1] = SW_KF(1, 0); kb[1] = SW_KF(1, 1); ka[2] = SW_KF(2, 0); kb[2] = SW_KF(2, 1);
                __builtin_amdgcn_sched_barrier(0);
#pragma unroll
                for (int s = 0; s < 8; ++s) {
                    if (s + 3 < 8) { ka[(s + 3) & 3] = SW_KF(s + 3, 0); kb[(s + 3) & 3] = SW_KF(s + 3, 1); }
                    if (!(abl & 1)) { p0 = MFMA32(ka[s & 3], qf[s], p0); p1 = MFMA32(kb[s & 3], qf[s], p1); }
                    __builtin_amdgcn_sched_barrier(0); }
#undef SW_KF
                if (!(abl & 2)) {
                const bool needmask = !(k0 + 63 - qlo <= 128 && qlo + 31 - k0 <= 128);
                if (needmask) {
#pragma unroll
                    for (int r = 0; r < 16; ++r) { const int kj = k0 + (r & 3) + 8 * (r >> 2) + 4 * hi;
                        p0[r] = ((unsigned)(qi - kj + 128) <= 256u) ? p0[r] : -INFINITY; p1[r] = ((unsigned)(qi - kj - 32 + 128) <= 256u) ? p1[r] : -INFINITY; } }
                float mn = m, alpha = 1.f;
                if (!fastsm) { float mloc = -INFINITY;
#pragma unroll
                    for (int r = 0; r < 16; ++r) mloc = fmaxf(mloc, fmaxf(p0[r], p1[r]));
                    mloc = fmaxf(mloc, __shfl_xor(mloc, 32));
                    mn = fmaxf(m, mloc); alpha = __builtin_amdgcn_exp2f(m - mn); m = mn; }
                float ls = 0.f;
#pragma unroll
                for (int r = 0; r < 16; ++r) { p0[r] = __builtin_amdgcn_exp2f(p0[r] - mn); p1[r] = __builtin_amdgcn_exp2f(p1[r] - mn); ls += p0[r] + p1[r]; }
                l = l * alpha + ls;
                if (!fastsm) {
#pragma unroll
                    for (int dt = 0; dt < 4; ++dt)
#pragma unroll
                        for (int r = 0; r < 16; ++r) O[dt][r] *= alpha; }
                }
                bf16x8 pb[4]; pb[0] = pack_step(p0, 0); pb[1] = pack_step(p0, 1); pb[2] = pack_step(p1, 0); pb[3] = pack_step(p1, 1);
                unsigned aVr0 = (unsigned)(bs * 32768 + 16384) + (unsigned)(((4 * hi + q4) << 8) | ((((2 * h16 + (p4 >> 1)) ^ ((q4 << 2) | hi)) & 15) << 4) | ((p4 & 1) << 3));
                unsigned aVr1 = (unsigned)(bs * 32768 + 16384) + (unsigned)(((4 * hi + q4 + 8) << 8) | ((((2 * h16 + (p4 >> 1)) ^ ((q4 << 2) | (2 + hi))) & 15) << 4) | ((p4 & 1) << 3));
                asm volatile("" : "+v"(aVr0), "+v"(aVr1));
#define SW_VF(f_) ({ const s16x4 lo_ = tr_rd(L + (aVr0 ^ (((f_) >> 2) << 6)) + ((f_) & 3) * 4096), hh_ = tr_rd(L + (aVr1 ^ (((f_) >> 2) << 6)) + ((f_) & 3) * 4096); (bf16x8){lo_[0], lo_[1], lo_[2], lo_[3], hh_[0], hh_[1], hh_[2], hh_[3]}; })
                bf16x8 vf[4]; vf[0] = SW_VF(0); vf[1] = SW_VF(1); vf[2] = SW_VF(2);
                __builtin_amdgcn_sched_barrier(0);
#pragma unroll
                for (int f = 0; f < 16; ++f) {
                    if (f + 3 < 16) vf[(f + 3) & 3] = SW_VF(f + 3);
                    if (!(abl & 4)) O[f >> 2] = MFMA32(vf[f & 3], pb[f & 3], O[f >> 2]);
                    __builtin_amdgcn_sched_barrier(0); }
#undef SW_VF
            }
        }
        __builtin_amdgcn_sched_barrier(0);
        const unsigned nx = qword[2]; const int nitem = (nx < (unsigned)SWA_ITEMS) ? (int)nx : SWA_ITEMS;
        if (nitem < SWA_ITEMS) SW_PREFETCH(nitem);
        __builtin_amdgcn_sched_barrier(0);
        l += __shfl_xor(l, 32);
        const float inv = 1.0f / l;
        if (!(abl & 64)) {
            LAS unsigned char* ost = L + 65536 + w * 8704;
#pragma unroll
            for (int dt = 0; dt < 4; ++dt)
#pragma unroll
                for (int g = 0; g < 4; ++g) { u32x2 ow; ow.x = cvtpk(O[dt][4 * g] * inv, O[dt][4 * g + 1] * inv); ow.y = cvtpk(O[dt][4 * g + 2] * inv, O[dt][4 * g + 3] * inv);
                    *(LAS u32x2*)(ost + r32 * 272 + 2 * (32 * dt + 8 * g + 4 * hi)) = ow; }
            asm volatile("s_waitcnt lgkmcnt(0)" ::: "memory");
            bf16* ob = dummy_o ? (bf16*)(F.ws + WS_DUMMY) + (size_t)((128 * n + 32 * qt) & 1023) * 1024 + head * 128 : SQp + (rowb + 128 * n + 32 * qt) * 1024 + head * 128;
            int ln2 = lane; asm volatile("" : "+v"(ln2));
            const unsigned oo = (unsigned)((ln2 >> 4) * 2048 + 16 * (ln2 & 15)), so = (unsigned)((ln2 >> 4) * 272 + 16 * (ln2 & 15));
#pragma unroll
            for (int i = 0; i < 8; ++i) { const v4u ov = *(const LAS v4u*)(ost + so + 4 * 272 * i); *(v4u*)((unsigned char*)ob + (oo + 8192u * i)) = ov; }
            asm volatile("s_waitcnt lgkmcnt(0)" ::: "memory");
        }
        __syncthreads();
        item = nitem;
    }
#undef SW_LOAD
#undef SW_STORE
#undef SW_PREFETCH
#undef SW_DECODE
}

constexpr int N_PHASES = 10;
constexpr int SWA_PHASE3_LIMIT = 600;
#ifndef STAGGER_US
#define STAGGER_US 0
#endif
__device__ __forceinline__ void stagger_wait(int us) { if (us > 0 && (blockIdx.x & 8)) { const unsigned long long t0 = __builtin_amdgcn_s_memrealtime(); while (__builtin_amdgcn_s_memrealtime() - t0 < (unsigned long long)us * 100ull) __builtin_amdgcn_s_sleep(8); } }
#ifndef PROBE_REP
#define PROBE_REP -1
#endif
#ifndef PROBE_N
#define PROBE_N 3
#endif
#ifndef PROBE_ABL
#define PROBE_ABL 0
#endif
static_assert(GLA_LDS_END <= LDSCTL_OFF, "GLA LDS map");
struct Args { const float* in[17]; float* out; unsigned char* ws; int ph_lo, ph_hi, use_bar, pad; };
__global__ void __launch_bounds__(NWAVES * 64, 2) mk_fwd(Args args) {
    extern __shared__ __attribute__((aligned(16))) unsigned char lds[];
    Frame F;
    F.lds = (LAS unsigned char*)lds;
    F.MISC = (volatile LAS unsigned*)(F.lds + MISC_OFF);
    F.tid = threadIdx.x; F.lane = F.tid & 63; F.wave = __builtin_amdgcn_readfirstlane(F.tid >> 6);
    F.G = gridDim.x; { const int bx = blockIdx.x; F.vcu = (F.G % 8 == 0) ? (bx % 8) * (F.G / 8) + bx / 8 : bx; }
    F.ws = args.ws; F.out = args.out;
    F.ctl = (gu32*)(args.ws + WS_CTL);
    for (int u = F.tid; u < (LDS_BYTES - LDSCTL_OFF) / 4; u += NWAVES * 64) ((LAS unsigned*)(F.lds + LDSCTL_OFF))[u] = 0u;
    __syncthreads();
    XcdBarrier bar; bar.bar = (unsigned*)(F.ctl + CW_BAR); bar.x = 0; bar.st = nullptr;
    if (args.use_bar) bar = xcd_barrier_post((unsigned*)(F.ctl + CW_BAR), F.MISC + 8);
    const int lo = args.ph_lo, hi = args.ph_hi;
#define IN(k) (lo <= (k) && (k) < hi)
#define SEAM(k) do { if (IN(k) && IN((k) + 1)) xcd_barrier(bar); } while (0)

    if (IN(0)) { p0_prologue(F); } SEAM(0);
    if (IN(1)) {
#if PROBE_REP == 11
        p1_lr(F);
#endif
        stagger_wait(STAGGER_US);
        pg8::Gemm g{F.XN(), F.WIN(), M, NPROJ, DM}; pg8::StaticOrder S; S.init(M, NPROJ, F.G, (int)blockIdx.x);
        static_assert(pg8::EpiProj::O_QG == WS_QG && pg8::EpiProj::O_KG == WS_KG && pg8::EpiProj::O_VG == WS_VG && pg8::EpiProj::O_R == WS_R && pg8::EpiProj::O_SQ == WS_SQ && pg8::EpiProj::O_SK == WS_SK && pg8::EpiProj::O_SV == WS_SV && pg8::EpiProj::O_GA == WS_GA && pg8::EpiProj::O_GB == WS_GB, "EpiProj offsets");
        pg8::EpiProj E{F.ws, args.pad & 128};
        pg8::gemm_phase<pg8::EpiProj, pg8::StaticOrder, true, true>(F.lds + RING_OFF, g, S, E);
    } SEAM(1);
    if (IN(2)) { p1b_qknorm_rope(F, args.pad & 8); } SEAM(2);
    if (IN(3)) { if ((args.pad & 3) != 2) gla_mfma<0>(F, F.vcu); __syncthreads(); if ((args.pad & 3) != 1) swa_mfma(F, args.pad & 8, args.pad >> 8); } SEAM(3);
    if (IN(4)) { gla_mfma<1>(F, F.vcu); } SEAM(4);
    if (IN(5)) { p2c_combine(F, args.pad & 8); } SEAM(5);
    if (IN(6)) {
        pg8::Gemm g{F.R(), F.WG(), M, DM, DM, F.SQ(), F.WS_()}; pg8::StaticOrder S; S.init(M, DM, F.G, (int)blockIdx.x);
        pg8::EpiMerge2 E{F.GA(), F.GB(), F.MERGED()};
        pg8::gemm_phase<pg8::EpiMerge2, pg8::StaticOrder, true, true, true>(F.lds + RING_OFF, g, S, E);
    } SEAM(6);
    if (IN(7)) {
        pg8::Gemm g{F.MERGED(), F.WOUT(), M, DM, DM}; pg8::StaticOrder S; S.init(M, DM, F.G, (int)blockIdx.x);
        pg8::EpiX1 E{inp(I_X), F.X1B(), F.SSQ()};
        pg8::gemm_phase<pg8::EpiX1, pg8::StaticOrder, true, true>(F.lds + RING_OFF, g, S, E);
    } SEAM(7);
    if (IN(8)) {
        stagger_wait(STAGGER_US);
        pg8::Gemm g{F.X1B(), F.WFI(), M, 2 * DFF, DM}; pg8::StaticOrder S; S.init(M, 2 * DFF, F.G, (int)blockIdx.x);
        pg8::EpiSwiGLU E{F.SSQ(), F.H()};
        pg8::gemm_phase<pg8::EpiSwiGLU, pg8::StaticOrder, true, true>(F.lds + RING_OFF, g, S, E);
    } SEAM(8);
    if (IN(9)) {
        pg8::Gemm g{F.H(), F.WFO(), M, DM, DFF}; pg8::StaticOrder S; S.init(M, DM, F.G, (int)blockIdx.x);
        pg8::EpiResid E{F.X1B(), F.out};
        pg8::gemm_phase<pg8::EpiResid, pg8::StaticOrder, true, true>(F.lds + RING_OFF, g, S, E);
    }
#undef IN
#undef SEAM
}

#ifndef MK_ONE_LAUNCH
#define MK_ONE_LAUNCH 1
#endif
extern "C" void kernel_launch(void* const* d_in, const int* in_sizes, int n_in, void* d_out, int out_size, void* d_ws, size_t ws_size, hipStream_t stream) {
    static int grid = 0;
    if (grid == 0) {
        if (n_in != 17 || in_sizes[0] != M * DM || out_size != M * DM || ws_size < WS_END + 33 * MiB) { fprintf(stderr, "kernel_launch: shape/workspace mismatch (n_in %d, in0 %d, out %d, ws %zu); nothing launched\n", n_in, n_in > 0 ? in_sizes[0] : -1, out_size, ws_size); grid = -1; return; }
        int dev = 0, cus = 0;
        if (hipGetDevice(&dev) != hipSuccess || hipDeviceGetAttribute(&cus, hipDeviceAttributeMultiprocessorCount, dev) != hipSuccess) { grid = -1; return; }
        if (hipFuncSetAttribute((const void*)mk_fwd, hipFuncAttributeMaxDynamicSharedMemorySize, LDS_BYTES) != hipSuccess) { fprintf(stderr, "kernel_launch: hipFuncSetAttribute failed\n"); grid = -1; return; }
        (void)hipGetLastError();
        grid = cus;
        if (grid != 256) fprintf(stderr, "kernel_launch: %d CUs; built for 256\n", grid);
    }
    if (grid < 0) return;
    (void)hipMemsetAsync((char*)d_ws + WS_CTL, 0, CTL_ZERO_BYTES, stream);
    Args a{};
    for (int i = 0; i < 17; ++i) a.in[i] = (const float*)d_in[i];
    a.out = (float*)d_out; a.ws = (unsigned char*)d_ws;
#if PROBE_REP == -1
    a.ph_lo = 0; a.ph_hi = N_PHASES; a.use_bar = 1;
    hipLaunchKernelGGL(mk_fwd, dim3(grid), dim3(NWAVES * 64), LDS_BYTES, stream, a);
#else
    for (int p = 0; p < N_PHASES; ++p) { const int nrep = (p == PROBE_REP) ? PROBE_N : 1;
        if (p == 2 && PROBE_REP == 21) {
            a.ph_lo = 2; a.ph_hi = 3; a.use_bar = 0;
            for (int r = 0; r + 1 < PROBE_N; ++r) { a.pad = 2 | 8; hipLaunchKernelGGL(mk_fwd, dim3(grid), dim3(NWAVES * 64), LDS_BYTES, stream, a); }
            a.pad = 0; hipLaunchKernelGGL(mk_fwd, dim3(grid), dim3(NWAVES * 64), LDS_BYTES, stream, a); continue; }
        if (p == 4 && PROBE_REP == 40) {
            a.ph_lo = 4; a.ph_hi = 5; a.use_bar = 0;
            for (int r = 0; r + 1 < PROBE_N; ++r) { a.pad = 8; hipLaunchKernelGGL(mk_fwd, dim3(grid), dim3(NWAVES * 64), LDS_BYTES, stream, a); }
            a.pad = 0; hipLaunchKernelGGL(mk_fwd, dim3(grid), dim3(NWAVES * 64), LDS_BYTES, stream, a); continue; }
        if (p == 2 && PROBE_REP == 20) {
            a.ph_lo = 2; a.ph_hi = 3; a.use_bar = 0;
            for (int r = 0; r + 1 < PROBE_N; ++r) { a.pad = 5; hipLaunchKernelGGL(mk_fwd, dim3(grid), dim3(NWAVES * 64), LDS_BYTES, stream, a); }
            a.pad = 0; hipLaunchKernelGGL(mk_fwd, dim3(grid), dim3(NWAVES * 64), LDS_BYTES, stream, a); continue; }
        if (p == 1 && PROBE_REP == 11) {
            a.ph_lo = 1; a.ph_hi = 2; a.use_bar = 0; a.pad = 16; hipLaunchKernelGGL(mk_fwd, dim3(grid), dim3(NWAVES * 64), LDS_BYTES, stream, a); a.pad = 0; continue; }
        if (p == 1 && PROBE_REP == 12) {
            a.ph_lo = 1; a.ph_hi = 2; a.use_bar = 0;
            for (int r = 0; r + 1 < PROBE_N; ++r) { a.pad = 128; hipLaunchKernelGGL(mk_fwd, dim3(grid), dim3(NWAVES * 64), LDS_BYTES, stream, a); }
            a.pad = 0; hipLaunchKernelGGL(mk_fwd, dim3(grid), dim3(NWAVES * 64), LDS_BYTES, stream, a); continue; }
        if (p == 4 && PROBE_REP == 41) {
            a.ph_lo = 4; a.ph_hi = 5; a.use_bar = 0;
            for (int r = 0; r + 1 < PROBE_N; ++r) { a.pad = 4 | (PROBE_ABL << 8); hipLaunchKernelGGL(mk_fwd, dim3(grid), dim3(NWAVES * 64), LDS_BYTES, stream, a); }
            a.pad = 0; hipLaunchKernelGGL(mk_fwd, dim3(grid), dim3(NWAVES * 64), LDS_BYTES, stream, a); continue; }
        if (p == 3 && PROBE_REP == 36) {
            a.ph_lo = 3; a.ph_hi = 4; a.use_bar = 0;
            for (int r = 0; r + 1 < PROBE_N; ++r) { a.pad = 1; hipLaunchKernelGGL(mk_fwd, dim3(grid), dim3(NWAVES * 64), LDS_BYTES, stream, a); }
            a.pad = 0; hipLaunchKernelGGL(mk_fwd, dim3(grid), dim3(NWAVES * 64), LDS_BYTES, stream, a); continue; }
        if (p == 3 && PROBE_REP == 37) {
            a.ph_lo = 3; a.ph_hi = 4; a.use_bar = 0;
            for (int r = 0; r + 1 < PROBE_N; ++r) { a.pad = 8; hipLaunchKernelGGL(mk_fwd, dim3(grid), dim3(NWAVES * 64), LDS_BYTES, stream, a); (void)hipMemsetAsync((char*)d_ws + WS_CTL, 0, 4096, stream); }
            a.pad = 0; hipLaunchKernelGGL(mk_fwd, dim3(grid), dim3(NWAVES * 64), LDS_BYTES, stream, a); continue; }
        if (p == 3 && PROBE_REP == 35) {
            a.ph_lo = 3; a.ph_hi = 4; a.use_bar = 0;
            for (int r = 0; r + 1 < PROBE_N; ++r) { a.pad = 2 | 8 | (PROBE_ABL << 8); hipLaunchKernelGGL(mk_fwd, dim3(grid), dim3(NWAVES * 64), LDS_BYTES, stream, a); (void)hipMemsetAsync((char*)d_ws + WS_CTL, 0, 4096, stream); }
            a.pad = 0; hipLaunchKernelGGL(mk_fwd, dim3(grid), dim3(NWAVES * 64), LDS_BYTES, stream, a); continue; }
        if (p == 3 && PROBE_REP >= 30 && PROBE_REP < 40) {
            a.ph_lo = 3; a.ph_hi = 4; a.use_bar = 0;
            for (int r = 0; r < (PROBE_REP == 30 ? 1 : PROBE_N); ++r) { a.pad = (r + 1 < (PROBE_REP == 30 ? 1 : PROBE_N)) ? 5 : 1; hipLaunchKernelGGL(mk_fwd, dim3(grid), dim3(NWAVES * 64), LDS_BYTES, stream, a); }
            a.pad = 2; hipLaunchKernelGGL(mk_fwd, dim3(grid), dim3(NWAVES * 64), LDS_BYTES, stream, a); a.pad = 0; continue; }
        for (int r = 0; r < nrep; ++r) { a.ph_lo = p; a.ph_hi = p + 1; a.use_bar = 0; hipLaunchKernelGGL(mk_fwd, dim3(grid), dim3(NWAVES * 64), LDS_BYTES, stream, a); } }
#endif
}
```

```cpp
#include <hip/hip_runtime.h>
#include <cstdio>
#include <cstdint>
#include <cmath>
namespace pg8 {
#define PG8_LAS __attribute__((address_space(3)))
typedef unsigned short bf16_t;
typedef short bf16x8 __attribute__((ext_vector_type(8)));
typedef float f32x4 __attribute__((ext_vector_type(4)));
typedef unsigned u32x4 __attribute__((ext_vector_type(4)));
constexpr int BM = 256, BK = 64, HALF = 128, HTB = HALF * BK * 2  , STAGE_BYTES = 8 * HTB, NXCD = 8, WGM = 8;

__host__ __device__ __forceinline__ int lds_byte(int r, int c) { const int st = (r >> 4) * 2 + (c >> 5), rr = r & 15, cc = c & 31, ob = rr * 64 + cc * 2; return st * 1024 + (ob ^ (((ob >> 9) & 1) << 5)); }
__host__ __device__ __forceinline__ void stage_rc(int b, int& R, int& C) { const int st = b / 1024, sb = b % 1024, swz = sb ^ (((sb >> 9) & 1) << 5); R = (st >> 1) * 16 + swz / 64; C = (st & 1) * 32 + (swz % 64) / 2; }
__host__ __device__ __forceinline__ int perm32(int rho) { const int n = rho >> 4, i = rho & 15; return 8 * (i >> 2) + 4 * n + (i & 3); }

template <class E> struct epi_has_post { static constexpr bool v = false; };
struct Unit { int pm, pn; };
struct Gemm { const bf16_t* A; const bf16_t* Bt; int M, N, K; const bf16_t* A2 = nullptr; const bf16_t* Bt2 = nullptr; };

struct StaticOrder {
    int nM, nN, nwg, G, c;
    __host__ __device__ void init(int M, int N, int G_, int c_) { nM = M / BM; nN = N / BM; nwg = nM * nN; G = G_; c = c_; }
    __host__ __device__ bool next(int i, Unit& u) const {
        const long L = (long)i * G + c; if (L >= nwg) return false;
        int wgid = (int)L; { const int q = nwg / NXCD, r = nwg % NXCD, xcd = wgid % NXCD, off = wgid / NXCD; wgid = (xcd < r ? xcd * (q + 1) : r * (q + 1) + (xcd - r) * q) + off; }
        const int nig = WGM * nN, gid = wgid / nig, fm = gid * WGM, gsz = (nM - fm) < WGM ? (nM - fm) : WGM;
        u.pm = fm + ((wgid % nig) % gsz); u.pn = (wgid % nig) / gsz; return true;
    }
    __device__ __forceinline__ void a_ready(const Unit&) const {}
    __device__ __forceinline__ void done(const Unit&) const {}
};

__device__ __forceinline__ unsigned cvt_pk_bf16(float lo, float hi) { unsigned r; asm volatile("v_cvt_pk_bf16_f32 %0, %1, %2" : "=v"(r) : "v"(lo), "v"(hi)); return r; }
typedef float f32x2 __attribute__((ext_vector_type(2)));
typedef unsigned u32x2 __attribute__((ext_vector_type(2)));
__device__ __forceinline__ float bflo(unsigned w) { return __uint_as_float(w << 16); }
__device__ __forceinline__ float bfhi(unsigned w) { return __uint_as_float(w & 0xffff0000u); }
__device__ __forceinline__ float sigm(float x) { return __builtin_amdgcn_rcpf(1.0f + __builtin_amdgcn_exp2f(-1.4426950408889634f * x)); }

struct EpiProj {
    static constexpr bool PERM = true, AFTER_DRAIN = false;
    static constexpr size_t MB = 1u << 20, O_QG = 48 * MB, O_KG = 80 * MB, O_VG = 112 * MB, O_R = 176 * MB, O_SQ = 240 * MB, O_SK = 304 * MB, O_SV = 320 * MB, O_GA = 336 * MB, O_GB = 400 * MB;
    unsigned char* ws; int skip;
    __device__ __forceinline__ void operator()(const f32x4 (&acc)[2][2][4][2], const Unit& u, int wr, int wc, int fr, int fq) const { part(acc, u, wr, wc, fr, fq, 0); part(acc, u, wr, wc, fr, fq, 1); }
    __device__ __forceinline__ void part(const f32x4 (&acc)[2][2][4][2], const Unit& u, int wr, int wc, int fr, int fq, const int ai) const {
        if (skip) { asm volatile("" :: "v"(acc[0][0][0][0]), "v"(acc[1][1][3][1])); return; }
        const int pn = u.pn; size_t off; int ldc, ct; float sc = 1.f;
        if (pn < 2) { off = O_QG; ldc = 512; ct = pn * 256; sc = 0.08838834764831845f; }
        else if (pn < 4) { off = O_KG; ldc = 512; ct = (pn - 2) * 256; }
        else if (pn < 8) { off = O_VG; ldc = 1024; ct = (pn - 4) * 256; }
        else if (pn < 12) { off = O_R; ldc = 1024; ct = (pn - 8) * 256; }
        else if (pn < 16) { off = O_SQ; ldc = 1024; ct = (pn - 12) * 256; }
        else if (pn == 16) { off = O_SK; ldc = 256; ct = 0; }
        else if (pn == 17) { off = O_SV; ldc = 256; ct = 0; }
        else if (pn < 22) { off = O_GA; ldc = 1024; ct = (pn - 18) * 256; }
        else { off = O_GB; ldc = 1024; ct = (pn - 22) * 256; }
        bf16_t* base = (bf16_t*)(ws + off);
        const int row0 = u.pm * BM + wr * 64 + fr, col0 = ct + wc * 32 + 8 * fq;
#pragma unroll
            for (int m = 0; m < 4; ++m) { bf16_t* rowp = base + (size_t)(row0 + ai * HALF + m * 16) * ldc + col0;
#pragma unroll
                for (int bj = 0; bj < 2; ++bj) { const f32x4 v0 = acc[ai][bj][m][0] * sc, v1 = acc[ai][bj][m][1] * sc;
                    u32x4 w; w.x = cvt_pk_bf16(v0[0], v0[1]); w.y = cvt_pk_bf16(v0[2], v0[3]); w.z = cvt_pk_bf16(v1[0], v1[1]); w.w = cvt_pk_bf16(v1[2], v1[3]);
                    *(u32x4*)(rowp + bj * HALF) = w; } }
    }
};
struct QkPost {
    bf16_t *SQ, *SK; const float *rope, *g_q, *g_k; float qsc;
    __device__ __forceinline__ void post(const Unit& u, int tid) const {
        const int wave = tid >> 6, lane = tid & 63, slot = lane >> 3, c = lane & 7; const bool isq = u.pn < 16;
        bf16_t* base = isq ? SQ + (size_t)(u.pn - 12) * 256 : SK; const int ldc = isq ? 1024 : 256; const float* gn = isq ? g_q : g_k; const float sc = isq ? qsc : 1.f;
        const f32x4 g10 = *(const f32x4*)(gn + 8 * c), g11 = *(const f32x4*)(gn + 8 * c + 4), g20 = *(const f32x4*)(gn + 64 + 8 * c), g21 = *(const f32x4*)(gn + 64 + 8 * c + 4);
#pragma unroll 1
        for (int rd = 0; rd < 2; ++rd) {
            u32x4 a1[4], a2[4]; f32x4 cs[4][4]; bf16_t* pp[4];
#pragma unroll
            for (int q = 0; q < 4; ++q) { const int idx = ((rd * 4 + q) * 8 + wave) * 8 + slot, row = u.pm * BM + (idx >> 1), pos = row & 4095;
                pp[q] = base + (size_t)row * ldc + (idx & 1) * 128; a1[q] = *(const u32x4*)(pp[q] + 8 * c); a2[q] = *(const u32x4*)(pp[q] + 64 + 8 * c);
                const f32x4* rp = (const f32x4*)(rope + 2 * (pos * 64 + 8 * c));
#pragma unroll
                for (int j = 0; j < 4; ++j) cs[q][j] = rp[j]; }
#pragma unroll
            for (int q = 0; q < 4; ++q) { float x1[8], x2[8];
                x1[0] = bflo(a1[q].x); x1[1] = bfhi(a1[q].x); x1[2] = bflo(a1[q].y); x1[3] = bfhi(a1[q].y); x1[4] = bflo(a1[q].z); x1[5] = bfhi(a1[q].z); x1[6] = bflo(a1[q].w); x1[7] = bfhi(a1[q].w);
                x2[0] = bflo(a2[q].x); x2[1] = bfhi(a2[q].x); x2[2] = bflo(a2[q].y); x2[3] = bfhi(a2[q].y); x2[4] = bflo(a2[q].z); x2[5] = bfhi(a2[q].z); x2[6] = bflo(a2[q].w); x2[7] = bfhi(a2[q].w);
                float ss = 0.f;
#pragma unroll
                for (int e = 0; e < 8; ++e) ss += x1[e] * x1[e] + x2[e] * x2[e];
                ss += __shfl_xor(ss, 1); ss += __shfl_xor(ss, 2); ss += __shfl_xor(ss, 4);
                const float rstd = sc * __builtin_amdgcn_rsqf(ss * (1.f / 128.f) + 1e-6f);
                float o1[8], o2[8];
#pragma unroll
                for (int e = 0; e < 8; ++e) { const float y1 = x1[e] * rstd * (e < 4 ? g10[e & 3] : g11[e & 3]), y2 = x2[e] * rstd * (e < 4 ? g20[e & 3] : g21[e & 3]);
                    const float cc = cs[q][e >> 1][2 * (e & 1)], sn = cs[q][e >> 1][2 * (e & 1) + 1]; o1[e] = y1 * cc - y2 * sn; o2[e] = y2 * cc + y1 * sn; }
                u32x4 w1, w2; w1.x = cvt_pk_bf16(o1[0], o1[1]); w1.y = cvt_pk_bf16(o1[2], o1[3]); w1.z = cvt_pk_bf16(o1[4], o1[5]); w1.w = cvt_pk_bf16(o1[6], o1[7]);
                w2.x = cvt_pk_bf16(o2[0], o2[1]); w2.y = cvt_pk_bf16(o2[2], o2[3]); w2.z = cvt_pk_bf16(o2[4], o2[5]); w2.w = cvt_pk_bf16(o2[6], o2[7]);
                *(u32x4*)(pp[q] + 8 * c) = w1; *(u32x4*)(pp[q] + 64 + 8 * c) = w2; }
        }
    }
};
struct EpiMerge2 {
    static constexpr bool PERM = true, AFTER_DRAIN = false;
    const bf16_t* ga; const bf16_t* gb; bf16_t* out;
    __device__ __forceinline__ void mid(f32x4 (&acc)[2][2][4][2], const Unit& u, int wr, int wc, int fr, int fq) const {
        int row0 = u.pm * BM + wr * 64 + fr, col0 = u.pn * BM + wc * 32 + 8 * fq; asm volatile("" : "+v"(row0), "+v"(col0));
#pragma unroll
        for (int ai = 0; ai < 2; ++ai)
#pragma unroll
            for (int m = 0; m < 4; ++m) { const size_t off = (size_t)(row0 + ai * HALF + m * 16) * 1024 + col0;
#pragma unroll
                for (int bj = 0; bj < 2; ++bj) { const size_t o2 = off + bj * HALF; const u32x4 a = *(const u32x4*)(ga + o2), b = *(const u32x4*)(gb + o2);
#define PG8_RATIO(aw, bw) ((1.0f + __builtin_amdgcn_exp2f(-1.4426950408889634f * (bw))) * __builtin_amdgcn_rcpf(1.0f + __builtin_amdgcn_exp2f(-1.4426950408889634f * (aw))))
                    acc[ai][bj][m][0][0] *= PG8_RATIO(bflo(a.x), bflo(b.x)); acc[ai][bj][m][0][1] *= PG8_RATIO(bfhi(a.x), bfhi(b.x)); acc[ai][bj][m][0][2] *= PG8_RATIO(bflo(a.y), bflo(b.y)); acc[ai][bj][m][0][3] *= PG8_RATIO(bfhi(a.y), bfhi(b.y));
                    acc[ai][bj][m][1][0] *= PG8_RATIO(bflo(a.z), bflo(b.z)); acc[ai][bj][m][1][1] *= PG8_RATIO(bfhi(a.z), bfhi(b.z)); acc[ai][bj][m][1][2] *= PG8_RATIO(bflo(a.w), bflo(b.w)); acc[ai][bj][m][1][3] *= PG8_RATIO(bfhi(a.w), bfhi(b.w));
#undef PG8_RATIO
                }
                if (m & 1) asm volatile("" ::: "memory"); }
    }
    __device__ __forceinline__ void operator()(const f32x4 (&acc)[2][2][4][2], const Unit& u, int wr, int wc, int fr, int fq) const {
        int row0 = u.pm * BM + wr * 64 + fr, col0 = u.pn * BM + wc * 32 + 8 * fq; asm volatile("" : "+v"(row0), "+v"(col0));
        u32x4 gq[2][4][2];
#pragma unroll
        for (int ai = 0; ai < 2; ++ai)
#pragma unroll
            for (int m = 0; m < 4; ++m)
#pragma unroll
                for (int bj = 0; bj < 2; ++bj) gq[ai][m][bj] = *(const u32x4*)(gb + (size_t)(row0 + ai * HALF + m * 16) * 1024 + col0 + bj * HALF);
        asm volatile("" ::: "memory");
#pragma unroll
        for (int ai = 0; ai < 2; ++ai)
#pragma unroll
            for (int m = 0; m < 4; ++m) { const size_t off = (size_t)(row0 + ai * HALF + m * 16) * 1024 + col0;
#pragma unroll
                for (int bj = 0; bj < 2; ++bj) { const size_t o2 = off + bj * HALF; const u32x4 g = gq[ai][m][bj];
                    const f32x4 a0 = acc[ai][bj][m][0], a1 = acc[ai][bj][m][1];
                    u32x4 w; w.x = cvt_pk_bf16(a0[0] * sigm(bflo(g.x)), a0[1] * sigm(bfhi(g.x))); w.y = cvt_pk_bf16(a0[2] * sigm(bflo(g.y)), a0[3] * sigm(bfhi(g.y)));
                    w.z = cvt_pk_bf16(a1[0] * sigm(bflo(g.z)), a1[1] * sigm(bfhi(g.z))); w.w = cvt_pk_bf16(a1[2] * sigm(bflo(g.w)), a1[3] * sigm(bfhi(g.w)));
                    *(u32x4*)(out + o2) = w; } }
    }
};
struct EpiX1 {
    static constexpr bool PERM = true, AFTER_DRAIN = false;
    const float* x; bf16_t* xb; float* ssq;
    __device__ __forceinline__ void operator()(const f32x4 (&acc)[2][2][4][2], const Unit& u, int wr, int wc, int fr, int fq) const {
        const int row0 = u.pm * BM + wr * 64 + fr, col0 = u.pn * BM + wc * 32 + 8 * fq;
        f32x4 xv[2][2][2][2];
#define PG8_X1_LOAD(q_) do { _Pragma("unroll") for (int m2 = 0; m2 < 2; ++m2) _Pragma("unroll") for (int bj = 0; bj < 2; ++bj) { \
            const size_t o2_ = (size_t)(row0 + ((q_) >> 1) * HALF + (2 * ((q_) & 1) + m2) * 16) * 1024 + col0 + bj * HALF; xv[(q_) & 1][m2][bj][0] = *(const f32x4*)(x + o2_); xv[(q_) & 1][m2][bj][1] = *(const f32x4*)(x + o2_ + 4); } } while (0)
        PG8_X1_LOAD(0);
#pragma unroll
        for (int q = 0; q < 4; ++q) {
            if (q + 1 < 4) PG8_X1_LOAD(q + 1);
            asm volatile("" ::: "memory");
#pragma unroll
            for (int m2 = 0; m2 < 2; ++m2) { const int ai = q >> 1, m = 2 * (q & 1) + m2, row = row0 + ai * HALF + m * 16; const size_t off = (size_t)row * 1024 + col0; float s = 0.f;
#pragma unroll
                for (int bj = 0; bj < 2; ++bj) { const size_t o2 = off + bj * HALF;
                    const f32x4 v0 = xv[q & 1][m2][bj][0] + acc[ai][bj][m][0], v1 = xv[q & 1][m2][bj][1] + acc[ai][bj][m][1];
                    s += ((v0[0] * v0[0] + v0[1] * v0[1]) + (v0[2] * v0[2] + v0[3] * v0[3])) + ((v1[0] * v1[0] + v1[1] * v1[1]) + (v1[2] * v1[2] + v1[3] * v1[3]));
                    u32x4 w; w.x = cvt_pk_bf16(v0[0], v0[1]); w.y = cvt_pk_bf16(v0[2], v0[3]); w.z = cvt_pk_bf16(v1[0], v1[1]); w.w = cvt_pk_bf16(v1[2], v1[3]); *(u32x4*)(xb + o2) = w; }
                s += __shfl_xor(s, 16); s += __shfl_xor(s, 32);
                if (fq == 0) ssq[(size_t)row * 16 + u.pn * 4 + wc] = s; }
            asm volatile("" ::: "memory");
        }
#undef PG8_X1_LOAD
    }
};
struct EpiSwiGLU {
    static constexpr bool PERM = true, AFTER_DRAIN = false;
    const float* ssq; bf16_t* H;
    __device__ __forceinline__ void operator()(const f32x4 (&acc)[2][2][4][2], const Unit& u, int wr, int wc, int fr, int fq) const {
        const int row0 = u.pm * BM + wr * 64 + fr, col0 = u.pn * HALF + wc * 32 + 8 * fq;
        f32x4 sq[2][4];
#pragma unroll
        for (int ai = 0; ai < 2; ++ai)
#pragma unroll
            for (int m = 0; m < 4; ++m) sq[ai][m] = *((const f32x4*)(ssq + (size_t)(row0 + ai * HALF + m * 16) * 16) + fq);
        asm volatile("" ::: "memory");
#pragma unroll
        for (int ai = 0; ai < 2; ++ai)
#pragma unroll
            for (int m = 0; m < 4; ++m) { const int row = row0 + ai * HALF + m * 16;
                float st = (sq[ai][m][0] + sq[ai][m][1]) + (sq[ai][m][2] + sq[ai][m][3]); st += __shfl_xor(st, 16); st += __shfl_xor(st, 32);
                const float rstd = __builtin_amdgcn_rsqf(st * (1.0f / 1024.0f) + 1e-6f);
                float hv[8];
#pragma unroll
                for (int n = 0; n < 2; ++n)
#pragma unroll
                    for (int e = 0; e < 4; ++e) { const float g = acc[ai][0][m][n][e] * rstd, up = acc[ai][1][m][n][e] * rstd; hv[4 * n + e] = g * sigm(g) * up; }
                u32x4 w; w.x = cvt_pk_bf16(hv[0], hv[1]); w.y = cvt_pk_bf16(hv[2], hv[3]); w.z = cvt_pk_bf16(hv[4], hv[5]); w.w = cvt_pk_bf16(hv[6], hv[7]);
                *(u32x4*)(H + (size_t)row * 2816 + col0) = w; }
    }
};
struct EpiResid {
    static constexpr bool PERM = true, AFTER_DRAIN = false;
    const bf16_t* xb; float* out;
    __device__ __forceinline__ void operator()(const f32x4 (&acc)[2][2][4][2], const Unit& u, int wr, int wc, int fr, int fq) const {
        const int row0 = u.pm * BM + wr * 64 + fr, col0 = u.pn * BM + wc * 32 + 8 * fq;
        u32x4 xw[2][4][2];
#pragma unroll
        for (int ai = 0; ai < 2; ++ai)
#pragma unroll
            for (int m = 0; m < 4; ++m)
#pragma unroll
                for (int bj = 0; bj < 2; ++bj) xw[ai][m][bj] = *(const u32x4*)(xb + (size_t)(row0 + ai * HALF + m * 16) * 1024 + col0 + bj * HALF);
        asm volatile("" ::: "memory");
#pragma unroll
        for (int ai = 0; ai < 2; ++ai)
#pragma unroll
            for (int m = 0; m < 4; ++m) { const size_t off = (size_t)(row0 + ai * HALF + m * 16) * 1024 + col0;
#pragma unroll
                for (int bj = 0; bj < 2; ++bj) { const size_t o2 = off + bj * HALF; const u32x4 w = xw[ai][m][bj];
                    *(f32x4*)(out + o2) = (f32x4){bflo(w.x), bfhi(w.x), bflo(w.y), bfhi(w.y)} + acc[ai][bj][m][0];
                    *(f32x4*)(out + o2 + 4) = (f32x4){bflo(w.z), bfhi(w.z), bflo(w.w), bfhi(w.w)} + acc[ai][bj][m][1]; } }
    }
};

template <class Epi, class Sched, bool ALIGN_EPI = false, bool SP2 = false, bool DUAL = false, bool SPLIT_EPI = false>
__device__ __forceinline__ void gemm_phase(PG8_LAS unsigned char* lds, const Gemm g, const Sched& S, const Epi& E) {
    const int tid = threadIdx.x, wid = __builtin_amdgcn_readfirstlane(tid >> 6), lane = tid & 63, wr = wid >> 2, wc = wid & 3, fr = lane & 15, fq = lane >> 4;
    const int K = g.K, TS = K / BK, nt = DUAL ? 2 * TS : TS;
    unsigned voffA[2], voffB[2];
#pragma unroll
    for (int i = 0; i < 2; ++i) { int R, C; stage_rc(tid * 16 + i * 8192, R, C); const int Rb = Epi::PERM ? ((R & ~31) + perm32(R & 31)) : R;
        voffA[i] = (unsigned)(R * K + C) * 2u; voffB[i] = (unsigned)(Rb * K + C) * 2u; }
    const size_t kstep = (size_t)(BK * 2);
    const size_t hstep = (size_t)HALF * K * 2;
    const size_t tstep = 2 * hstep;
    const unsigned ldsw = (unsigned)wid * 1024u;
    const int aoff = lds_byte(wr * 64 + fr, fq * 8), boff = lds_byte(wc * 32 + fr, fq * 8);
#define PG8_SA(b, h) (((b) * 2 + (h)) * HTB)
#define PG8_SB(b, h) ((4 + (b) * 2 + (h)) * HTB)
#define PG8_STAGE(bufoff, gbase, voff) do { _Pragma("unroll") for (int _i = 0; _i < 2; ++_i) \
        __builtin_amdgcn_global_load_lds((const unsigned*)((const char*)(gbase) + (voff)[_i]), (PG8_LAS unsigned*)(lds + (bufoff) + ldsw + _i * 8192), 16, 0, 0); } while (0)
#define PG8_LDA(dst, b, h) do { _Pragma("unroll") for (int m = 0; m < 4; ++m) _Pragma("unroll") for (int k = 0; k < 2; ++k) dst[m][k] = *(const PG8_LAS bf16x8*)(lds + PG8_SA(b, h) + aoff + m * 2048 + k * 1024); } while (0)
#define PG8_LDB(dst, b, h) do { _Pragma("unroll") for (int n = 0; n < 2; ++n) _Pragma("unroll") for (int k = 0; k < 2; ++k) dst[n][k] = *(const PG8_LAS bf16x8*)(lds + PG8_SB(b, h) + boff + n * 2048 + k * 1024); } while (0)
#define PG8_MMA(ai, bj, At, Bt) do { __builtin_amdgcn_s_setprio(1); _Pragma("unroll") for (int m = 0; m < 4; ++m) _Pragma("unroll") for (int n = 0; n < 2; ++n) _Pragma("unroll") for (int k = 0; k < 2; ++k) \
        acc[ai][bj][m][n] = __builtin_amdgcn_mfma_f32_16x16x32_bf16(Bt[n][k], At[m][k], acc[ai][bj][m][n], 0, 0, 0); __builtin_amdgcn_s_setprio(0); } while (0)
#define PG8_WAIT_V(n) asm volatile("s_waitcnt vmcnt(" #n ")" ::: "memory")
#define PG8_WAIT_L(n) asm volatile("s_waitcnt lgkmcnt(" #n ")" ::: "memory")
#define PG8_BAR __builtin_amdgcn_s_barrier()
#define PG8_SCHED __builtin_amdgcn_sched_barrier(0)
    Unit cur, nxt, prev; int ui = 0; bool have_prev = false; (void)prev; (void)have_prev;
    static_assert(!SPLIT_EPI || (SP2 && !ALIGN_EPI && !DUAL && !Epi::AFTER_DRAIN), "SPLIT_EPI geometry");
    if (!S.next(0, cur)) return;
    f32x4 acc[2][2][4][2];
#pragma unroll
    for (int a = 0; a < 2; ++a)
#pragma unroll
        for (int b = 0; b < 2; ++b)
#pragma unroll
            for (int m = 0; m < 4; ++m)
#pragma unroll
                for (int n = 0; n < 2; ++n) acc[a][b][m][n] = (f32x4){0.f, 0.f, 0.f, 0.f};
    bf16x8 At[4][2], B0[2][2], B1[2][2];
    const char* cA = (const char*)g.A + (size_t)cur.pm * tstep; const char* cB = (const char*)g.Bt + (size_t)cur.pn * tstep;
    const char* cA2 = DUAL ? (const char*)g.A2 + (size_t)cur.pm * tstep - (size_t)TS * kstep : cA; const char* cB2 = DUAL ? (const char*)g.Bt2 + (size_t)cur.pn * tstep - (size_t)TS * kstep : cB;
    S.a_ready(cur);
    if constexpr (SP2) {
        PG8_STAGE(PG8_SB(0, 0), cB, voffB); PG8_STAGE(PG8_SB(0, 1), cB + hstep, voffB); PG8_STAGE(PG8_SA(0, 0), cA, voffA); PG8_STAGE(PG8_SA(0, 1), cA + hstep, voffA);
        if (wr == 1) PG8_BAR;
        PG8_WAIT_V(2); PG8_BAR;
        PG8_STAGE(PG8_SB(1, 0), cB + kstep, voffB); PG8_STAGE(PG8_SA(1, 0), cA + kstep, voffA); PG8_STAGE(PG8_SB(1, 1), cB + hstep + kstep, voffB);
        PG8_WAIT_V(6); PG8_BAR;
    } else {
        PG8_STAGE(PG8_SB(0, 0), cB, voffB); PG8_STAGE(PG8_SA(0, 0), cA, voffA); PG8_STAGE(PG8_SB(0, 1), cB + hstep, voffB); PG8_STAGE(PG8_SA(0, 1), cA + hstep, voffA);
        if (wr == 1) PG8_BAR;
        PG8_WAIT_V(4); PG8_BAR;
        PG8_STAGE(PG8_SB(1, 0), cB + kstep, voffB); PG8_STAGE(PG8_SA(1, 0), cA + kstep, voffA); PG8_STAGE(PG8_SB(1, 1), cB + hstep + kstep, voffB);
        PG8_WAIT_V(6); PG8_BAR;
    }
    for (;;) {
        const bool has_next = S.next(ui + 1, nxt);
        const char* nA = has_next ? (const char*)g.A + (size_t)nxt.pm * tstep : cA; const char* nB = has_next ? (const char*)g.Bt + (size_t)nxt.pn * tstep : cB;
        const char* nA2 = (DUAL && has_next) ? (const char*)g.A2 + (size_t)nxt.pm * tstep - (size_t)TS * kstep : cA2; const char* nB2 = (DUAL && has_next) ? (const char*)g.Bt2 + (size_t)nxt.pn * tstep - (size_t)TS * kstep : cB2;
#pragma unroll
        for (int seg = 0; seg < (DUAL ? 2 : 1); ++seg) {
        if constexpr (DUAL) { if (seg == 1) E.mid(acc, cur, wr, wc, fr, fq); }
        for (int t = (seg ? TS : 0); t < ((DUAL && seg == 0) ? TS : nt); t += 2) {
            const bool last = (t == nt - 2);
            const char* a1 = ((DUAL && t + 1 >= TS) ? cA2 : cA) + (size_t)(t + 1) * kstep;
            const char* a2 = last ? nA : ((DUAL && t + 2 >= TS) ? cA2 : cA) + (size_t)(t + 2) * kstep; const char* b2 = last ? nB : ((DUAL && t + 2 >= TS) ? cB2 : cB) + (size_t)(t + 2) * kstep;
            const char* a3 = a2 + kstep; const char* b3 = b2 + kstep;
            if (last && has_next) S.a_ready(nxt);
            if constexpr (SP2) {
            PG8_LDB(B0, 0, 0); PG8_LDB(B1, 0, 1); PG8_SCHED; PG8_LDA(At, 0, 0); PG8_STAGE(PG8_SA(1, 1), a1 + hstep, voffA);
            PG8_WAIT_V(8); PG8_WAIT_L(0); PG8_BAR;
            if constexpr (SPLIT_EPI) { if (t == 0 && have_prev) { E.part(acc, prev, wr, wc, fr, fq, 1);
                _Pragma("unroll") for (int b_ = 0; b_ < 2; ++b_) _Pragma("unroll") for (int m_ = 0; m_ < 4; ++m_) _Pragma("unroll") for (int n_ = 0; n_ < 2; ++n_) acc[1][b_][m_][n_] = (f32x4){0.f, 0.f, 0.f, 0.f}; } }
            PG8_MMA(0, 0, At, B0); PG8_MMA(0, 1, At, B1); PG8_BAR; PG8_SCHED;
            PG8_LDA(At, 0, 1); PG8_STAGE(PG8_SB(0, 0), b2, voffB); PG8_STAGE(PG8_SB(0, 1), b2 + hstep, voffB); PG8_STAGE(PG8_SA(0, 0), a2, voffA);
            PG8_WAIT_V(8); PG8_WAIT_L(0); PG8_BAR; PG8_MMA(1, 0, At, B0); PG8_MMA(1, 1, At, B1); PG8_BAR; PG8_SCHED;
            PG8_LDB(B0, 1, 0); PG8_LDB(B1, 1, 1); PG8_SCHED; PG8_LDA(At, 1, 0); PG8_STAGE(PG8_SA(0, 1), a2 + hstep, voffA);
            PG8_WAIT_V(8); PG8_WAIT_L(0); PG8_BAR; PG8_MMA(0, 0, At, B0); PG8_MMA(0, 1, At, B1); PG8_BAR; PG8_SCHED;
            PG8_LDA(At, 1, 1); PG8_STAGE(PG8_SB(1, 0), b3, voffB); PG8_STAGE(PG8_SB(1, 1), b3 + hstep, voffB); PG8_STAGE(PG8_SA(1, 0), a3, voffA);
            PG8_WAIT_V(8); PG8_WAIT_L(0); PG8_BAR;
            if constexpr (SPLIT_EPI) { if (last) { E.part(acc, cur, wr, wc, fr, fq, 0);
                _Pragma("unroll") for (int b_ = 0; b_ < 2; ++b_) _Pragma("unroll") for (int m_ = 0; m_ < 4; ++m_) _Pragma("unroll") for (int n_ = 0; n_ < 2; ++n_) acc[0][b_][m_][n_] = (f32x4){0.f, 0.f, 0.f, 0.f}; } }
            PG8_MMA(1, 0, At, B0); PG8_MMA(1, 1, At, B1); PG8_BAR; PG8_SCHED;
            } else {
            PG8_LDB(B0, 0, 0); PG8_SCHED; PG8_LDA(At, 0, 0); PG8_STAGE(PG8_SA(1, 1), a1 + hstep, voffA);
            PG8_WAIT_L(8); PG8_BAR; PG8_WAIT_L(0); PG8_MMA(0, 0, At, B0); PG8_BAR; PG8_SCHED;
            PG8_LDB(B1, 0, 1); PG8_STAGE(PG8_SB(0, 0), b2, voffB);
            PG8_BAR; PG8_WAIT_L(0); PG8_MMA(0, 1, At, B1); PG8_BAR;
            PG8_LDA(At, 0, 1); PG8_STAGE(PG8_SA(0, 0), a2, voffA);
            PG8_BAR; PG8_WAIT_L(0); PG8_MMA(1, 0, At, B0); PG8_BAR; PG8_SCHED;
            PG8_STAGE(PG8_SB(0, 1), b2 + hstep, voffB);
            PG8_WAIT_V(6); PG8_BAR; PG8_MMA(1, 1, At, B1); PG8_BAR;
            PG8_LDB(B0, 1, 0); PG8_SCHED; PG8_LDA(At, 1, 0); PG8_STAGE(PG8_SA(0, 1), a2 + hstep, voffA);
            PG8_WAIT_L(8); PG8_BAR; PG8_WAIT_L(0); PG8_MMA(0, 0, At, B0); PG8_BAR; PG8_SCHED;
            PG8_LDB(B1, 1, 1); PG8_STAGE(PG8_SB(1, 0), b3, voffB);
            PG8_BAR; PG8_WAIT_L(0); PG8_MMA(0, 1, At, B1); PG8_BAR;
            PG8_LDA(At, 1, 1); PG8_STAGE(PG8_SA(1, 0), a3, voffA);
            PG8_BAR; PG8_WAIT_L(0); PG8_MMA(1, 0, At, B0); PG8_BAR; PG8_SCHED;
            PG8_STAGE(PG8_SB(1, 1), b3 + hstep, voffB);
            PG8_WAIT_V(6); PG8_BAR; PG8_MMA(1, 1, At, B1); PG8_BAR;
            }
        }
        }
        if constexpr (SPLIT_EPI) { prev = cur; have_prev = true; if (!has_next) break; cur = nxt; cA = nA; cB = nB; cA2 = nA2; cB2 = nB2; ++ui; continue; }
        if constexpr (ALIGN_EPI) { if (wr == 0) PG8_BAR; }
        if constexpr (!Epi::AFTER_DRAIN) { E(acc, cur, wr, wc, fr, fq); S.done(cur); }
        if constexpr (ALIGN_EPI && epi_has_post<Epi>::v) {
            if (E.need_post(cur)) { PG8_WAIT_V(0); PG8_WAIT_L(0); PG8_BAR; asm volatile("" ::: "memory"); E.post(cur, tid); } }
        if (!has_next) break;
#pragma unroll
        for (int a = 0; a < 2; ++a)
#pragma unroll
            for (int b = 0; b < 2; ++b)
#pragma unroll
                for (int m = 0; m < 4; ++m)
#pragma unroll
                    for (int n = 0; n < 2; ++n) acc[a][b][m][n] = (f32x4){0.f, 0.f, 0.f, 0.f};
        cur = nxt; cA = nA; cB = nB; cA2 = nA2; cB2 = nB2; ++ui;
        if constexpr (ALIGN_EPI) { if (wr == 1) PG8_BAR; }
    }
    PG8_WAIT_V(0);
    if constexpr (!ALIGN_EPI) { if (wr == 0) PG8_BAR; }
    PG8_BAR;
    if constexpr (Epi::AFTER_DRAIN) { E.fused(acc, cur, wr, wc, fr, fq, lds, wid, lane); S.done(cur); }
    if constexpr (SPLIT_EPI) { if (have_prev) E.part(acc, prev, wr, wc, fr, fq, 1); }
#undef PG8_SA
#undef PG8_SB
#undef PG8_STAGE
#undef PG8_LDA
#undef PG8_LDB
#undef PG8_MMA
#undef PG8_WAIT_V
#undef PG8_WAIT_L
#undef PG8_BAR
#undef PG8_SCHED
}
}
#define GAS __attribute__((address_space(1)))
#define LAS __attribute__((address_space(3)))
typedef unsigned short bf16;
typedef unsigned v4u __attribute__((ext_vector_type(4)));
typedef float f32x4 __attribute__((ext_vector_type(4)));
typedef short bf16x8 __attribute__((ext_vector_type(8)));
typedef GAS unsigned gu32;
typedef GAS unsigned long long gu64;
#define RLX_AGENT __ATOMIC_RELAXED, __HIP_MEMORY_SCOPE_AGENT
#define LDS_WAIT() asm volatile("s_waitcnt lgkmcnt(0)" ::: "memory")
#define VM_WAIT() asm volatile("s_waitcnt vmcnt(0)" ::: "memory")
__device__ __forceinline__ unsigned long long rt() { return __builtin_amdgcn_s_memrealtime(); }
__device__ __forceinline__ unsigned f2bf(float f) { unsigned u = __builtin_bit_cast(unsigned, f); return (u + 0x7fffu + ((u >> 16) & 1u)) >> 16; }
__device__ __forceinline__ unsigned pk2(float lo, float hi) { return f2bf(lo) | (f2bf(hi) << 16); }
constexpr int NWAVES = 8;
#ifndef GLA_MFMA
#define GLA_MFMA 1
#endif
#ifndef SWA_MFMA
#define SWA_MFMA 1
#endif
constexpr int BATCH = 8, SEQ = 4096, DM = 1024, M = BATCH * SEQ;
constexpr int NPROJ = 6656;
constexpr int DFF = 2816;
constexpr float EPS = 1e-6f;
constexpr size_t MiB = 1u << 20;
constexpr size_t WS_CTL = 0, CTL_ZERO_BYTES = 1 * MiB;
constexpr size_t WS_WIN = 1 * MiB;
constexpr size_t WS_WLR = 14 * MiB;
constexpr size_t WS_WG = 15 * MiB, WS_WS = 17 * MiB, WS_WOUT = 19 * MiB;
constexpr size_t WS_WFI = 21 * MiB;
constexpr size_t WS_WFO = 32 * MiB;
constexpr size_t WS_ROPE = 38 * MiB;
constexpr size_t WS_LR = 40 * MiB;
constexpr size_t WS_SSQ = 44 * MiB;
constexpr size_t WS_QG = 48 * MiB, WS_KG = 80 * MiB;
constexpr size_t WS_VG = 112 * MiB, WS_R = 176 * MiB, WS_SQ = 240 * MiB;
constexpr size_t WS_SK = 304 * MiB, WS_SV = 320 * MiB;
constexpr size_t WS_GA = 336 * MiB, WS_GB = 400 * MiB;
constexpr size_t WS_END = 464 * MiB;
constexpr size_t WS_DUMMY = 500 * MiB;
constexpr size_t WS_MERGED = WS_VG;
constexpr size_t WS_X1B = WS_QG;
constexpr size_t WS_H = WS_SQ;
static_assert(WS_H + (size_t)M * DFF * 2 <= WS_END, "h overlay");
constexpr int CW_TMO = 0, CW_CODE = 1;
constexpr int CW_BAR = 4096;
constexpr int RING_OFF = 0, RING_BYTES = 131072;
constexpr int LDS_BYTES = 163840;
constexpr int LDSCTL_OFF = LDS_BYTES - 1024, MISC_OFF = LDSCTL_OFF + 320;
static_assert(MISC_OFF + 128 <= LDS_BYTES, "LDS map");

#define XB_TMO      128
#define XB_XCNT(j)  (256  + 64 * (j))
#define XB_XSUB(j)  (1280 + 64 * (j))
#define XB_XGEN(j)  (2304 + 64 * (j))
#define XB_TOP      3328
#define XB_TOPGEN   3392
#define XCD_BAR_WORDS 3456
#define XB_SPIN_CAP (1u << 18)

__device__ __forceinline__ unsigned xb_ld(unsigned* p)              { return __hip_atomic_load(p, __ATOMIC_RELAXED, __HIP_MEMORY_SCOPE_AGENT); }
__device__ __forceinline__ unsigned xb_add(unsigned* p, unsigned v) { return __hip_atomic_fetch_add(p, v, __ATOMIC_RELAXED, __HIP_MEMORY_SCOPE_AGENT); }
__device__ __forceinline__ unsigned xb_xcc_id() { return (unsigned)__builtin_amdgcn_s_getreg((3 << 11) | 20) & 0xFu; }
#define XB_SPIN(cond, bar) do { unsigned _sp = 0; while (cond) { __builtin_amdgcn_s_sleep(1); \
    if ((++_sp & 255u) == 0u) { if (xb_ld(&(bar)[XB_TMO])) break; if (_sp > XB_SPIN_CAP) { atomicAdd(&(bar)[XB_TMO], 1u); break; } } } } while (0)

struct XcdBarrier {
    unsigned* bar; unsigned x;
    volatile LAS unsigned* st;
};

__device__ __forceinline__ XcdBarrier xcd_barrier_post(unsigned* bar, volatile LAS unsigned* st) {
    XcdBarrier b; b.bar = bar; b.x = xb_xcc_id(); b.st = st;
    if (threadIdx.x == 0) (void)xb_add(&bar[XB_XCNT(b.x)], 1u);
    return b;
}
__device__ __forceinline__ void xcd_barrier_complete(unsigned* bar, unsigned x, unsigned& nloc, unsigned& nx) {
    const unsigned G = gridDim.x * gridDim.y * gridDim.z;
    unsigned sum, cnt, mine, sp = 0u;
    for (;;) {
        sum = 0u; cnt = 0u; mine = 0u;
#pragma unroll
        for (unsigned j = 0; j < 16; ++j) { const unsigned c = xb_ld(&bar[XB_XCNT(j)]); sum += c; cnt += (c > 0u) ? 1u : 0u; mine = (j == x) ? c : mine; }
        if (sum == G) break;
        __builtin_amdgcn_s_sleep(1);
        if ((++sp & 255u) == 0u) { if (xb_ld(&bar[XB_TMO])) break; if (sp > XB_SPIN_CAP) { atomicAdd(&bar[XB_TMO], 1u); break; } }
    }
    nloc = mine > 0u ? mine : 1u; nx = cnt > 0u ? cnt : 1u;
}

__device__ __forceinline__ void xcd_barrier(const XcdBarrier& b) {
    asm volatile("s_waitcnt vmcnt(0)" ::: "memory");
    __syncthreads();
    if (threadIdx.x == 0) {
        unsigned* bar = b.bar;
        __builtin_amdgcn_s_waitcnt(0);
        unsigned nloc = b.st[0], nx = b.st[1];
        if (nloc == 0u) { xcd_barrier_complete(bar, b.x, nloc, nx); b.st[0] = nloc; b.st[1] = nx; }
        const unsigned old = xb_add(&bar[XB_XSUB(b.x)], 1u);
        const unsigned gen = old / nloc;
        if (old + 1u == (gen + 1u) * nloc) {
            __builtin_amdgcn_fence(__ATOMIC_RELEASE, "agent");
            asm volatile("s_waitcnt vmcnt(0)" ::: "memory");
            const unsigned og = xb_add(&bar[XB_TOP], 1u);
            const unsigned tg = og / nx;
            if (og + 1u == (tg + 1u) * nx) xb_add(&bar[XB_TOPGEN], 1u);
            else XB_SPIN(xb_ld(&bar[XB_TOPGEN]) == tg, bar);
            __builtin_amdgcn_fence(__ATOMIC_ACQUIRE, "agent");
            xb_add(&bar[XB_XGEN(b.x)], 1u);
            asm volatile("s_waitcnt vmcnt(0)" ::: "memory");
        } else {
            XB_SPIN(xb_ld(&bar[XB_XGEN(b.x)]) == gen, bar);
            __builtin_amdgcn_fence(__ATOMIC_ACQUIRE, "agent");
            asm volatile("s_waitcnt vmcnt(0)" ::: "memory");
        }
    }
    __syncthreads();
}

typedef unsigned u32x2 __attribute__((ext_vector_type(2)));
__device__ __forceinline__ const float* inp(int i) { const float* const* ka = (const float* const*)__builtin_amdgcn_kernarg_segment_ptr(); asm volatile("" : "+s"(ka)); return ka[i]; }
enum { I_X = 0, I_GMIX, I_WIN, I_UPF, I_BIASF, I_UPB, I_BIASB, I_GGLA, I_WOG, I_GQ, I_GK, I_SINKS, I_WOS, I_WOUT, I_GFFN, I_WFI, I_WFO };
struct Frame {
    LAS unsigned char* lds;
    volatile LAS unsigned* MISC;
    gu32* ctl;
    unsigned char* ws; float* out;
    int tid, lane, wave;
    int vcu, G;
#define WSPTR(name, T, off) __device__ __forceinline__ T* name() const { return (T*)(ws + (off)); }
    WSPTR(WIN, bf16, WS_WIN) WSPTR(WLR, bf16, WS_WLR) WSPTR(WG, bf16, WS_WG) WSPTR(WS_, bf16, WS_WS) WSPTR(WOUT, bf16, WS_WOUT) WSPTR(WFI, bf16, WS_WFI) WSPTR(WFO, bf16, WS_WFO)
    WSPTR(ROPE, float, WS_ROPE) WSPTR(LR, float, WS_LR) WSPTR(SSQ, float, WS_SSQ)
    WSPTR(QG, bf16, WS_QG) WSPTR(KG, bf16, WS_KG) WSPTR(VG, bf16, WS_VG) WSPTR(R, bf16, WS_R) WSPTR(SQ, bf16, WS_SQ) WSPTR(SK, bf16, WS_SK) WSPTR(SV, bf16, WS_SV)
    WSPTR(GA, bf16, WS_GA) WSPTR(GB, bf16, WS_GB) WSPTR(MERGED, bf16, WS_MERGED) WSPTR(X1B, bf16, WS_X1B) WSPTR(H, bf16, WS_H)
#undef WSPTR
    __device__ __forceinline__ bf16* XN() const { return (bf16*)out; }
    __device__ __forceinline__ bf16* OF() const { return (bf16*)out; }
    __device__ __forceinline__ bf16* OB() const { return (bf16*)out + (size_t)M * DM; }
};
__device__ __forceinline__ float wave_sum(float v) {
#pragma unroll
    for (int o = 1; o < 64; o <<= 1) v += __shfl_xor(v, o);
    return v;
}
__device__ __forceinline__ float wave_max(float v) {
#pragma unroll
    for (int o = 1; o < 64; o <<= 1) v = fmaxf(v, __shfl_xor(v, o));
    return v;
}
__device__ __forceinline__ float bflo(unsigned w) { return __uint_as_float(w << 16); }
__device__ __forceinline__ float bfhi(unsigned w) { return __uint_as_float(w & 0xffff0000u); }
__device__ __forceinline__ float bf1(bf16 b) { return __uint_as_float((unsigned)b << 16); }

__device__ __forceinline__ void p0_item(const float* W, int ldw, int K, int scol0, bf16* WT, int drow0, int k0, const float* gain, LAS float* scr, int lane) {
    float wv[32];
#pragma unroll
    for (int i = 0; i < 32; ++i) wv[i] = W[(size_t)(k0 + 2 * i + (lane >> 5)) * ldw + scol0 + (lane & 31)];
#pragma unroll
    for (int i = 0; i < 32; ++i) { const int kk = 2 * i + (lane >> 5); float v = wv[i]; if (gain) v *= gain[k0 + kk]; scr[kk * 33 + (lane & 31)] = v; }
    LDS_WAIT(); asm volatile("" ::: "memory");
    const int c = lane & 7;
#pragma unroll
    for (int j = 0; j < 4; ++j) { const int n = (lane >> 3) + 8 * j; const LAS float* s = scr + (8 * c) * 33 + n;
        v4u o; o.x = pk2(s[0 * 33], s[1 * 33]); o.y = pk2(s[2 * 33], s[3 * 33]); o.z = pk2(s[4 * 33], s[5 * 33]); o.w = pk2(s[6 * 33], s[7 * 33]);
        *(GAS v4u*)(WT + (size_t)(drow0 + n) * K + k0 + 8 * c) = o; }
    LDS_WAIT(); asm volatile("" ::: "memory");
}
__device__ __forceinline__ void sincos_d(double a, float& c, float& s) {
    const double n = __builtin_rint(a * 0.6366197723675814);
    double r = __builtin_fma(-n, 1.5707963267948966, a); r = __builtin_fma(-n, 6.123233995736766e-17, r);
    const double r2 = r * r;
    double sp = -1.0 / 1307674368000.0;
    sp = sp * r2 + 1.0 / 6227020800.0; sp = sp * r2 - 1.0 / 39916800.0; sp = sp * r2 + 1.0 / 362880.0; sp = sp * r2 - 1.0 / 5040.0; sp = sp * r2 + 1.0 / 120.0; sp = sp * r2 - 1.0 / 6.0; sp = sp * r2 * r + r;
    double cp = 1.0 / 20922789888000.0;
    cp = cp * r2 - 1.0 / 87178291200.0; cp = cp * r2 + 1.0 / 479001600.0; cp = cp * r2 - 1.0 / 3628800.0; cp = cp * r2 + 1.0 / 40320.0; cp = cp * r2 - 1.0 / 720.0; cp = cp * r2 + 1.0 / 24.0; cp = cp * r2 - 0.5; cp = cp * r2 + 1.0;
    const int q = (int)n & 3;
    const double sv = (q == 0) ? sp : (q == 1) ? cp : (q == 2) ? -sp : -cp;
    const double cv = (q == 0) ? cp : (q == 1) ? -sp : (q == 2) ? -cp : sp;
    c = (float)cv; s = (float)sv;
}
__device__ __forceinline__ void p0_prologue(Frame& F) {
    LAS float* scr = (LAS float*)(F.lds + RING_OFF + F.wave * 8448);
    LAS unsigned char* wlr = F.lds + RING_OFF + 8 * 8448;
    const int gw = F.vcu * NWAVES + F.wave, NGW = F.G * NWAVES;
    {
        const float* wsrc = inp(I_WIN) + (size_t)(2 * F.tid) * 6688 + 3072;
        f32x4 w0[8], w1[8];
#pragma unroll
        for (int j = 0; j < 8; ++j) { w0[j] = *(const f32x4*)(wsrc + 4 * j); w1[j] = *(const f32x4*)(wsrc + 6688 + 4 * j); }
#pragma unroll
        for (int n = 0; n < 32; ++n) { const int fF = ((n & 3) << 2) | ((n >> 2) & 3);
            *(LAS unsigned*)(wlr + 2048 * n + 16 * ((F.tid >> 2) ^ fF) + 4 * (F.tid & 3)) = pk2(w0[n >> 2][n & 3], w1[n >> 2][n & 3]); }
        __syncthreads();
    }
    constexpr int I_IN = 16 * 208, I_LR = 16, I_SQ = 16 * 32, I_FI = 16 * 176, I_FO = 44 * 32;
    constexpr int NITEMS = I_IN + I_LR + 3 * I_SQ + I_FI + I_FO;
    for (int it = gw; it < NITEMS; it += NGW) {
        int r = it;
        if (r < I_IN) { const int kb = r / 208, nb = r % 208, dn0 = 32 * nb, sc0 = dn0 + (dn0 >= 3072 ? 32 : 0); p0_item(inp(I_WIN), 6688, 1024, sc0, F.WIN(), dn0, 64 * kb, nullptr, scr, F.lane); continue; } r -= I_IN;
        if (r < I_LR) { p0_item(inp(I_WIN), 6688, 1024, 3072, F.WLR(), 0, 64 * r, nullptr, scr, F.lane); continue; } r -= I_LR;
        if (r < I_SQ) { p0_item(inp(I_WOG), 1024, 1024, 32 * (r % 32), F.WG(), 32 * (r % 32), 64 * (r / 32), nullptr, scr, F.lane); continue; } r -= I_SQ;
        if (r < I_SQ) { p0_item(inp(I_WOS), 1024, 1024, 32 * (r % 32), F.WS_(), 32 * (r % 32), 64 * (r / 32), nullptr, scr, F.lane); continue; } r -= I_SQ;
        if (r < I_SQ) { p0_item(inp(I_WOUT), 1024, 1024, 32 * (r % 32), F.WOUT(), 32 * (r % 32), 64 * (r / 32), nullptr, scr, F.lane); continue; } r -= I_SQ;
        if (r < I_FI) { const int kb = r / 176, nb = r % 176, dn0 = 32 * nb, tj = dn0 >> 8, wi = dn0 & 255, sc0 = (wi < 128) ? (128 * tj + wi) : (DFF + 128 * tj + (wi - 128));
            p0_item(inp(I_WFI), 2 * DFF, 1024, sc0, F.WFI(), dn0, 64 * kb, inp(I_GFFN), scr, F.lane); continue; } r -= I_FI;
        p0_item(inp(I_WFO), 1024, DFF, 32 * (r % 32), F.WFO(), 32 * (r % 32), 64 * (r / 32), nullptr, scr, F.lane);
    }
    {
        const float* xin = inp(I_X); const float* gmix = inp(I_GMIX); bf16* XNp = F.XN(); bf16* LRp = (bf16*)F.LR();
        f32x4 gm[4];
#pragma unroll
        for (int j = 0; j < 4; ++j) gm[j] = *((const f32x4*)gmix + F.lane + 64 * j);
        for (int g = gw; g < M / 16; g += NGW) {
            for (int it = 0; it < 4; ++it) {
                const int m0 = 16 * g + 4 * it;
                f32x4 v[4][4];
#pragma unroll
                for (int u = 0; u < 4; ++u) { const GAS f32x4* xr = (const GAS f32x4*)(xin + (size_t)(m0 + u) * DM) + F.lane;
#pragma unroll
                    for (int j = 0; j < 4; ++j) v[u][j] = xr[64 * j]; }
#pragma unroll
                for (int u = 0; u < 4; ++u) { float s = 0.f;
#pragma unroll
                    for (int j = 0; j < 4; ++j) s += (v[u][j].x * v[u][j].x + v[u][j].y * v[u][j].y) + (v[u][j].z * v[u][j].z + v[u][j].w * v[u][j].w);
                    const float rstd = 1.0f / sqrtf(wave_sum(s) * (1.f / DM) + EPS);
                    GAS unsigned long long* o8 = (GAS unsigned long long*)(XNp + (size_t)(m0 + u) * DM) + F.lane;
#pragma unroll
                    for (int j = 0; j < 4; ++j) o8[64 * j] = (unsigned long long)pk2(v[u][j].x * rstd * gm[j].x, v[u][j].y * rstd * gm[j].y) | ((unsigned long long)pk2(v[u][j].z * rstd * gm[j].z, v[u][j].w * rstd * gm[j].w) << 32); }
            }
            asm volatile("s_waitcnt vmcnt(0)" ::: "memory");
            int ln = F.lane; asm volatile("" : "+v"(ln));
            const int fr = ln & 15, fq = ln >> 4, fF = ((fr & 3) << 2) | ((fr >> 2) & 3);
            const bf16* ap = XNp + (size_t)(16 * g + fr) * DM + 8 * fq;
            const unsigned aB = (unsigned)(2048 * fr + 16 * (fq ^ fF));
            f32x4 a0 = {0.f, 0.f, 0.f, 0.f}, a1 = {0.f, 0.f, 0.f, 0.f};
#pragma unroll
            for (int hb = 0; hb < 2; ++hb) {
                bf16x8 af[16];
#pragma unroll
                for (int kk = 0; kk < 16; ++kk) af[kk] = *(const bf16x8*)(ap + 32 * (16 * hb + kk));
#pragma unroll
                for (int kk = 0; kk < 16; ++kk) { const int k2 = 16 * hb + kk;
                    const bf16x8 b0 = *(const LAS bf16x8*)(wlr + (aB ^ ((k2 & 3) << 6)) + 256 * (k2 >> 2)), b1 = *(const LAS bf16x8*)(wlr + (aB ^ ((k2 & 3) << 6)) + 256 * (k2 >> 2) + 32768);
                    a0 = __builtin_amdgcn_mfma_f32_16x16x32_bf16(b0, af[kk], a0, 0, 0, 0); a1 = __builtin_amdgcn_mfma_f32_16x16x32_bf16(b1, af[kk], a1, 0, 0, 0);
                    if ((kk & 3) == 3) __builtin_amdgcn_sched_barrier(0); }
            }
            { u32x2 w0, w1; w0.x = pk2(a0[0], a0[1]); w0.y = pk2(a0[2], a0[3]); w1.x = pk2(a1[0], a1[1]); w1.y = pk2(a1[2], a1[3]);
              bf16* o = LRp + (size_t)(16 * g + fr) * 32 + 4 * fq; *(u32x2*)o = w0; *(u32x2*)(o + 16) = w1; }
        }
    }
    float* ROPEp = F.ROPE();
    for (int idx = (F.vcu * NWAVES + F.wave) * 64 + F.lane; idx < SEQ * 64; idx += NGW * 64) {
        const int i = idx & 63, pos = idx >> 6; double f = 1.0;
        for (int k = 0; k < i; ++k) f *= 0.8659643233600653;
        float c, s; sincos_d((double)pos * f, c, s);
        ROPEp[2 * idx] = c; ROPEp[2 * idx + 1] = s;
    }
}
__device__ __forceinline__ void p1_lr(Frame& F) {
    const int gw = F.vcu * NWAVES + F.wave, NGW = F.G * NWAVES, fr = F.lane & 15, fq = F.lane >> 4;
    const bf16* XNp = F.XN(); const bf16* WLRp = F.WLR(); bf16* LRp = (bf16*)F.LR();
    for (int g = gw; g < M / 16; g += NGW) {
        const bf16* ap = XNp + (size_t)(16 * g + fr) * DM + 8 * fq; const bf16* b0p = WLRp + (size_t)fr * DM + 8 * fq; const bf16* b1p = b0p + 16 * DM;
        f32x4 a0 = {0.f, 0.f, 0.f, 0.f}, a1 = {0.f, 0.f, 0.f, 0.f};
#pragma unroll 4
        for (int kk = 0; kk < 32; ++kk) { const bf16x8 a = *(const bf16x8*)(ap + 32 * kk), b0 = *(const bf16x8*)(b0p + 32 * kk), b1 = *(const bf16x8*)(b1p + 32 * kk);
            a0 = __builtin_amdgcn_mfma_f32_16x16x32_bf16(a, b0, a0, 0, 0, 0); a1 = __builtin_amdgcn_mfma_f32_16x16x32_bf16(a, b1, a1, 0, 0, 0); }
#pragma unroll
        for (int i = 0; i < 4; ++i) { bf16* o = LRp + (size_t)(16 * g + 4 * fq + i) * 32 + fr; o[0] = (bf16)f2bf(a0[i]); o[16] = (bf16)f2bf(a1[i]); }
    }
}
__device__ __forceinline__ void p1b_qknorm_rope(Frame& F, int dummy = 0) {
    const int gw = F.vcu * NWAVES + F.wave, NGW = F.G * NWAVES, lane = F.lane, slot = lane >> 3, c = lane & 7;
    constexpr int NGRP = M * 10 / 8;
    bf16* SQp = F.SQ(); bf16* SKp = F.SK(); const float* ROPEp = F.ROPE(); const float* gqp = inp(I_GQ); const float* gkp = inp(I_GK);
    for (int g0 = gw; g0 < NGRP; g0 += 4 * NGW) {
        v4u a1[4], a2[4]; f32x4 cs[4][4];
#pragma unroll
        for (int u = 0; u < 4; ++u) { const int g = g0 + u * NGW, idx = (g < NGRP ? g : g0) * 8 + slot, row = idx / 10, hh = idx - row * 10, pos = row & (SEQ - 1);
            const bf16* p = (hh < 8) ? SQp + (size_t)row * 1024 + hh * 128 : SKp + (size_t)row * 256 + (hh - 8) * 128;
            a1[u] = *(const v4u*)(p + 8 * c); a2[u] = *(const v4u*)(p + 64 + 8 * c);
            const f32x4* rp = (const f32x4*)(ROPEp + 2 * (pos * 64 + 8 * c));
#pragma unroll
            for (int j = 0; j < 4; ++j) cs[u][j] = rp[j]; }
#pragma unroll
        for (int u = 0; u < 4; ++u) { const int g = g0 + u * NGW, idx = (g < NGRP ? g : g0) * 8 + slot, row = idx / 10, hh = idx - row * 10;
            bf16* p = (hh < 8) ? SQp + (size_t)row * 1024 + hh * 128 : SKp + (size_t)row * 256 + (hh - 8) * 128;
            const float* gn = (hh < 8) ? gqp : gkp; const float sc = (hh < 8) ? (SWA_MFMA ? 0.08838834764831845f * 1.4426950408889634f : 0.08838834764831845f) : 1.f;
            float x1[8], x2[8];
            x1[0] = bflo(a1[u].x); x1[1] = bfhi(a1[u].x); x1[2] = bflo(a1[u].y); x1[3] = bfhi(a1[u].y); x1[4] = bflo(a1[u].z); x1[5] = bfhi(a1[u].z); x1[6] = bflo(a1[u].w); x1[7] = bfhi(a1[u].w);
            x2[0] = bflo(a2[u].x); x2[1] = bfhi(a2[u].x); x2[2] = bflo(a2[u].y); x2[3] = bfhi(a2[u].y); x2[4] = bflo(a2[u].z); x2[5] = bfhi(a2[u].z); x2[6] = bflo(a2[u].w); x2[7] = bfhi(a2[u].w);
            float ss = 0.f;
#pragma unroll
            for (int e = 0; e < 8; ++e) ss += x1[e] * x1[e] + x2[e] * x2[e];
            ss += __shfl_xor(ss, 1); ss += __shfl_xor(ss, 2); ss += __shfl_xor(ss, 4);
            const float rstd = sc / sqrtf(ss * (1.f / 128.f) + EPS);
            const f32x4 g10 = *(const f32x4*)(gn + 8 * c), g11 = *(const f32x4*)(gn + 8 * c + 4), g20 = *(const f32x4*)(gn + 64 + 8 * c), g21 = *(const f32x4*)(gn + 64 + 8 * c + 4);
            float o1[8], o2[8];
#pragma unroll
            for (int e = 0; e < 8; ++e) { const float y1 = x1[e] * rstd * (e < 4 ? g10[e & 3] : g11[e & 3]), y2 = x2[e] * rstd * (e < 4 ? g20[e & 3] : g21[e & 3]);
                const float cc = cs[u][e >> 1][2 * (e & 1)], sn = cs[u][e >> 1][2 * (e & 1) + 1]; o1[e] = y1 * cc - y2 * sn; o2[e] = y2 * cc + y1 * sn; }
            if (g < NGRP) { v4u w1, w2; w1.x = pk2(o1[0], o1[1]); w1.y = pk2(o1[2], o1[3]); w1.z = pk2(o1[4], o1[5]); w1.w = pk2(o1[6], o1[7]); w2.x = pk2(o2[0], o2[1]); w2.y = pk2(o2[2], o2[3]); w2.z = pk2(o2[4], o2[5]); w2.w = pk2(o2[6], o2[7]);
                bf16* po = dummy ? (bf16*)(F.ws + WS_DUMMY) + (size_t)(idx & 8191) * 128 : p; *(v4u*)(po + 8 * c) = w1; *(v4u*)(po + 64 + 8 * c) = w2; } }
    }
}
#if 0
__device__ __forceinline__ float logsig(float z) { return fminf(z, 0.f) - log1pf(expf(-fabsf(z))); }
__device__ __forceinline__ void gla_naive(Frame& F) {
    if (F.vcu >= 64) return;
    const int b = F.vcu >> 3, h = (F.vcu >> 1) & 3, dir = F.vcu & 1;
    LAS float* Gs = (LAS float*)(F.lds + RING_OFF); LAS float* Qs = Gs + 2048; LAS float* Ks = Qs + 2048;
    const float* up = dir ? F.up_b : F.up_f; const float* bias = dir ? F.bias_b : F.bias_f;
    const int tt = F.tid >> 5, d0 = (F.tid & 31) * 4;
    const int col = 32 * F.wave + (F.lane & 31), hf = F.lane >> 5;
    bf16* O = dir ? F.OB : F.OF;
    float S[64];
#pragma unroll
    for (int i = 0; i < 64; ++i) S[i] = 0.f;
    for (int tile = 0; tile < SEQ / 16; ++tile) {
        {
            const int i = tile * 16 + tt, t = dir ? (SEQ - 1 - i) : i; const size_t row = (size_t)b * SEQ + t;
            const f32x4* lrp = (const f32x4*)(F.LR + row * 32 + dir * 16);
            f32x4 z = *(const f32x4*)(bias + h * 128 + d0);
#pragma unroll
            for (int r4 = 0; r4 < 4; ++r4) { const f32x4 l = lrp[r4];
#pragma unroll
                for (int e = 0; e < 4; ++e) { const f32x4 u = *(const f32x4*)(up + (size_t)(4 * r4 + e) * 512 + h * 128 + d0); z += u * l[e]; } }
            f32x4 g;
#pragma unroll
            for (int e = 0; e < 4; ++e) g[e] = expf(fmaxf(logsig(z[e]) * (1.f / 16.f), -0.5f));
            const u32x2 qw = *(const u32x2*)(F.QG + row * 512 + h * 128 + d0), kw = *(const u32x2*)(F.KG + row * 512 + h * 128 + d0);
            *(LAS f32x4*)(Gs + tt * 128 + d0) = g;
            *(LAS f32x4*)(Qs + tt * 128 + d0) = (f32x4){bflo(qw.x), bfhi(qw.x), bflo(qw.y), bfhi(qw.y)};
            *(LAS f32x4*)(Ks + tt * 128 + d0) = (f32x4){bflo(kw.x), bfhi(kw.x), bflo(kw.y), bfhi(kw.y)};
        }
        __syncthreads();
        for (int t2 = 0; t2 < 16; ++t2) {
            const int i = tile * 16 + t2, t = dir ? (SEQ - 1 - i) : i; const size_t row = (size_t)b * SEQ + t;
            const float v = bf1(F.VG[row * 1024 + h * 256 + col]);
            float o = 0.f;
#pragma unroll
            for (int dd = 0; dd < 64; dd += 4) {
                const f32x4 g4 = *(const LAS f32x4*)(Gs + t2 * 128 + 64 * hf + dd), q4 = *(const LAS f32x4*)(Qs + t2 * 128 + 64 * hf + dd), k4 = *(const LAS f32x4*)(Ks + t2 * 128 + 64 * hf + dd);
#pragma unroll
                for (int e = 0; e < 4; ++e) { float s = S[dd + e] * g4[e];
                    if (dir == 0) { s = fmaf(k4[e], v, s); o = fmaf(q4[e], s, o); } else { o = fmaf(q4[e], s, o); s = fmaf(k4[e], v, s); }
                    S[dd + e] = s; }
            }
            o += __shfl_xor(o, 32);
            if (hf == 0) O[row * 1024 + h * 256 + col] = (bf16)f2bf(o);
        }
        __syncthreads();
    }
}
__device__ __forceinline__ void swa_naive(Frame& F) {
    LAS float* qs = (LAS float*)(F.lds + RING_OFF + 32768) + F.wave * 512; LAS float* ps = qs + 128;
    const int gw = F.vcu * NWAVES + F.wave, NGW = F.G * NWAVES, lane = F.lane;
    const int per = (BATCH * 8 * SEQ) / NGW;
    for (int j = 0; j < per; ++j) {
        const int it = gw * per + j, bh = it >> 12, i = it & (SEQ - 1), b = bh >> 3, hd = bh & 7, kvh = hd >> 2;
        const size_t rowb = (size_t)b * SEQ;
        bf16* qp = F.SQ + (rowb + i) * 1024 + hd * 128;
        { const unsigned w = *(const unsigned*)(qp + 2 * lane); qs[2 * lane] = bflo(w); qs[2 * lane + 1] = bfhi(w); }
        LDS_WAIT(); asm volatile("" ::: "memory");
        const int jlo = (i - 128 > 0) ? i - 128 : 0, jhi = (i + 128 < SEQ - 1) ? i + 128 : SEQ - 1;
        float s[5];
#pragma unroll
        for (int c = 0; c < 5; ++c) { const int jj = jlo + lane + 64 * c; const bool valid = jj <= jhi;
            const bf16* kp = F.SK + (rowb + (valid ? jj : jhi)) * 256 + kvh * 128; float a = 0.f;
#pragma unroll 4
            for (int ch = 0; ch < 16; ++ch) { const v4u w = *(const v4u*)(kp + 8 * ch); const f32x4 qa = *(const LAS f32x4*)(qs + 8 * ch), qb = *(const LAS f32x4*)(qs + 8 * ch + 4);
                a += (bflo(w.x) * qa[0] + bfhi(w.x) * qa[1]) + (bflo(w.y) * qa[2] + bfhi(w.y) * qa[3]) + (bflo(w.z) * qb[0] + bfhi(w.z) * qb[1]) + (bflo(w.w) * qb[2] + bfhi(w.w) * qb[3]); }
            s[c] = valid ? a : -INFINITY; }
        const float sink = F.sinks[hd];
        float mx = fmaxf(fmaxf(fmaxf(s[0], s[1]), fmaxf(s[2], s[3])), s[4]); mx = fmaxf(wave_max(mx), sink);
        float sum = 0.f;
#pragma unroll
        for (int c = 0; c < 5; ++c) { const float p = expf(s[c] - mx); ps[lane + 64 * c] = p; sum += p; }
        sum = wave_sum(sum) + expf(sink - mx);
        LDS_WAIT(); asm volatile("" ::: "memory");
        const int n = jhi - jlo + 1; float o0 = 0.f, o1 = 0.f;
        const bf16* vp = F.SV + (rowb + jlo) * 256 + kvh * 128 + 2 * lane;
        for (int jj = 0; jj < n; ++jj) { const float p = ps[jj]; const unsigned w = *(const unsigned*)(vp + (size_t)jj * 256); o0 = fmaf(p, bflo(w), o0); o1 = fmaf(p, bfhi(w), o1); }
        const float inv = 1.0f / sum;
        *(unsigned*)(qp + 2 * lane) = pk2(o0 * inv, o1 * inv);
        asm volatile("" ::: "memory");
    }
}
#endif
__device__ __forceinline__ void p2c_combine(Frame& F, int dummy = 0) {
    const int gw = F.vcu * NWAVES + F.wave, NGW = F.G * NWAVES, lane = F.lane, l32 = lane & 31;
    const float* ggla = inp(I_GGLA); bf16* Rp = F.R();
    const bf16* OFp = F.OF(); const bf16* OBp = F.OB();
    const f32x4 ga = *((const f32x4*)ggla + 2 * l32), gb = *((const f32x4*)ggla + 2 * l32 + 1);
    constexpr int NGRP = M * 4 / 2;
    for (int g0 = gw; g0 < NGRP; g0 += 4 * NGW) {
        v4u a[4], b2[4], r4[4];
#pragma unroll
        for (int u = 0; u < 4; ++u) { const int g = g0 + u * NGW, idx = (g < NGRP ? g : g0) * 2 + (lane >> 5); const size_t so = (size_t)idx * 256 + 8 * l32;
            a[u] = *(const v4u*)(OFp + so); b2[u] = *(const v4u*)(OBp + so); r4[u] = *(const v4u*)(Rp + so); }
#pragma unroll
        for (int u = 0; u < 4; ++u) { const int g = g0 + u * NGW; const size_t off = (size_t)((g < NGRP ? g : g0) * 2 + (lane >> 5)) * 256 + 8 * l32;
            float o[8], r[8];
            o[0] = bflo(a[u].x) + bflo(b2[u].x); o[1] = bfhi(a[u].x) + bfhi(b2[u].x); o[2] = bflo(a[u].y) + bflo(b2[u].y); o[3] = bfhi(a[u].y) + bfhi(b2[u].y);
            o[4] = bflo(a[u].z) + bflo(b2[u].z); o[5] = bfhi(a[u].z) + bfhi(b2[u].z); o[6] = bflo(a[u].w) + bflo(b2[u].w); o[7] = bfhi(a[u].w) + bfhi(b2[u].w);
            r[0] = bflo(r4[u].x); r[1] = bfhi(r4[u].x); r[2] = bflo(r4[u].y); r[3] = bfhi(r4[u].y); r[4] = bflo(r4[u].z); r[5] = bfhi(r4[u].z); r[6] = bflo(r4[u].w); r[7] = bfhi(r4[u].w);
            float ss = 0.f;
#pragma unroll
            for (int e = 0; e < 8; ++e) ss += o[e] * o[e];
            ss += __shfl_xor(ss, 1); ss += __shfl_xor(ss, 2); ss += __shfl_xor(ss, 4); ss += __shfl_xor(ss, 8); ss += __shfl_xor(ss, 16);
            const float rstd = 1.0f / sqrtf(ss * (1.f / 256.f) + EPS);
            float y[8];
#pragma unroll
            for (int e = 0; e < 8; ++e) y[e] = o[e] * rstd * (e < 4 ? ga[e & 3] : gb[e & 3]) * r[e] / (1.f + __expf(-r[e]));
            if (g < NGRP) { v4u w; w.x = pk2(y[0], y[1]); w.y = pk2(y[2], y[3]); w.z = pk2(y[4], y[5]); w.w = pk2(y[6], y[7]); *(v4u*)((dummy ? (bf16*)(F.ws + WS_DUMMY) + (off & 0xfffff) : Rp + off)) = w; } }
    }
}

typedef float f32x16 __attribute__((ext_vector_type(16)));
typedef short s16x4 __attribute__((ext_vector_type(4)));
typedef float f32x2_t __attribute__((ext_vector_type(2))); typedef __bf16 bf16x2_t __attribute__((ext_vector_type(2)));
__device__ __forceinline__ unsigned cvtpk(float lo, float hi) { f32x2_t v = {lo, hi}; bf16x2_t b = __builtin_convertvector(v, bf16x2_t); return __builtin_bit_cast(unsigned, b); }
__device__ __forceinline__ bf16x8 pack_step(const f32x16& x, int s) { v4u p; p.x = cvtpk(x[8 * s], x[8 * s + 1]); p.y = cvtpk(x[8 * s + 2], x[8 * s + 3]); p.z = cvtpk(x[8 * s + 4], x[8 * s + 5]); p.w = cvtpk(x[8 * s + 6], x[8 * s + 7]); return __builtin_bit_cast(bf16x8, p); }
__device__ __forceinline__ int qk_off(int row, int ch) { return 256 * row + 16 * (ch ^ (((row & 3) << 2) | ((row >> 2) & 3))); }
__device__ __forceinline__ int v_off(int tok, int ch) { return 512 * tok + 16 * (ch ^ ((tok & 3) << 2)); }
__device__ __forceinline__ int p_off(int row, int ch) { return 128 * row + 16 * (ch ^ ((row >> 1) & 7)); }
typedef short v4i16_t __attribute__((ext_vector_type(4)));
__device__ __forceinline__ s16x4 tr_rd(LAS const unsigned char* p) { return __builtin_bit_cast(s16x4, __builtin_amdgcn_ds_read_tr16_b64_v4i16((LAS v4i16_t*)p)); }
#define MFMA32(a, b, c) __builtin_amdgcn_mfma_f32_32x32x16_bf16((a), (b), (c), 0, 0, 0)
#define MFMA16(a, b, c) __builtin_amdgcn_mfma_f32_16x16x32_bf16((a), (b), (c), 0, 0, 0)
constexpr int GL_QKSZ = 32768, GL_KI = 16384, GL_V0 = 65536, GL_VSZ = 32768, GL_P = 131072, GL_DEC = 139264;
constexpr int GL_OST = 140800, GL_OSTW = 2560;
constexpr int GLA_LDS_END = GL_OST + 8 * GL_OSTW;
constexpr int GL_DSEG = GLA_LDS_END;
constexpr int GL_NSEG = 4, GL_SEGC = 64 / GL_NSEG;
__device__ __forceinline__ void glds16(const void* gsrc, unsigned lds_dst) { unsigned keep;
    asm volatile("s_mov_b32 %0, m0\n\ts_mov_b32 m0, %2\n\ts_nop 0\n\tglobal_load_lds_dwordx4 %1, off\n\ts_mov_b32 m0, %0" : "=&s"(keep) : "v"(gsrc), "s"(lds_dst) : "memory"); }

__device__ __forceinline__ void ldg8_nc(u32x2& d, const void* p) { asm volatile("global_load_dwordx2 %0, %1, off" : "=v"(d) : "v"(p) : "memory"); }
__device__ __forceinline__ void ldg16_nc(v4u& d, const void* p) { asm volatile("global_load_dwordx4 %0, %1, off" : "=v"(d) : "v"(p) : "memory"); }
__device__ __forceinline__ float* gl_sloc(Frame& F) { return (float*)(F.ws + WS_END); }
__device__ __forceinline__ float* gl_dseg(Frame& F) { return (float*)(F.ws + WS_END + 32 * MiB); }
template <int MODE> __device__ __forceinline__ void gla_mfma(Frame& F, int item, bool dump = (MODE == 0)) {
    const int b = item >> 5, h = (item >> 3) & 3, dir = (item >> 2) & 1, seg = item & 3, n0 = seg * GL_SEGC, n1e = n0 + GL_SEGC;
    if (MODE == 0 && seg == GL_NSEG - 1) return;
    const int w = F.wave;
    LAS unsigned char* L = F.lds + RING_OFF; const unsigned lds0 = (unsigned)(size_t)L;
    bf16* O = dir ? F.OB() : F.OF(); const bf16* VGp = F.VG(); const bf16* QGp = F.QG(); const bf16* KGp = F.KG(); const bf16* LRp = (const bf16*)F.LR();
    const size_t rowb = (size_t)b * SEQ;
    bf16x8 upf; float biasv;
    { const float* up = inp(dir ? I_UPB : I_UPF); const float* bias = inp(dir ? I_BIASB : I_BIASF); const int fr = F.lane & 15, fq = F.lane >> 4;
      v4u t = {0u, 0u, 0u, 0u};
      if (fq < 2) { const float* p = up + (size_t)(8 * fq) * 512 + h * 128 + 16 * w + fr; t.x = cvtpk(p[0], p[512]); t.y = cvtpk(p[1024], p[1536]); t.z = cvtpk(p[2048], p[2560]); t.w = cvtpk(p[3072], p[3584]); }
      upf = __builtin_bit_cast(bf16x8, t); biasv = bias[h * 128 + 16 * w + fr]; }
    f32x16 S[4];
#pragma unroll
    for (int j = 0; j < 4; ++j)
#pragma unroll
        for (int r = 0; r < 16; ++r) S[j][r] = 0.f;
    if (MODE == 1 && seg > 0) {
        if (F.tid < 128 * seg) *(LAS float*)(L + GL_DSEG + 4 * F.tid) = gl_dseg(F)[(size_t)(item - seg + (F.tid >> 7)) * 128 + (F.tid & 127)];
        __syncthreads();
        const int hi_ = F.lane >> 5;
        for (int sp = 0; sp < seg; ++sp) { const float* sl = gl_sloc(F) + ((size_t)((item - seg + sp) * 8 + w) * 64) * 64 + F.lane;
#pragma unroll
            for (int j = 0; j < 4; ++j)
#pragma unroll
                for (int g = 0; g < 4; ++g) { const f32x4 d4 = *(const LAS f32x4*)(L + GL_DSEG + 512 * sp + 4 * (32 * j + 8 * g + 4 * hi_));
#pragma unroll
                    for (int e = 0; e < 4; ++e) S[j][4 * g + e] = S[j][4 * g + e] * d4[e] + sl[(size_t)(j * 16 + 4 * g + e) * 64]; } }
    }
    float dprod = 1.f;

#define GL_ROW(n_, i_) (rowb + (size_t)(dir ? (SEQ - 1 - (64 * (n_) + (i_))) : (64 * (n_) + (i_))))
#define GL_OPAQUE(x) asm volatile("" : "+v"(x))
#define GL_LANE() int ln_ = F.lane; GL_OPAQUE(ln_); const int fr = ln_ & 15, fq = ln_ >> 4, r32 = ln_ & 31, hi = ln_ >> 5; (void)fr; (void)fq; (void)r32; (void)hi
#define GL_LOAD(n1) do { GL_LANE(); \
        _Pragma("unroll") for (int tt = 0; tt < 4; ++tt) { const size_t row_ = GL_ROW(n1, 16 * tt + fr); \
            if (MODE == 1) ldg8_nc(pq[tt], QGp + row_ * 512 + h * 128 + 16 * w + 4 * fq); ldg8_nc(pk[tt], KGp + row_ * 512 + h * 128 + 16 * w + 4 * fq); } \
    } while (0)
#define GL_LOAD_LR(n1) do { GL_LANE(); _Pragma("unroll") for (int tt = 0; tt < 4; ++tt) ldg16_nc(plr[tt], LRp + GL_ROW(n1, 16 * tt + fr) * 32 + dir * 16 + 8 * (fq & 1)); } while (0)
#define GL_WAIT(cnt) asm volatile("s_waitcnt vmcnt(" #cnt ")" : "+v"(plr[0]), "+v"(plr[1]), "+v"(plr[2]), "+v"(plr[3]), "+v"(pk[0]), "+v"(pk[1]), "+v"(pk[2]), "+v"(pk[3]), "+v"(pq[0]), "+v"(pq[1]), "+v"(pq[2]), "+v"(pq[3]) :: "memory")
#define GL_DMA_V(n1, bsel) do { GL_LANE(); _Pragma("unroll") for (int i_ = 0; i_ < 4; ++i_) { const int tok_ = 8 * w + 2 * i_ + hi, ch_ = r32 ^ (((2 * i_ + hi) & 3) << 2); \
        glds16(VGp + GL_ROW(n1, tok_) * 1024 + h * 256 + 8 * ch_, (unsigned)__builtin_amdgcn_readfirstlane((int)(lds0 + GL_V0 + (bsel) * GL_VSZ + 4096 * w + 1024 * i_))); } } while (0)
#define GL_STAGE_A(bsel) do { GL_LANE(); \
        const int fF_ = ((fr & 3) << 2) | ((fr >> 2) & 3); \
        const unsigned aW_ = (unsigned)((fr << 8) | (((2 * w + (fq >> 1)) ^ fF_) << 4) | ((fq & 1) << 3)) + (bsel) * GL_QKSZ; \
        bf16x8 tri0, tri1, ones; \
        _Pragma("unroll") for (int j = 0; j < 8; ++j) { const int tk = 16 * (j >> 2) + 4 * fq + (j & 3); tri0[j] = (tk <= fr) ? (short)0x3F80 : (short)0; tri1[j] = (tk <= 16 + fr) ? (short)0x3F80 : (short)0; ones[j] = (short)0x3F80; } \
        f32x4 zt_[4]; \
        _Pragma("unroll") for (int tt = 0; tt < 4; ++tt) { v4u a_ = plr[tt]; if (fq >= 2) a_ = (v4u){0u, 0u, 0u, 0u}; \
            zt_[tt] = MFMA16(__builtin_bit_cast(bf16x8, a_), upf, ((f32x4){biasv, biasv, biasv, biasv})); } \
        v4u ahi_[2], alo_[2]; \
        _Pragma("unroll") for (int tt = 0; tt < 4; ++tt) { float lg_[4], lo_[4]; unsigned hw_[2]; \
            _Pragma("unroll") for (int r = 0; r < 4; ++r) { const float z_ = zt_[tt][r]; \
                const float ls_ = fminf(z_, 0.f) - 0.6931471805599453f * __builtin_amdgcn_logf(1.0f + __builtin_amdgcn_exp2f(-1.4426950408889634f * fabsf(z_))); \
                lg_[r] = fmaxf(ls_ * 0.0625f, -0.5f); } \
            hw_[0] = cvtpk(lg_[0], lg_[1]); hw_[1] = cvtpk(lg_[2], lg_[3]); \
            lo_[0] = lg_[0] - bflo(hw_[0]); lo_[1] = lg_[1] - bfhi(hw_[0]); lo_[2] = lg_[2] - bflo(hw_[1]); lo_[3] = lg_[3] - bfhi(hw_[1]); \
            const unsigned lw0_ = cvtpk(lo_[0], lo_[1]), lw1_ = cvtpk(lo_[2], lo_[3]); \
            if (tt & 1) { ahi_[tt >> 1].z = hw_[0]; ahi_[tt >> 1].w = hw_[1]; alo_[tt >> 1].z = lw0_; alo_[tt >> 1].w = lw1_; } else { ahi_[tt >> 1].x = hw_[0]; ahi_[tt >> 1].y = hw_[1]; alo_[tt >> 1].x = lw0_; alo_[tt >> 1].y = lw1_; } } \
        const bf16x8 AH0_ = __builtin_bit_cast(bf16x8, ahi_[0]), AL0_ = __builtin_bit_cast(bf16x8, alo_[0]), AH1_ = __builtin_bit_cast(bf16x8, ahi_[1]), AL1_ = __builtin_bit_cast(bf16x8, alo_[1]); \
        const f32x4 z4_ = {0.f, 0.f, 0.f, 0.f}; f32x4 bq_[4]; \
        bq_[0] = MFMA16(AH0_, tri0, z4_); bq_[0] = MFMA16(AL0_, tri0, bq_[0]); \
        bq_[1] = MFMA16(AH0_, tri1, z4_); bq_[1] = MFMA16(AL0_, tri1, bq_[1]); \
        f32x4 tot_ = MFMA16(AH0_, ones, z4_); tot_ = MFMA16(AL0_, ones, tot_); \
        bq_[2] = MFMA16(AH1_, tri0, tot_); bq_[2] = MFMA16(AL1_, tri0, bq_[2]); \
        bq_[3] = MFMA16(AH1_, tri1, tot_); bq_[3] = MFMA16(AL1_, tri1, bq_[3]); \
        if (fr == 15) { f32x4 d_; _Pragma("unroll") for (int r = 0; r < 4; ++r) d_[r] = __builtin_amdgcn_exp2f(1.4426950408889634f * bq_[3][r]); \
            *(LAS f32x4*)(L + GL_DEC + (bsel) * 512 + 4 * (16 * w + 4 * fq)) = d_; } \
        _Pragma("unroll") for (int tq = 0; tq < 4; ++tq) { const u32x2 qw_ = pq[tq], kw_ = pk[tq]; \
            float e_[4], ei_[4]; \
            _Pragma("unroll") for (int r = 0; r < 4; ++r) { const float bl_ = 1.4426950408889634f * bq_[tq][r]; if (MODE == 1) e_[r] = __builtin_amdgcn_exp2f(bl_); ei_[r] = __builtin_amdgcn_exp2f(-bl_); } \
            u32x2 qo_, ko_; if (MODE == 1) { qo_.x = cvtpk(bflo(qw_.x) * e_[0], bfhi(qw_.x) * e_[1]); qo_.y = cvtpk(bflo(qw_.y) * e_[2], bfhi(qw_.y) * e_[3]); } \
            ko_.x = cvtpk(bflo(kw_.x) * ei_[0], bfhi(kw_.x) * ei_[1]); ko_.y = cvtpk(bflo(kw_.y) * ei_[2], bfhi(kw_.y) * ei_[3]); \
            if (MODE == 1) *(LAS u32x2*)(L + aW_ + tq * 4096) = qo_; *(LAS u32x2*)(L + aW_ + GL_KI + tq * 4096) = ko_; } \
    } while (0)

    v4u plr[4]; u32x2 pq[4] = {}, pk[4];
    GL_DMA_V(n0, n0 & 1);
    GL_LOAD(n0); GL_LOAD_LR(n0);
    GL_WAIT(0);
    GL_STAGE_A(n0 & 1);
    GL_LOAD(n0 + 1); GL_LOAD_LR(n0 + 1);
    GL_WAIT(0);
    __syncthreads();
    for (int n = n0; n < n1e; ++n) {
        const int bs = n & 1;
        if (MODE == 1) {
            GL_LANE();
            const int fF = ((fr & 3) << 2) | ((fr >> 2) & 3);
            const unsigned aB = (unsigned)((fr << 8) | ((fq ^ fF) << 4)) + bs * GL_QKSZ;
            const unsigned aPw = (unsigned)((fr << 7) | (((fq >> 1) ^ ((fr >> 1) & 7)) << 4) | ((fq & 1) << 3)) + GL_P;
            const int tq = w & 3;
#pragma unroll
            for (int tkk = 0; tkk < 2; ++tkk) { const int tk = 2 * (w >> 2) + tkk; f32x4 acc = {0.f, 0.f, 0.f, 0.f};
                if (tk <= tq) {
#pragma unroll
                    for (int kk = 0; kk < 4; ++kk) { const bf16x8 a = *(const LAS bf16x8*)(L + (aB ^ (kk << 6)) + GL_KI + tk * 4096), bb = *(const LAS bf16x8*)(L + (aB ^ (kk << 6)) + tq * 4096); acc = MFMA16(a, bb, acc); }
#pragma unroll
                    for (int r = 0; r < 4; ++r) { const int tokk = 16 * tk + 4 * fq + r, tokq = 16 * tq + fr; const bool keep = dir ? (tokk < tokq) : (tokk <= tokq); acc[r] = keep ? acc[r] : 0.f; }
                }
                u32x2 pw; pw.x = cvtpk(acc[0], acc[1]); pw.y = cvtpk(acc[2], acc[3]);
                *(LAS u32x2*)(L + (aPw ^ (tk << 5)) + tq * 2048) = pw; }
        }
        __builtin_amdgcn_sched_barrier(0);
        if (n + 1 < n1e) { if (MODE == 1) GL_WAIT(4); else GL_WAIT(0); GL_STAGE_A(bs ^ 1); }
        __builtin_amdgcn_sched_barrier(0);
        if (MODE == 1) { asm volatile("s_waitcnt vmcnt(4)" ::: "memory"); __syncthreads(); }
        if (n + 1 < n1e) { GL_DMA_V(n + 1, bs ^ 1); }
        if (n + 2 < n1e) { GL_LOAD(n + 2); GL_LOAD_LR(n + 2); }
        if (dump && F.tid < 128) dprod *= *(const LAS float*)(L + GL_DEC + bs * 512 + 4 * F.tid);
        {
            GL_LANE();
            const int i16 = ln_ & 15, q4 = i16 >> 2, p4 = i16 & 3, h16 = (ln_ >> 4) & 1;
            const int fR = ((r32 & 3) << 2) | ((r32 >> 2) & 3);
            const unsigned aV = (unsigned)(((8 * hi + q4) << 9) | (((4 * w + 2 * h16 + (p4 >> 1)) ^ (q4 << 2)) << 4) | ((p4 & 1) << 3)) + GL_V0 + bs * GL_VSZ;
            const unsigned aC = (unsigned)((r32 << 8) | (fR << 4) | (hi << 3)) + bs * GL_QKSZ;
            const unsigned aPr = (unsigned)((r32 << 7) | ((hi ^ ((r32 >> 1) & 7)) << 4)) + GL_P;
            const unsigned aK0 = (unsigned)(((8 * hi + q4) << 8) | ((((2 * h16 + (p4 >> 1)) ^ ((q4 << 2) | ((2 * hi) & 3))) & 15) << 4) | ((p4 & 1) << 3)) + bs * GL_QKSZ + GL_KI;
            const unsigned aK1 = (unsigned)(((8 * hi + q4 + 4) << 8) | ((((2 * h16 + (p4 >> 1)) ^ ((q4 << 2) | ((2 * hi + 1) & 3))) & 15) << 4) | ((p4 & 1) << 3)) + bs * GL_QKSZ + GL_KI;
            const unsigned aD = GL_DEC + bs * 512 + 16 * hi;
            bf16x8 vf[4];
#pragma unroll
            for (int s = 0; s < 4; ++s) { const s16x4 lo = tr_rd(L + aV + s * 8192), hh = tr_rd(L + aV + s * 8192 + 2048);
                vf[s] = (bf16x8){lo[0], lo[1], lo[2], lo[3], hh[0], hh[1], hh[2], hh[3]}; }
#define GL_QDF(f, a) ({ const u32x2 q0_ = *(const LAS u32x2*)(L + (aC ^ ((2 * (f)) << 4)) + (a) * 8192), q1_ = *(const LAS u32x2*)(L + (aC ^ ((2 * (f) + 1) << 4)) + (a) * 8192); (v4u){q0_.x, q0_.y, q1_.x, q1_.y}; })
#define GL_KIF(f) ({ const s16x4 lo_ = tr_rd(L + (aK0 ^ (((f) >> 2) << 6)) + ((f) & 3) * 4096), hh_ = tr_rd(L + (aK1 ^ (((f) >> 2) << 6)) + ((f) & 3) * 4096); (bf16x8){lo_[0], lo_[1], lo_[2], lo_[3], hh_[0], hh_[1], hh_[2], hh_[3]}; })
            if (MODE == 1) {
#pragma unroll
            for (int a = 0; a < 2; ++a) {
                f32x16 oT;
#pragma unroll
                for (int r = 0; r < 16; ++r) oT[r] = 0.f;
                v4u qf[4]; bf16x8 pf[4];
                qf[0] = GL_QDF(0, a); qf[1] = GL_QDF(1, a); qf[2] = GL_QDF(2, a);
                __builtin_amdgcn_sched_barrier(0);
#pragma unroll
                for (int f = 0; f < 8; ++f) {
                    if (f + 3 < 8) qf[(f + 3) & 3] = GL_QDF(f + 3, a);
                    if (f == 6) { pf[0] = *(const LAS bf16x8*)(L + (aPr ^ (0 << 5)) + a * 4096); pf[1] = *(const LAS bf16x8*)(L + (aPr ^ (1 << 5)) + a * 4096); }
                    if (f == 7) { pf[2] = *(const LAS bf16x8*)(L + (aPr ^ (2 << 5)) + a * 4096); pf[3] = *(const LAS bf16x8*)(L + (aPr ^ (3 << 5)) + a * 4096); }
                    oT = MFMA32(pack_step(S[f >> 1], f & 1), __builtin_bit_cast(bf16x8, qf[f & 3]), oT);
                    __builtin_amdgcn_sched_barrier(0); }
#pragma unroll
                for (int s = 0; s < 4; ++s) oT = MFMA32(vf[s], pf[s], oT);
                { const unsigned ost = GL_OST + w * GL_OSTW;
#pragma unroll
                  for (int g = 0; g < 4; ++g) { u32x2 ow; ow.x = cvtpk(oT[4 * g], oT[4 * g + 1]); ow.y = cvtpk(oT[4 * g + 2], oT[4 * g + 3]); *(LAS u32x2*)(L + ost + r32 * 80 + 16 * g + 8 * hi) = ow; }
                  asm volatile("s_waitcnt lgkmcnt(0)" ::: "memory");
#pragma unroll
                  for (int i = 0; i < 2; ++i) { const int tk = (ln_ >> 2) + 16 * i; const v4u ov = *(const LAS v4u*)(L + ost + tk * 80 + 16 * (ln_ & 3));
                      *(v4u*)(O + GL_ROW(n, 32 * a + tk) * 1024 + h * 256 + 32 * w + 8 * (ln_ & 3)) = ov; }
                  asm volatile("s_waitcnt lgkmcnt(0)" ::: "memory"); }
            }
            }
            {
                bf16x8 kf[4]; kf[0] = GL_KIF(0); kf[1] = GL_KIF(1); kf[2] = GL_KIF(2);
                f32x4 d4[4];
                __builtin_amdgcn_sched_barrier(0);
#pragma unroll
                for (int f = 0; f < 16; ++f) {
                    if (f + 3 < 16) kf[(f + 3) & 3] = GL_KIF(f + 3);
                    if ((f & 3) == 1) {
#pragma unroll
                        for (int g = 0; g < 4; ++g) d4[g] = *(const LAS f32x4*)(L + aD + 128 * (f >> 2) + 32 * g); }
                    S[f >> 2] = MFMA32(kf[f & 3], vf[f & 3], S[f >> 2]);
                    if ((f & 3) == 3) { const int j = f >> 2;
#pragma unroll
                        for (int g = 0; g < 4; ++g)
#pragma unroll
                            for (int e = 0; e < 4; ++e) S[j][4 * g + e] *= d4[g][e]; }
                    __builtin_amdgcn_sched_barrier(0);
                }
            }
#undef GL_QDF
#undef GL_KIF
        }
        if (MODE == 0) { if (n + 2 < n1e) asm volatile("s_waitcnt vmcnt(8)" ::: "memory"); else asm volatile("s_waitcnt vmcnt(0)" ::: "memory"); }
        __syncthreads();
    }
    if (dump) {
        float* sl = gl_sloc(F) + ((size_t)(item * 8 + w) * 64) * 64 + F.lane;
#pragma unroll
        for (int j = 0; j < 4; ++j)
#pragma unroll
            for (int r = 0; r < 16; ++r) sl[(size_t)(j * 16 + r) * 64] = S[j][r];
        if (F.tid < 128) gl_dseg(F)[(size_t)item * 128 + F.tid] = dprod; }
#undef GL_STAGE_A
#undef GL_LOAD
#undef GL_LOAD_LR
#undef GL_WAIT
#undef GL_DMA_V
#undef GL_LANE
#undef GL_ROW
#undef GL_OPAQUE
}

constexpr int CW_SWAQ = 64;
constexpr int SWA_ITEMS = BATCH * 2 * 32 * 2;
__device__ __forceinline__ void swa_mfma(Frame& F, int dummy_o = 0, int abl = 0) {
    const int lane = F.lane, w = F.wave, r32 = lane & 31, hi = lane >> 5, tid = F.tid;
    const int g16 = lane >> 4, i16 = lane & 15, q4 = i16 >> 2, p4 = i16 & 3, h16 = g16 & 1;
    LAS unsigned char* L = F.lds + RING_OFF;
    volatile LAS unsigned* qword = F.MISC + 16;
    unsigned step = 0;
    bf16* SQp = F.SQ(); const bf16* SKp = F.SK(); const bf16* SVp = F.SV(); const float* sinksp = inp(I_SINKS);
    bool fastsm;
    { const float* gq = inp(I_GQ); const float* gk = inp(I_GK);
      const float a = wave_max(fmaxf(fabsf(gq[lane]), fabsf(gq[lane + 64]))), b2 = wave_max(fmaxf(fabsf(gk[lane]), fabsf(gk[lane + 64]))), sk = wave_max(lane < 8 ? fabsf(sinksp[lane]) : 0.f);
      fastsm = __builtin_amdgcn_readfirstlane((16.4f * a * b2 + 1.4426950408889634f * sk < 60.f) ? 1 : 0) != 0; }
    if (tid == 0) qword[0] = __hip_atomic_fetch_add(F.ctl + CW_SWAQ, 1u, __ATOMIC_RELAXED, __HIP_MEMORY_SCOPE_AGENT);
    __syncthreads();
    int item = (int)qword[0]; if (item > SWA_ITEMS) item = SWA_ITEMS;
    const int qt = w & 3;
    v4u qv[8], kr[2], vr[2];
#define SW_DECODE(it_, hp_, n_, kvh_, b_) const int hp_ = (it_) & 1, n_ = ((it_) >> 1) & 31, kvh_ = ((it_) >> 6) & 1, b_ = (it_) >> 7
#define SW_LOAD(b_, kvh_, n_, t_) do { const bf16* kg_ = SKp + (size_t)(b_) * SEQ * 256 + (kvh_) * 128; const bf16* vg_ = SVp + (size_t)(b_) * SEQ * 256 + (kvh_) * 128; const int k0_ = 128 * ((n_) - 1) + 64 * (t_); \
        _Pragma("unroll") for (int i_ = 0; i_ < 2; ++i_) { const int c_ = tid + 512 * i_, key_ = c_ >> 4, ch_ = c_ & 15; \
            kr[i_] = *(const v4u*)(kg_ + (size_t)(k0_ + key_) * 256 + 8 * ch_); vr[i_] = *(const v4u*)(vg_ + (size_t)(k0_ + key_) * 256 + 8 * ch_); } } while (0)
#define SW_STORE(bsel) do { _Pragma("unroll") for (int i_ = 0; i_ < 2; ++i_) { const int c_ = tid + 512 * i_, key_ = c_ >> 4, ch_ = c_ & 15; \
            *(LAS v4u*)(L + (bsel) * 32768 + qk_off(key_, ch_)) = kr[i_]; *(LAS v4u*)(L + (bsel) * 32768 + 16384 + qk_off(key_, ch_)) = vr[i_]; } } while (0)
#define SW_PREFETCH(it_) do { SW_DECODE(it_, hp_, n_, kvh_, b_); const bf16* qb_ = SQp + ((size_t)b_ * SEQ + 128 * n_ + 32 * qt) * 1024 + (4 * kvh_ + 2 * hp_ + (w >> 2)) * 128; \
        int ln_ = lane; asm volatile("" : "+v"(ln_));        \
        const unsigned qo_ = (unsigned)((ln_ >> 4) * 2048 + 16 * (ln_ & 15)); \
        _Pragma("unroll") for (int i_ = 0; i_ < 8; ++i_) qv[i_] = (abl & 64) ? (v4u){0u, 0u, 0u, 0u} : *(const v4u*)((const unsigned char*)qb_ + (qo_ + 8192u * i_)); \
        if (!(abl & 8)) SW_LOAD(b_, kvh_, n_, (n_ == 0) ? 2 : 0); else { kr[0] = kr[1] = vr[0] = vr[1] = (v4u){0u, 0u, 0u, 0u}; } } while (0)
    if (item < SWA_ITEMS) SW_PREFETCH(item);
    while (item < SWA_ITEMS) {
        if (tid == 0) qword[2] = __hip_atomic_fetch_add(F.ctl + CW_SWAQ, 1u, __ATOMIC_RELAXED, __HIP_MEMORY_SCOPE_AGENT);
        SW_DECODE(item, hp, n, kvh, b);
        const int head = 4 * kvh + 2 * hp + (w >> 2), qi = 128 * n + 32 * qt + r32;
        const size_t rowb = (size_t)b * SEQ;
        bf16x8 qf[8];
        { LAS unsigned char* qst = L + 65536 + w * 8704;
#pragma unroll
          for (int i = 0; i < 8; ++i) *(LAS v4u*)(qst + (4 * i + (lane >> 4)) * 272 + 16 * (lane & 15)) = qv[i];
          asm volatile("s_waitcnt lgkmcnt(0)" ::: "memory");
#pragma unroll
          for (int s = 0; s < 8; ++s) qf[s] = *(const LAS bf16x8*)(qst + r32 * 272 + 16 * (2 * s + hi));
          asm volatile("s_waitcnt lgkmcnt(0)" ::: "memory"); }
        float m = sinksp[head] * 1.4426950408889634f, l = hi ? 0.f : 1.f;
        f32x16 O[4];
#pragma unroll
        for (int dt = 0; dt < 4; ++dt)
#pragma unroll
            for (int r = 0; r < 16; ++r) O[dt][r] = 0.f;
        const int t_lo = (n == 0) ? 2 : 0, t_hi = (n == 31) ? 4 : 6;
        for (int t = t_lo; t < t_hi; ++t) {
            const int bs = step & 1; ++step;
            if (!(abl & 16)) SW_STORE(bs);
            __syncthreads();
            if (t + 1 < t_hi && !(abl & 8)) SW_LOAD(b, kvh, n, t + 1);
            const int k0 = 128 * (n - 1) + 64 * t, qlo = 128 * n + 32 * qt;
            if (k0 + 63 >= qlo - 128 && k0 <= qlo + 31 + 128 && !(abl & 32)) {
                LAS unsigned char* K = L + bs * 32768; LAS unsigned char* V = K + 16384;
                f32x16 p0, p1;
#pragma unroll
                for (int r = 0; r < 16; ++r) { p0[r] = 0.f; p1[r] = 0.f; }
                unsigned aKr = (unsigned)(bs * 32768) + (unsigned)((r32 << 8) | ((hi ^ (((r32 & 3) << 2) | ((r32 >> 2) & 3))) << 4)); asm volatile("" : "+v"(aKr));
#define SW_KF(s_, half) (*(const LAS bf16x8*)(L + (aKr ^ ((2 * (s_)) << 4)) + (half) * 8192))
                bf16x8 ka[4], kb[4];
                ka[0] = SW_KF(0, 0); kb[0] = SW_KF(0, 1); ka[1] = SW_KF(1, 0); kb[1] = SW_KF(1, 1); ka[2] = SW_KF(2, 0); kb[2] = SW_KF(2, 1);
                __builtin_amdgcn_sched_barrier(0);
#pragma unroll
                for (int s = 0; s < 8; ++s) {
                    if (s + 3 < 8) { ka[(s + 3) & 3] = SW_KF(s + 3, 0); kb[(s + 3) & 3] = SW_KF(s + 3, 1); }
                    if (!(abl & 1)) { p0 = MFMA32(ka[s & 3], qf[s], p0); p1 = MFMA32(kb[s & 3], qf[s], p1); }
                    __builtin_amdgcn_sched_barrier(0); }
#undef SW_KF
                if (!(abl & 2)) {
                const bool needmask = !(k0 + 63 - qlo <= 128 && qlo + 31 - k0 <= 128);
                if (needmask) {
#pragma unroll
                    for (int r = 0; r < 16; ++r) { const int kj = k0 + (r & 3) + 8 * (r >> 2) + 4 * hi;
                        p0[r] = ((unsigned)(qi - kj + 128) <= 256u) ? p0[r] : -INFINITY; p1[r] = ((unsigned)(qi - kj - 32 + 128) <= 256u) ? p1[r] : -INFINITY; } }
                float mn = m, alpha = 1.f;
                if (!fastsm) { float mloc = -INFINITY;
#pragma unroll
                    for (int r = 0; r < 16; ++r) mloc = fmaxf(mloc, fmaxf(p0[r], p1[r]));
                    mloc = fmaxf(mloc, __shfl_xor(mloc, 32));
                    mn = fmaxf(m, mloc); alpha = __builtin_amdgcn_exp2f(m - mn); m = mn; }
                float ls = 0.f;
#pragma unroll
                for (int r = 0; r < 16; ++r) { p0[r] = __builtin_amdgcn_exp2f(p0[r] - mn); p1[r] = __builtin_amdgcn_exp2f(p1[r] - mn); ls += p0[r] + p1[r]; }
                l = l * alpha + ls;
                if (!fastsm) {
#pragma unroll
                    for (int dt = 0; dt < 4; ++dt)
#pragma unroll
                        for (int r = 0; r < 16; ++r) O[dt][r] *= alpha; }
                }
                bf16x8 pb[4]; pb[0] = pack_step(p0, 0); pb[1] = pack_step(p0, 1); pb[2] = pack_step(p1, 0); pb[3] = pack_step(p1, 1);
                unsigned aVr0 = (unsigned)(bs * 32768 + 16384) + (unsigned)(((4 * hi + q4) << 8) | ((((2 * h16 + (p4 >> 1)) ^ ((q4 << 2) | hi)) & 15) << 4) | ((p4 & 1) << 3));
                unsigned aVr1 = (unsigned)(bs * 32768 + 16384) + (unsigned)(((4 * hi + q4 + 8) << 8) | ((((2 * h16 + (p4 >> 1)) ^ ((q4 << 2) | (2 + hi))) & 15) << 4) | ((p4 & 1) << 3));
                asm volatile("" : "+v"(aVr0), "+v"(aVr1));
#define SW_VF(f_) ({ const s16x4 lo_ = tr_rd(L + (aVr0 ^ (((f_) >> 2) << 6)) + ((f_) & 3) * 4096), hh_ = tr_rd(L + (aVr1 ^ (((f_) >> 2) << 6)) + ((f_) & 3) * 4096); (bf16x8){lo_[0], lo_[1], lo_[2], lo_[3], hh_[0], hh_[1], hh_[2], hh_[3]}; })
                bf16x8 vf[4]; vf[0] = SW_VF(0); vf[1] = SW_VF(1); vf[2] = SW_VF(2);
                __builtin_amdgcn_sched_barrier(0);
#pragma unroll
                for (int f = 0; f < 16; ++f) {
                    if (f + 3 < 16) vf[(f + 3) & 3] = SW_VF(f + 3);
                    if (!(abl & 4)) O[f >> 2] = MFMA32(vf[f & 3], pb[f & 3], O[f >> 2]);
                    __builtin_amdgcn_sched_barrier(0); }
#undef SW_VF
            }
        }
        __builtin_amdgcn_sched_barrier(0);
        const unsigned nx = qword[2]; const int nitem = (nx < (unsigned)SWA_ITEMS) ? (int)nx : SWA_ITEMS;
        if (nitem < SWA_ITEMS) SW_PREFETCH(nitem);
        __builtin_amdgcn_sched_barrier(0);
        l += __shfl_xor(l, 32);
        const float inv = 1.0f / l;
        if (!(abl & 64)) {
            LAS unsigned char* ost = L + 65536 + w * 8704;
#pragma unroll
            for (int dt = 0; dt < 4; ++dt)
#pragma unroll
                for (int g = 0; g < 4; ++g) { u32x2 ow; ow.x = cvtpk(O[dt][4 * g] * inv, O[dt][4 * g + 1] * inv); ow.y = cvtpk(O[dt][4 * g + 2] * inv, O[dt][4 * g + 3] * inv);
                    *(LAS u32x2*)(ost + r32 * 272 + 2 * (32 * dt + 8 * g + 4 * hi)) = ow; }
            asm volatile("s_waitcnt lgkmcnt(0)" ::: "memory");
            bf16* ob = dummy_o ? (bf16*)(F.ws + WS_DUMMY) + (size_t)((128 * n + 32 * qt) & 1023) * 1024 + head * 128 : SQp + (rowb + 128 * n + 32 * qt) * 1024 + head * 128;
            int ln2 = lane; asm volatile("" : "+v"(ln2));
            const unsigned oo = (unsigned)((ln2 >> 4) * 2048 + 16 * (ln2 & 15)), so = (unsigned)((ln2 >> 4) * 272 + 16 * (ln2 & 15));
#pragma unroll
            for (int i = 0; i < 8; ++i) { const v4u ov = *(const LAS v4u*)(ost + so + 4 * 272 * i); *(v4u*)((unsigned char*)ob + (oo + 8192u * i)) = ov; }
            asm volatile("s_waitcnt lgkmcnt(0)" ::: "memory");
        }
        __syncthreads();
        item = nitem;
    }
#undef SW_LOAD
#undef SW_STORE
#undef SW_PREFETCH
#undef SW_DECODE
}

constexpr int N_PHASES = 10;
constexpr int SWA_PHASE3_LIMIT = 600;
#ifndef STAGGER_US
#define STAGGER_US 0
#endif
__device__ __forceinline__ void stagger_wait(int us) { if (us > 0 && (blockIdx.x & 8)) { const unsigned long long t0 = __builtin_amdgcn_s_memrealtime(); while (__builtin_amdgcn_s_memrealtime() - t0 < (unsigned long long)us * 100ull) __builtin_amdgcn_s_sleep(8); } }
#ifndef PROBE_REP
#define PROBE_REP -1
#endif
#ifndef PROBE_N
#define PROBE_N 3
#endif
#ifndef PROBE_ABL
#define PROBE_ABL 0
#endif
static_assert(GLA_LDS_END <= LDSCTL_OFF, "GLA LDS map");
struct Args { const float* in[17]; float* out; unsigned char* ws; int ph_lo, ph_hi, use_bar, pad; };
__global__ void __launch_bounds__(NWAVES * 64, 2) mk_fwd(Args args) {
    extern __shared__ __attribute__((aligned(16))) unsigned char lds[];
    Frame F;
    F.lds = (LAS unsigned char*)lds;
    F.MISC = (volatile LAS unsigned*)(F.lds + MISC_OFF);
    F.tid = threadIdx.x; F.lane = F.tid & 63; F.wave = __builtin_amdgcn_readfirstlane(F.tid >> 6);
    F.G = gridDim.x; { const int bx = blockIdx.x; F.vcu = (F.G % 8 == 0) ? (bx % 8) * (F.G / 8) + bx / 8 : bx; }
    F.ws = args.ws; F.out = args.out;
    F.ctl = (gu32*)(args.ws + WS_CTL);
    for (int u = F.tid; u < (LDS_BYTES - LDSCTL_OFF) / 4; u += NWAVES * 64) ((LAS unsigned*)(F.lds + LDSCTL_OFF))[u] = 0u;
    __syncthreads();
    XcdBarrier bar; bar.bar = (unsigned*)(F.ctl + CW_BAR); bar.x = 0; bar.st = nullptr;
    if (args.use_bar) bar = xcd_barrier_post((unsigned*)(F.ctl + CW_BAR), F.MISC + 8);
    const int lo = args.ph_lo, hi = args.ph_hi;
#define IN(k) (lo <= (k) && (k) < hi)
#define SEAM(k) do { if (IN(k) && IN((k) + 1)) xcd_barrier(bar); } while (0)

    if (IN(0)) { p0_prologue(F); } SEAM(0);
    if (IN(1)) {
#if PROBE_REP == 11
        p1_lr(F);
#endif
        stagger_wait(STAGGER_US);
        pg8::Gemm g{F.XN(), F.WIN(), M, NPROJ, DM}; pg8::StaticOrder S; S.init(M, NPROJ, F.G, (int)blockIdx.x);
        static_assert(pg8::EpiProj::O_QG == WS_QG && pg8::EpiProj::O_KG == WS_KG && pg8::EpiProj::O_VG == WS_VG && pg8::EpiProj::O_R == WS_R && pg8::EpiProj::O_SQ == WS_SQ && pg8::EpiProj::O_SK == WS_SK && pg8::EpiProj::O_SV == WS_SV && pg8::EpiProj::O_GA == WS_GA && pg8::EpiProj::O_GB == WS_GB, "EpiProj offsets");
        pg8::EpiProj E{F.ws, args.pad & 128};
        pg8::gemm_phase<pg8::EpiProj, pg8::StaticOrder, true, true>(F.lds + RING_OFF, g, S, E);
    } SEAM(1);
    if (IN(2)) { p1b_qknorm_rope(F, args.pad & 8); } SEAM(2);
    if (IN(3)) { if ((args.pad & 3) != 2) gla_mfma<0>(F, F.vcu); __syncthreads(); if ((args.pad & 3) != 1) swa_mfma(F, args.pad & 8, args.pad >> 8); } SEAM(3);
    if (IN(4)) { gla_mfma<1>(F, F.vcu); } SEAM(4);
    if (IN(5)) { p2c_combine(F, args.pad & 8); } SEAM(5);
    if (IN(6)) {
        pg8::Gemm g{F.R(), F.WG(), M, DM, DM, F.SQ(), F.WS_()}; pg8::StaticOrder S; S.init(M, DM, F.G, (int)blockIdx.x);
        pg8::EpiMerge2 E{F.GA(), F.GB(), F.MERGED()};
        pg8::gemm_phase<pg8::EpiMerge2, pg8::StaticOrder, true, true, true>(F.lds + RING_OFF, g, S, E);
    } SEAM(6);
    if (IN(7)) {
        pg8::Gemm g{F.MERGED(), F.WOUT(), M, DM, DM}; pg8::StaticOrder S; S.init(M, DM, F.G, (int)blockIdx.x);
        pg8::EpiX1 E{inp(I_X), F.X1B(), F.SSQ()};
        pg8::gemm_phase<pg8::EpiX1, pg8::StaticOrder, true, true>(F.lds + RING_OFF, g, S, E);
    } SEAM(7);
    if (IN(8)) {
        stagger_wait(STAGGER_US);
        pg8::Gemm g{F.X1B(), F.WFI(), M, 2 * DFF, DM}; pg8::StaticOrder S; S.init(M, 2 * DFF, F.G, (int)blockIdx.x);
        pg8::EpiSwiGLU E{F.SSQ(), F.H()};
        pg8::gemm_phase<pg8::EpiSwiGLU, pg8::StaticOrder, true, true>(F.lds + RING_OFF, g, S, E);
    } SEAM(8);
    if (IN(9)) {
        pg8::Gemm g{F.H(), F.WFO(), M, DM, DFF}; pg8::StaticOrder S; S.init(M, DM, F.G, (int)blockIdx.x);
        pg8::EpiResid E{F.X1B(), F.out};
        pg8::gemm_phase<pg8::EpiResid, pg8::StaticOrder, true, true>(F.lds + RING_OFF, g, S, E);
    }
#undef IN
#undef SEAM
}

#ifndef MK_ONE_LAUNCH
#define MK_ONE_LAUNCH 1
#endif
extern "C" void kernel_launch(void* const* d_in, const int* in_sizes, int n_in, void* d_out, int out_size, void* d_ws, size_t ws_size, hipStream_t stream) {
    static int grid = 0;
    if (grid == 0) {
        if (n_in != 17 || in_sizes[0] != M * DM || out_size != M * DM || ws_size < WS_END + 33 * MiB) { fprintf(stderr, "kernel_launch: shape/workspace mismatch (n_in %d, in0 %d, out %d, ws %zu); nothing launched\n", n_in, n_in > 0 ? in_sizes[0] : -1, out_size, ws_size); grid = -1; return; }
        int dev = 0, cus = 0;
        if (hipGetDevice(&dev) != hipSuccess || hipDeviceGetAttribute(&cus, hipDeviceAttributeMultiprocessorCount, dev) != hipSuccess) { grid = -1; return; }
        if (hipFuncSetAttribute((const void*)mk_fwd, hipFuncAttributeMaxDynamicSharedMemorySize, LDS_BYTES) != hipSuccess) { fprintf(stderr, "kernel_launch: hipFuncSetAttribute failed\n"); grid = -1; return; }
        (void)hipGetLastError();
        grid = cus;
        if (grid != 256) fprintf(stderr, "kernel_launch: %d CUs; built for 256\n", grid);
    }
    if (grid < 0) return;
    (void)hipMemsetAsync((char*)d_ws + WS_CTL, 0, CTL_ZERO_BYTES, stream);
    Args a{};
    for (int i = 0; i < 17; ++i) a.in[i] = (const float*)d_in[i];
    a.out = (float*)d_out; a.ws = (unsigned char*)d_ws;
#if PROBE_REP == -1
    a.ph_lo = 0; a.ph_hi = N_PHASES; a.use_bar = 1;
    hipLaunchKernelGGL(mk_fwd, dim3(grid), dim3(NWAVES * 64), LDS_BYTES, stream, a);
#else
    for (int p = 0; p < N_PHASES; ++p) { const int nrep = (p == PROBE_REP) ? PROBE_N : 1;
        if (p == 2 && PROBE_REP == 21) {
            a.ph_lo = 2; a.ph_hi = 3; a.use_bar = 0;
            for (int r = 0; r + 1 < PROBE_N; ++r) { a.pad = 2 | 8; hipLaunchKernelGGL(mk_fwd, dim3(grid), dim3(NWAVES * 64), LDS_BYTES, stream, a); }
            a.pad = 0; hipLaunchKernelGGL(mk_fwd, dim3(grid), dim3(NWAVES * 64), LDS_BYTES, stream, a); continue; }
        if (p == 4 && PROBE_REP == 40) {
            a.ph_lo = 4; a.ph_hi = 5; a.use_bar = 0;
            for (int r = 0; r + 1 < PROBE_N; ++r) { a.pad = 8; hipLaunchKernelGGL(mk_fwd, dim3(grid), dim3(NWAVES * 64), LDS_BYTES, stream, a); }
            a.pad = 0; hipLaunchKernelGGL(mk_fwd, dim3(grid), dim3(NWAVES * 64), LDS_BYTES, stream, a); continue; }
        if (p == 2 && PROBE_REP == 20) {
            a.ph_lo = 2; a.ph_hi = 3; a.use_bar = 0;
            for (int r = 0; r + 1 < PROBE_N; ++r) { a.pad = 5; hipLaunchKernelGGL(mk_fwd, dim3(grid), dim3(NWAVES * 64), LDS_BYTES, stream, a); }
            a.pad = 0; hipLaunchKernelGGL(mk_fwd, dim3(grid), dim3(NWAVES * 64), LDS_BYTES, stream, a); continue; }
        if (p == 1 && PROBE_REP == 11) {
            a.ph_lo = 1; a.ph_hi = 2; a.use_bar = 0; a.pad = 16; hipLaunchKernelGGL(mk_fwd, dim3(grid), dim3(NWAVES * 64), LDS_BYTES, stream, a); a.pad = 0; continue; }
        if (p == 1 && PROBE_REP == 12) {
            a.ph_lo = 1; a.ph_hi = 2; a.use_bar = 0;
            for (int r = 0; r + 1 < PROBE_N; ++r) { a.pad = 128; hipLaunchKernelGGL(mk_fwd, dim3(grid), dim3(NWAVES * 64), LDS_BYTES, stream, a); }
            a.pad = 0; hipLaunchKernelGGL(mk_fwd, dim3(grid), dim3(NWAVES * 64), LDS_BYTES, stream, a); continue; }
        if (p == 4 && PROBE_REP == 41) {
            a.ph_lo = 4; a.ph_hi = 5; a.use_bar = 0;
            for (int r = 0; r + 1 < PROBE_N; ++r) { a.pad = 4 | (PROBE_ABL << 8); hipLaunchKernelGGL(mk_fwd, dim3(grid), dim3(NWAVES * 64), LDS_BYTES, stream, a); }
            a.pad = 0; hipLaunchKernelGGL(mk_fwd, dim3(grid), dim3(NWAVES * 64), LDS_BYTES, stream, a); continue; }
        if (p == 3 && PROBE_REP == 36) {
            a.ph_lo = 3; a.ph_hi = 4; a.use_bar = 0;
            for (int r = 0; r + 1 < PROBE_N; ++r) { a.pad = 1; hipLaunchKernelGGL(mk_fwd, dim3(grid), dim3(NWAVES * 64), LDS_BYTES, stream, a); }
            a.pad = 0; hipLaunchKernelGGL(mk_fwd, dim3(grid), dim3(NWAVES * 64), LDS_BYTES, stream, a); continue; }
        if (p == 3 && PROBE_REP == 37) {
            a.ph_lo = 3; a.ph_hi = 4; a.use_bar = 0;
            for (int r = 0; r + 1 < PROBE_N; ++r) { a.pad = 8; hipLaunchKernelGGL(mk_fwd, dim3(grid), dim3(NWAVES * 64), LDS_BYTES, stream, a); (void)hipMemsetAsync((char*)d_ws + WS_CTL, 0, 4096, stream); }
            a.pad = 0; hipLaunchKernelGGL(mk_fwd, dim3(grid), dim3(NWAVES * 64), LDS_BYTES, stream, a); continue; }
        if (p == 3 && PROBE_REP == 35) {
            a.ph_lo = 3; a.ph_hi = 4; a.use_bar = 0;
            for (int r = 0; r + 1 < PROBE_N; ++r) { a.pad = 2 | 8 | (PROBE_ABL << 8); hipLaunchKernelGGL(mk_fwd, dim3(grid), dim3(NWAVES * 64), LDS_BYTES, stream, a); (void)hipMemsetAsync((char*)d_ws + WS_CTL, 0, 4096, stream); }
            a.pad = 0; hipLaunchKernelGGL(mk_fwd, dim3(grid), dim3(NWAVES * 64), LDS_BYTES, stream, a); continue; }
        if (p == 3 && PROBE_REP >= 30 && PROBE_REP < 40) {
            a.ph_lo = 3; a.ph_hi = 4; a.use_bar = 0;
            for (int r = 0; r < (PROBE_REP == 30 ? 1 : PROBE_N); ++r) { a.pad = (r + 1 < (PROBE_REP == 30 ? 1 : PROBE_N)) ? 5 : 1; hipLaunchKernelGGL(mk_fwd, dim3(grid), dim3(NWAVES * 64), LDS_BYTES, stream, a); }
            a.pad = 2; hipLaunchKernelGGL(mk_fwd, dim3(grid), dim3(NWAVES * 64), LDS_BYTES, stream, a); a.pad = 0; continue; }
        for (int r = 0; r < nrep; ++r) { a.ph_lo = p; a.ph_hi = p + 1; a.use_bar = 0; hipLaunchKernelGGL(mk_fwd, dim3(grid), dim3(NWAVES * 64), LDS_BYTES, stream, a); } }
#endif
}
```
